# Optimizing an MI355X kernel written in HIP

```python
import jax, jax.numpy as jnp
from jax import lax
import numpy as np


D_MODEL = 1024
BATCH = 4
SEQ = 8192
DEPTH = 4

MLA_HEADS = 4
QK_NOPE_DIM = 64
QK_ROPE_DIM = 32
V_HEAD_DIM = 64
Q_RANK = D_MODEL // 4
KV_RANK = D_MODEL // 8
ROPE_BASE = 10000.0
Q_BLOCK = 128
SG_GROUPS = 4
SG_WIDTH = D_MODEL // 4
SG_CHUNK = 128
CONV_WIDTH = D_MODEL // 4
CONV_K = 3
POOL_WINDOWS = (2, 4, 8, 16)
POOL_WIDTH = D_MODEL // 4
POOL_GROUP = POOL_WIDTH // 4
N_BRANCH = 4
D_FF = 4 * D_MODEL
EPS = 1e-6
N_IN = Q_RANK + KV_RANK + QK_ROPE_DIM + 2 * SG_WIDTH + 3 * CONV_WIDTH + POOL_WIDTH + N_BRANCH * D_MODEL

kernel_name = 'hybrid_gated_mla_sgmlp_conv_pool_block'


def rmsnorm(x, g):
    xf = x.astype(jnp.float32)
    y = xf * lax.rsqrt(jnp.mean(xf * xf, axis=-1, keepdims=True) + EPS)
    return (y * g.astype(jnp.float32)).astype(x.dtype)


def layernorm(x, g, b):
    xf = x.astype(jnp.float32)
    mu = jnp.mean(xf, axis=-1, keepdims=True)
    xc = xf - mu
    y = xc * lax.rsqrt(jnp.mean(xc * xc, axis=-1, keepdims=True) + EPS)
    return (y * g.astype(jnp.float32) + b.astype(jnp.float32)).astype(x.dtype)


def split_cols(proj):
    sizes = (Q_RANK, KV_RANK, QK_ROPE_DIM, SG_WIDTH, SG_WIDTH, CONV_WIDTH, CONV_WIDTH, CONV_WIDTH,
             POOL_WIDTH, N_BRANCH * D_MODEL)
    offs = []
    acc = 0
    for s in sizes[:-1]:
        acc += s
        offs.append(acc)
    return jnp.split(proj, offs, axis=-1)


def rope(x, cos, sin):
    x1, x2 = jnp.split(x, 2, axis=-1)
    return jnp.concatenate([x1 * cos - x2 * sin, x2 * cos + x1 * sin], axis=-1)


def mla(c_q, c_kv, k_rope, positions, q_norm, w_uq, kv_norm, w_ukv):
    B_, S_, _ = c_q.shape
    q = (rmsnorm(c_q, q_norm) @ w_uq).reshape(B_, S_, MLA_HEADS, QK_NOPE_DIM + QK_ROPE_DIM)
    q_nope, q_rope = q[..., :QK_NOPE_DIM], q[..., QK_NOPE_DIM:]
    kv = (rmsnorm(c_kv, kv_norm) @ w_ukv).reshape(B_, S_, MLA_HEADS, QK_NOPE_DIM + V_HEAD_DIM)
    k_nope, v = kv[..., :QK_NOPE_DIM], kv[..., QK_NOPE_DIM:]
    inv_freq = ROPE_BASE ** (-jnp.arange(0, QK_ROPE_DIM, 2, dtype=jnp.float32) / QK_ROPE_DIM)
    ang = positions.astype(jnp.float32)[..., None] * inv_freq
    cos = jnp.cos(ang).astype(q.dtype)
    sin = jnp.sin(ang).astype(q.dtype)
    q_rope = rope(q_rope, cos[:, :, None, :], sin[:, :, None, :])
    k_rope = rope(k_rope, cos, sin)
    scale = (QK_NOPE_DIM + QK_ROPE_DIM) ** -0.5
    nb = S_ // Q_BLOCK

    def to_blocks(a):
        return jnp.moveaxis(a.reshape((B_, nb, Q_BLOCK) + a.shape[2:]), 1, 0)

    k_idx = jnp.arange(S_)

    def block(args):
        qn, qr, start = args
        s = jnp.einsum('bqhd,bkhd->bhqk', qn, k_nope) + jnp.einsum('bqhr,bkr->bhqk', qr, k_rope)
        s = s.astype(jnp.float32) * scale
        q_idx = start + jnp.arange(Q_BLOCK)
        s = jnp.where(k_idx[None, :] <= q_idx[:, None], s, -jnp.inf)
        p = jax.nn.softmax(s, axis=-1).astype(v.dtype)
        return jnp.einsum('bhqk,bkhd->bqhd', p, v)

    starts = jnp.arange(nb, dtype=jnp.int32) * Q_BLOCK
    o = lax.map(block, (to_blocks(q_nope), to_blocks(q_rope), starts))
    return jnp.moveaxis(o, 0, 1).reshape(B_, S_, MLA_HEADS * V_HEAD_DIM)


def spatial_gating(u, v, ln_g, ln_b, w_s, b_s):
    B_, S_, _ = u.shape
    u = jax.nn.gelu(u)
    v = layernorm(jax.nn.gelu(v), ln_g, ln_b)
    n = S_ // SG_CHUNK
    vc = v.reshape(B_, n, SG_CHUNK, SG_GROUPS, SG_WIDTH // SG_GROUPS)
    mask = jnp.tril(jnp.ones((SG_CHUNK, SG_CHUNK), dtype=bool))
    w = jnp.where(mask, w_s, 0)
    s = jnp.einsum('gts,bnsgc->bntgc', w, vc) + b_s.T[:, :, None]
    return u * s.reshape(B_, S_, SG_WIDTH)


def short_conv(xin, bg, cg, conv_w):
    z = cg * xin
    S_ = z.shape[1]
    zp = jnp.pad(z, ((0, 0), (CONV_K - 1, 0), (0, 0)))
    y = sum(conv_w[k] * zp[:, k:k + S_] for k in range(CONV_K))
    return bg * y


def multiscale_pool(p, w_pool, scale):
    B_, S_, _ = p.shape
    pg = p.reshape(B_, S_, len(POOL_WINDOWS), POOL_GROUP).astype(jnp.float32)
    cs = jnp.cumsum(pg, axis=1)
    t = jnp.arange(S_)
    outs = []
    for g, win in enumerate(POOL_WINDOWS):
        c = cs[:, :, g]
        lagged = jnp.pad(c, ((0, 0), (win, 0), (0, 0)))[:, :S_]
        cnt = jnp.minimum(t + 1, win).astype(jnp.float32)[None, :, None]
        outs.append((c - lagged) / cnt - pg[:, :, g])
    pooled = jnp.stack(outs, axis=2).astype(p.dtype)
    mixed = jnp.einsum('bsgc,gcd->bsgd', pooled, w_pool)
    return mixed.reshape(B_, S_, POOL_WIDTH) * scale


def setup_inputs(seed: int = 0) -> dict:
    key = jax.random.key(seed)
    ks = jax.random.split(key, 26)
    L = DEPTH

    def nrm(k, shape, fan_in):
        return jax.random.normal(k, shape, jnp.float32) * fan_in ** -0.5

    def gain(k, shape):
        return 1.0 + 0.05 * jax.random.normal(k, shape, jnp.float32)

    def small(k, shape, s):
        return s * jax.random.normal(k, shape, jnp.float32)

    x = jax.random.normal(ks[0], (BATCH, SEQ, D_MODEL), jnp.float32)
    positions = (jax.random.randint(ks[1], (BATCH, 1), 0, 4096, dtype=jnp.int32)
                 + jnp.arange(SEQ, dtype=jnp.int32)[None, :])
    return {
        'x': x,
        'positions': positions,
        'norm_mix_pre': gain(ks[2], (L, D_MODEL)),
        'w_in': nrm(ks[3], (L, D_MODEL, N_IN), D_MODEL),
        'gate_b': small(ks[4], (L, N_BRANCH * D_MODEL), 0.01),
        'q_norm': gain(ks[5], (L, Q_RANK)),
        'w_uq': nrm(ks[6], (L, Q_RANK, MLA_HEADS * (QK_NOPE_DIM + QK_ROPE_DIM)), Q_RANK),
        'kv_norm': gain(ks[7], (L, KV_RANK)),
        'w_ukv': nrm(ks[8], (L, KV_RANK, MLA_HEADS * (QK_NOPE_DIM + V_HEAD_DIM)), KV_RANK),
        'w_br_mla': nrm(ks[9], (L, MLA_HEADS * V_HEAD_DIM, D_MODEL), MLA_HEADS * V_HEAD_DIM),
        'sg_ln_g': gain(ks[10], (L, SG_WIDTH)),
        'sg_ln_b': small(ks[11], (L, SG_WIDTH), 0.02),
        'sg_w': nrm(ks[12], (L, SG_GROUPS, SG_CHUNK, SG_CHUNK), SG_CHUNK),
        'sg_b': gain(ks[13], (L, SG_GROUPS, SG_CHUNK)),
        'w_br_sg': nrm(ks[14], (L, SG_WIDTH, D_MODEL), SG_WIDTH),
        'conv_w': nrm(ks[15], (L, CONV_K, CONV_WIDTH), CONV_K),
        'w_br_conv': nrm(ks[16], (L, CONV_WIDTH, D_MODEL), CONV_WIDTH),
        'pool_w': nrm(ks[17], (L, len(POOL_WINDOWS), POOL_GROUP, POOL_GROUP), POOL_GROUP),
        'pool_scale': gain(ks[18], (L, POOL_WIDTH)),
        'w_br_pool': nrm(ks[19], (L, POOL_WIDTH, D_MODEL), POOL_WIDTH),
        'w_out': nrm(ks[20], (L, D_MODEL, D_MODEL), D_MODEL),
        'norm_mix_post': gain(ks[21], (L, D_MODEL)),
        'norm_ffn_pre': gain(ks[22], (L, D_MODEL)),
        'w_ff1': nrm(ks[23], (L, D_MODEL, D_FF), D_MODEL),
        'w_ff2': nrm(ks[24], (L, D_FF, D_MODEL), D_FF),
        'norm_ffn_post': gain(ks[25], (L, D_MODEL)),
    }


def reference(x, positions, norm_mix_pre, w_in, gate_b, q_norm, w_uq, kv_norm, w_ukv, w_br_mla,
              sg_ln_g, sg_ln_b, sg_w, sg_b, w_br_sg, conv_w, w_br_conv, pool_w, pool_scale, w_br_pool,
              w_out, norm_mix_post, norm_ffn_pre, w_ff1, w_ff2, norm_ffn_post):
    B_, S_, D_ = x.shape
    for l in range(DEPTH):
        h = rmsnorm(x, norm_mix_pre[l])
        (c_q, c_kv, k_r, sg_u, sg_v, cv_x, cv_b, cv_c, pool_in, gate_pre) = split_cols(h @ w_in[l])
        gates = jax.nn.sigmoid(gate_pre + gate_b[l]).reshape(B_, S_, N_BRANCH, D_)
        y_a = mla(c_q, c_kv, k_r, positions, q_norm[l], w_uq[l], kv_norm[l], w_ukv[l]) @ w_br_mla[l]
        y_b = spatial_gating(sg_u, sg_v, sg_ln_g[l], sg_ln_b[l], sg_w[l], sg_b[l]) @ w_br_sg[l]
        y_c = short_conv(cv_x, cv_b, cv_c, conv_w[l]) @ w_br_conv[l]
        y_d = multiscale_pool(pool_in, pool_w[l], pool_scale[l]) @ w_br_pool[l]
        merged = (gates[:, :, 0] * y_a + gates[:, :, 1] * y_b
                  + gates[:, :, 2] * y_c + gates[:, :, 3] * y_d)
        x = x + rmsnorm(merged @ w_out[l], norm_mix_post[l])
        h = rmsnorm(x, norm_ffn_pre[l])
        f = jnp.square(jax.nn.relu(h @ w_ff1[l])) @ w_ff2[l]
        x = x + rmsnorm(f, norm_ffn_post[l])
    return x
```

```cpp
#include <hip/hip_runtime.h>
#include <hip/hip_cooperative_groups.h>
#include <cstdio>
#include <cstdint>
namespace cg = cooperative_groups;

#define LAS __attribute__((address_space(3)))
typedef unsigned short bf16_t;
typedef short bf16x8 __attribute__((ext_vector_type(8)));
typedef short s16x4 __attribute__((ext_vector_type(4)));
typedef float f32x4 __attribute__((ext_vector_type(4)));
typedef float f32x2 __attribute__((ext_vector_type(2)));
typedef float f32x16 __attribute__((ext_vector_type(16)));
typedef unsigned u32x4 __attribute__((ext_vector_type(4)));
typedef unsigned u32x2 __attribute__((ext_vector_type(2)));

__device__ __forceinline__ unsigned f2bf(float f) { unsigned u = __builtin_bit_cast(unsigned, f); return (u + 0x7fffu + ((u >> 16) & 1u)) >> 16; }
__device__ __forceinline__ unsigned pk2(float lo, float hi) { return f2bf(lo) | (f2bf(hi) << 16); }
__device__ __forceinline__ float bflo(unsigned w) { return __builtin_bit_cast(float, w << 16); }
__device__ __forceinline__ float bfhi(unsigned w) { return __builtin_bit_cast(float, w & 0xffff0000u); }
__device__ __forceinline__ float bf2f(bf16_t h) { return __builtin_bit_cast(float, ((unsigned)h) << 16); }
__device__ __forceinline__ float wave_sum(float v) {
#pragma unroll
    for (int o = 1; o < 64; o <<= 1) v += __shfl_xor(v, o);
    return v;
}
__device__ __forceinline__ float fast_sigmoid(float v) { return __builtin_amdgcn_rcpf(1.0f + __builtin_amdgcn_exp2f(-1.4426950408889634f * v)); }
__device__ __forceinline__ float gelu_tanh(float x) { const float u = 0.7978845608028654f * (x + 0.044715f * x * x * x); return x * fast_sigmoid(2.0f * u); }

namespace pg8 {
#define PG8_LAS __attribute__((address_space(3)))
constexpr int BM = 256, BK = 64, HALF = 128, HTB = HALF * BK * 2  , STAGE_BYTES = 8 * HTB, NXCD = 8, WGM = 8;

__host__ __device__ __forceinline__ int lds_byte(int r, int c) { const int st = (r >> 4) * 2 + (c >> 5), rr = r & 15, cc = c & 31, ob = rr * 64 + cc * 2; return st * 1024 + (ob ^ (((ob >> 9) & 1) << 5)); }
__host__ __device__ __forceinline__ void stage_rc(int b, int& R, int& C) { const int st = b / 1024, sb = b % 1024, swz = sb ^ (((sb >> 9) & 1) << 5); R = (st >> 1) * 16 + swz / 64; C = (st & 1) * 32 + (swz % 64) / 2; }
__host__ __device__ __forceinline__ int perm32(int rho) { const int n = rho >> 4, i = rho & 15; return 8 * (i >> 2) + 4 * n + (i & 3); }

struct Unit { int pm, pn, bn, ak, z; };
struct Gemm { const bf16_t* A; const bf16_t* Bt; int M, N, K, lda, ldb; };

struct StaticOrder {
    int nM, nN, nwg, G, c;
    __host__ __device__ void init(int M, int N, int G_, int c_) { nM = M / BM; nN = N / BM; nwg = nM * nN; G = G_; c = c_; }
    __host__ __device__ bool map(long L, Unit& u) const {
        if (L >= nwg) return false;
        int wgid = (int)L; { const int q = nwg / NXCD, r = nwg % NXCD, xcd = wgid % NXCD, off = wgid / NXCD; wgid = (xcd < r ? xcd * (q + 1) : r * (q + 1) + (xcd - r) * q) + off; }
        const int nig = WGM * nN, gid = wgid / nig, fm = gid * WGM, gsz = (nM - fm) < WGM ? (nM - fm) : WGM;
        u.pm = fm + ((wgid % nig) % gsz); u.pn = (wgid % nig) / gsz; return true;
    }
    __host__ __device__ bool next(int i, Unit& u) const { u.ak = 0; u.z = 0; const bool ok = map((long)i * G + c, u); u.bn = u.pn; return ok; }
    __device__ __forceinline__ void a_ready(const Unit&) const {}
    __device__ __forceinline__ void done(const Unit&) const {}
};
struct MergeOrder {
    StaticOrder S; int nbr;
    __host__ __device__ void init(int M, int N, int G_, int c_, int nbr_) { S.init(M, N, G_, c_); nbr = nbr_; }
    __host__ __device__ bool next(int i, Unit& u) const { const int z = i % nbr; const bool ok = S.map((long)(i / nbr) * S.G + S.c, u); u.z = z; u.ak = z * 256; u.bn = z * S.nN + u.pn; return ok; }
    __device__ __forceinline__ void a_ready(const Unit&) const {}
    __device__ __forceinline__ void done(const Unit&) const {}
};

__device__ __forceinline__ unsigned cvt_pk_bf16(float lo, float hi) { unsigned r; asm volatile("v_cvt_pk_bf16_f32 %0, %1, %2" : "=v"(r) : "v"(lo), "v"(hi)); return r; }

struct EpiRT {
    static constexpr bool PERM = true, AFTER_DRAIN = false;
    bf16_t* O; int ldc; const float* rs; const float* bias; const bf16_t* gates; int mode;
    __device__ __forceinline__ void operator()(const f32x4 (&acc)[2][2][4][2], const Unit& u, int wr, int wc, int fr, int fq) const {
        const int row0 = u.pm * BM + wr * 64 + fr; const int col0 = u.pn * BM + wc * 32 + 8 * fq;
        const int m_eff = (mode == 1) ? ((u.pn == 2 || u.pn == 3) ? 1 : 0) : mode;
#pragma unroll
        for (int ai = 0; ai < 2; ++ai)
#pragma unroll
            for (int m = 0; m < 4; ++m) { const int row = row0 + ai * HALF + m * 16; bf16_t* rowp = O + (size_t)row * ldc + col0;
                const float sc = rs ? rs[row] : 1.0f;
#pragma unroll
                for (int bj = 0; bj < 2; ++bj) { f32x4 v0 = acc[ai][bj][m][0] * sc, v1 = acc[ai][bj][m][1] * sc;
                    if (m_eff == 1) {
#pragma unroll
                        for (int e = 0; e < 4; ++e) { v0[e] = gelu_tanh(v0[e]); v1[e] = gelu_tanh(v1[e]); }
                    } else if (m_eff == 2) { v0 = v0 + *(const f32x4*)(bias + col0 + bj * HALF); v1 = v1 + *(const f32x4*)(bias + col0 + bj * HALF + 4);
#pragma unroll
                        for (int e = 0; e < 4; ++e) { v0[e] = fast_sigmoid(v0[e]); v1[e] = fast_sigmoid(v1[e]); }
                    } else if (m_eff == 3) {
#pragma unroll
                        for (int e = 0; e < 4; ++e) { const float a = fmaxf(v0[e], 0.f), b = fmaxf(v1[e], 0.f); v0[e] = a * a; v1[e] = b * b; }
                    } else if (m_eff == 4) { const u32x4 gw = *(const u32x4*)(gates + (size_t)row * 4096 + u.z * 1024 + col0 + bj * HALF);
                        v0[0] *= bflo(gw.x); v0[1] *= bfhi(gw.x); v0[2] *= bflo(gw.y); v0[3] *= bfhi(gw.y);
                        v1[0] *= bflo(gw.z); v1[1] *= bfhi(gw.z); v1[2] *= bflo(gw.w); v1[3] *= bfhi(gw.w);
                        if (u.z != 0) { const u32x4 ow = *(const u32x4*)(rowp + bj * HALF);
                            v0[0] += bflo(ow.x); v0[1] += bfhi(ow.x); v0[2] += bflo(ow.y); v0[3] += bfhi(ow.y);
                            v1[0] += bflo(ow.z); v1[1] += bfhi(ow.z); v1[2] += bflo(ow.w); v1[3] += bfhi(ow.w); } }
                    u32x4 w; w.x = cvt_pk_bf16(v0[0], v0[1]); w.y = cvt_pk_bf16(v0[2], v0[3]); w.z = cvt_pk_bf16(v1[0], v1[1]); w.w = cvt_pk_bf16(v1[2], v1[3]);
                    *(u32x4*)(rowp + bj * HALF) = w; } }
    }
};

template <class Epi, class Sched, bool ALIGN_EPI = false, bool SP2 = false>
__device__ __forceinline__ void gemm_phase(PG8_LAS unsigned char* lds, const Gemm g, const Sched& S, const Epi& E, const int tid) {
    const int wid = __builtin_amdgcn_readfirstlane(tid >> 6), lane = tid & 63, wr = wid >> 2, wc = wid & 3, fr = lane & 15, fq = lane >> 4;
    const int K = g.K, nt = K / BK;
    unsigned voffA[2], voffB[2];
#pragma unroll
    for (int i = 0; i < 2; ++i) { int R, C; stage_rc(tid * 16 + i * 8192, R, C); const int Rb = Epi::PERM ? ((R & ~31) + perm32(R & 31)) : R;
        voffA[i] = (unsigned)(R * g.lda + C) * 2u; voffB[i] = (unsigned)(Rb * g.ldb + C) * 2u; }
    const size_t kstep = (size_t)(BK * 2);
    const size_t hstepA = (size_t)HALF * g.lda * 2, hstepB = (size_t)HALF * g.ldb * 2;
    const size_t tstepA = 2 * hstepA, tstepB = 2 * hstepB;
    const unsigned ldsw = (unsigned)wid * 1024u;
    const int aoff = lds_byte(wr * 64 + fr, fq * 8), boff = lds_byte(wc * 32 + fr, fq * 8);
#define PG8_SA(b, h) (((b) * 2 + (h)) * HTB)
#define PG8_SB(b, h) ((4 + (b) * 2 + (h)) * HTB)
#define PG8_STAGE(bufoff, gbase, voff) do { _Pragma("unroll") for (int _i = 0; _i < 2; ++_i) \
        __builtin_amdgcn_global_load_lds((const unsigned*)((const char*)(gbase) + (voff)[_i]), (PG8_LAS unsigned*)(lds + (bufoff) + ldsw + _i * 8192), 16, 0, 0); } while (0)
#define PG8_LDA(dst, b, h) do { _Pragma("unroll") for (int m = 0; m < 4; ++m) _Pragma("unroll") for (int k = 0; k < 2; ++k) dst[m][k] = *(const PG8_LAS bf16x8*)(lds + PG8_SA(b, h) + aoff + m * 2048 + k * 1024); } while (0)
#define PG8_LDB(dst, b, h) do { _Pragma("unroll") for (int n = 0; n < 2; ++n) _Pragma("unroll") for (int k = 0; k < 2; ++k) dst[n][k] = *(const PG8_LAS bf16x8*)(lds + PG8_SB(b, h) + boff + n * 2048 + k * 1024); } while (0)
#define PG8_MMA(ai, bj, At, Bt) do { __builtin_amdgcn_s_setprio(1); _Pragma("unroll") for (int m = 0; m < 4; ++m) _Pragma("unroll") for (int n = 0; n < 2; ++n) _Pragma("unroll") for (int k = 0; k < 2; ++k) \
        acc[ai][bj][m][n] = __builtin_amdgcn_mfma_f32_16x16x32_bf16(Bt[n][k], At[m][k], acc[ai][bj][m][n], 0, 0, 0); __builtin_amdgcn_s_setprio(0); } while (0)
#define PG8_WAIT_V(n) asm volatile("s_waitcnt vmcnt(" #n ")" ::: "memory")
#define PG8_WAIT_L(n) asm volatile("s_waitcnt lgkmcnt(" #n ")" ::: "memory")
#define PG8_BAR __builtin_amdgcn_s_barrier()
#define PG8_SCHED __builtin_amdgcn_sched_barrier(0)
    Unit cur, nxt; int ui = 0;
    if (!S.next(0, cur)) return;
    f32x4 acc[2][2][4][2];
#pragma unroll
    for (int a = 0; a < 2; ++a)
#pragma unroll
        for (int b = 0; b < 2; ++b)
#pragma unroll
            for (int m = 0; m < 4; ++m)
#pragma unroll
                for (int n = 0; n < 2; ++n) acc[a][b][m][n] = (f32x4){0.f, 0.f, 0.f, 0.f};
    bf16x8 At[4][2], B0[2][2], B1[2][2];
    const char* cA = (const char*)g.A + (size_t)cur.pm * tstepA + (size_t)cur.ak * 2; const char* cB = (const char*)g.Bt + (size_t)cur.bn * tstepB;
    S.a_ready(cur);
    if constexpr (SP2) {
        PG8_STAGE(PG8_SB(0, 0), cB, voffB); PG8_STAGE(PG8_SB(0, 1), cB + hstepB, voffB); PG8_STAGE(PG8_SA(0, 0), cA, voffA); PG8_STAGE(PG8_SA(0, 1), cA + hstepA, voffA);
        if (wr == 1) PG8_BAR;
        PG8_WAIT_V(2); PG8_BAR;
        PG8_STAGE(PG8_SB(1, 0), cB + kstep, voffB); PG8_STAGE(PG8_SA(1, 0), cA + kstep, voffA); PG8_STAGE(PG8_SB(1, 1), cB + hstepB + kstep, voffB);
        PG8_WAIT_V(6); PG8_BAR;
    } else {
        PG8_STAGE(PG8_SB(0, 0), cB, voffB); PG8_STAGE(PG8_SA(0, 0), cA, voffA); PG8_STAGE(PG8_SB(0, 1), cB + hstepB, voffB); PG8_STAGE(PG8_SA(0, 1), cA + hstepA, voffA);
        if (wr == 1) PG8_BAR;
        PG8_WAIT_V(4); PG8_BAR;
        PG8_STAGE(PG8_SB(1, 0), cB + kstep, voffB); PG8_STAGE(PG8_SA(1, 0), cA + kstep, voffA); PG8_STAGE(PG8_SB(1, 1), cB + hstepB + kstep, voffB);
        PG8_WAIT_V(6); PG8_BAR;
    }
    for (;;) {
        const bool has_next = S.next(ui + 1, nxt);
        const char* nA = has_next ? (const char*)g.A + (size_t)nxt.pm * tstepA + (size_t)nxt.ak * 2 : cA; const char* nB = has_next ? (const char*)g.Bt + (size_t)nxt.bn * tstepB : cB;
        for (int t = 0; t < nt; t += 2) {
            const bool last = (t == nt - 2);
            const char* a1 = cA + (size_t)(t + 1) * kstep;
            const char* a2 = last ? nA : cA + (size_t)(t + 2) * kstep; const char* b2 = last ? nB : cB + (size_t)(t + 2) * kstep;
            const char* a3 = a2 + kstep; const char* b3 = b2 + kstep;
            if (last && has_next) S.a_ready(nxt);
            if constexpr (SP2) {
            PG8_LDB(B0, 0, 0); PG8_LDB(B1, 0, 1); PG8_SCHED; PG8_LDA(At, 0, 0); PG8_STAGE(PG8_SA(1, 1), a1 + hstepA, voffA);
            PG8_WAIT_V(8); PG8_WAIT_L(0); PG8_BAR; PG8_MMA(0, 0, At, B0); PG8_MMA(0, 1, At, B1); PG8_BAR; PG8_SCHED;
            PG8_LDA(At, 0, 1); PG8_STAGE(PG8_SB(0, 0), b2, voffB); PG8_STAGE(PG8_SB(0, 1), b2 + hstepB, voffB); PG8_STAGE(PG8_SA(0, 0), a2, voffA);
            PG8_WAIT_V(8); PG8_WAIT_L(0); PG8_BAR; PG8_MMA(1, 0, At, B0); PG8_MMA(1, 1, At, B1); PG8_BAR; PG8_SCHED;
            PG8_LDB(B0, 1, 0); PG8_LDB(B1, 1, 1); PG8_SCHED; PG8_LDA(At, 1, 0); PG8_STAGE(PG8_SA(0, 1), a2 + hstepA, voffA);
            PG8_WAIT_V(8); PG8_WAIT_L(0); PG8_BAR; PG8_MMA(0, 0, At, B0); PG8_MMA(0, 1, At, B1); PG8_BAR; PG8_SCHED;
            PG8_LDA(At, 1, 1); PG8_STAGE(PG8_SB(1, 0), b3, voffB); PG8_STAGE(PG8_SB(1, 1), b3 + hstepB, voffB); PG8_STAGE(PG8_SA(1, 0), a3, voffA);
            PG8_WAIT_V(8); PG8_WAIT_L(0); PG8_BAR; PG8_MMA(1, 0, At, B0); PG8_MMA(1, 1, At, B1); PG8_BAR; PG8_SCHED;
            } else {
            PG8_LDB(B0, 0, 0); PG8_SCHED; PG8_LDA(At, 0, 0); PG8_STAGE(PG8_SA(1, 1), a1 + hstepA, voffA);
            PG8_WAIT_L(8); PG8_BAR; PG8_WAIT_L(0); PG8_MMA(0, 0, At, B0); PG8_BAR; PG8_SCHED;
            PG8_LDB(B1, 0, 1); PG8_STAGE(PG8_SB(0, 0), b2, voffB);
            PG8_BAR; PG8_WAIT_L(0); PG8_MMA(0, 1, At, B1); PG8_BAR;
            PG8_LDA(At, 0, 1); PG8_STAGE(PG8_SA(0, 0), a2, voffA);
            PG8_BAR; PG8_WAIT_L(0); PG8_MMA(1, 0, At, B0); PG8_BAR; PG8_SCHED;
            PG8_STAGE(PG8_SB(0, 1), b2 + hstepB, voffB);
            PG8_WAIT_V(6); PG8_BAR; PG8_MMA(1, 1, At, B1); PG8_BAR;
            PG8_LDB(B0, 1, 0); PG8_SCHED; PG8_LDA(At, 1, 0); PG8_STAGE(PG8_SA(0, 1), a2 + hstepA, voffA);
            PG8_WAIT_L(8); PG8_BAR; PG8_WAIT_L(0); PG8_MMA(0, 0, At, B0); PG8_BAR; PG8_SCHED;
            PG8_LDB(B1, 1, 1); PG8_STAGE(PG8_SB(1, 0), b3, voffB);
            PG8_BAR; PG8_WAIT_L(0); PG8_MMA(0, 1, At, B1); PG8_BAR;
            PG8_LDA(At, 1, 1); PG8_STAGE(PG8_SA(1, 0), a3, voffA);
            PG8_BAR; PG8_WAIT_L(0); PG8_MMA(1, 0, At, B0); PG8_BAR; PG8_SCHED;
            PG8_STAGE(PG8_SB(1, 1), b3 + hstepB, voffB);
            PG8_WAIT_V(6); PG8_BAR; PG8_MMA(1, 1, At, B1); PG8_BAR;
            }
        }
        if constexpr (ALIGN_EPI) { if (wr == 0) PG8_BAR; }
        if constexpr (!Epi::AFTER_DRAIN) { E(acc, cur, wr, wc, fr, fq); S.done(cur); }
        if (!has_next) break;
#pragma unroll
        for (int a = 0; a < 2; ++a)
#pragma unroll
            for (int b = 0; b < 2; ++b)
#pragma unroll
                for (int m = 0; m < 4; ++m)
#pragma unroll
                    for (int n = 0; n < 2; ++n) acc[a][b][m][n] = (f32x4){0.f, 0.f, 0.f, 0.f};
        cur = nxt; cA = nA; cB = nB; ++ui;
        if constexpr (ALIGN_EPI) { if (wr == 1) PG8_BAR; }
    }
    PG8_WAIT_V(0);
    if constexpr (!ALIGN_EPI) { if (wr == 0) PG8_BAR; }
    PG8_BAR;
    if constexpr (Epi::AFTER_DRAIN) { E.fused(acc, cur, wr, wc, fr, fq, lds, wid, lane); S.done(cur); }
#undef PG8_SA
#undef PG8_SB
#undef PG8_STAGE
#undef PG8_LDA
#undef PG8_LDB
#undef PG8_MMA
#undef PG8_WAIT_V
#undef PG8_WAIT_L
#undef PG8_BAR
#undef PG8_SCHED
}
}

constexpr int MTOK = 32768, DM = 1024, SEQ = 8192, NLAYER = 4, NIN = 6048, DFF = 4096;
constexpr float EPS = 1e-6f;
constexpr float QSCALE = 0.10206207261596575f * 1.4426950408889634f;
constexpr size_t MiB = 1u << 20;
constexpr size_t WS_RS = 1 * MiB, WS_ROPEC = 2 * MiB, WS_ROPES = 4 * MiB;
constexpr size_t WS_WIN = 6 * MiB, WS_WUQ = 18 * MiB, WS_WK = WS_WUQ + 256 * 1024, WS_WV = WS_WK + 64 * 1024, WS_SGW = WS_WUQ + 512 * 1024;
constexpr size_t WS_WBR = 19 * MiB, WS_WOUT = 21 * MiB, WS_W1 = 23 * MiB, WS_W2 = 31 * MiB;
constexpr size_t WS_XBF = 40 * MiB;
constexpr size_t WS_BR = 104 * MiB;
constexpr size_t WS_BIG = 168 * MiB;
constexpr size_t WS_PROJ = WS_BIG, WS_CQN = WS_BIG + 128 * MiB, WS_CKVN = WS_BIG + 144 * MiB, WS_KR = WS_BIG + 152 * MiB, WS_Q = WS_BIG + 154 * MiB, WS_KN = WS_BIG + 186 * MiB, WS_VT = WS_BIG + 202 * MiB;
constexpr size_t WS_END = 424 * MiB;
constexpr int LDS_BYTES = 147456;

struct Args { const float* in[26]; float* out; unsigned char* ws; int lo, hi; };
enum { I_X = 0, I_POS, I_NPRE, I_WIN, I_GATEB, I_QN, I_WUQ, I_KVN, I_WUKV, I_WBRMLA, I_LNG, I_LNB, I_SGW, I_SGB, I_WBRSG, I_CONVW, I_WBRCONV, I_POOLW, I_POOLS, I_WBRPOOL, I_WOUT, I_NPOST, I_NFPRE, I_WFF1, I_WFF2, I_NFPOST };

__device__ __forceinline__ int crow(int r, int hi) { return (r & 3) + 8 * (r >> 2) + 4 * hi; }
#define MFMA32(a, b, c) __builtin_amdgcn_mfma_f32_32x32x16_bf16((a), (b), (c), 0, 0, 0)

__device__ __forceinline__ void tr_item(const float* __restrict__ W, int ldw, int k0, int srcn0, const float* __restrict__ gk, float mul, bf16_t* WT, int ldt, int dstn0, LAS float* scr, int lane) {
#pragma unroll 8
    for (int i = 0; i < 32; ++i) { const int kk = 2 * i + (lane >> 5); float v = 0.f;
        if (srcn0 >= 0) { v = W[(size_t)(k0 + kk) * ldw + srcn0 + (lane & 31)] * mul; if (gk) v *= gk[k0 + kk]; }
        scr[kk * 33 + (lane & 31)] = v; }
    asm volatile("s_waitcnt lgkmcnt(0)" ::: "memory");
    const int c = lane & 7;
#pragma unroll
    for (int j = 0; j < 4; ++j) { const int n = (lane >> 3) + 8 * j; const LAS float* s = scr + (8 * c) * 33 + n;
        u32x4 o; o.x = pk2(s[0 * 33], s[1 * 33]); o.y = pk2(s[2 * 33], s[3 * 33]); o.z = pk2(s[4 * 33], s[5 * 33]); o.w = pk2(s[6 * 33], s[7 * 33]);
        *(u32x4*)(WT + (size_t)(dstn0 + n) * ldt + k0 + 8 * c) = o; }
    asm volatile("s_waitcnt lgkmcnt(0)" ::: "memory");
}

__device__ __forceinline__ void prep_weights(const Args& a, int l, LAS unsigned char* lds, int tid) {
    const int lane = tid & 63, wave = tid >> 6, G = gridDim.x;
    LAS float* scr = (LAS float*)(lds + wave * 8448);
    const int gw = blockIdx.x * 8 + wave, NGW = G * 8;
    unsigned char* ws = a.ws;
    constexpr int N0 = 16 * 192, N1 = 4 * 16, N2 = 2 * 8, N3 = 2 * 8, N4 = 3 * 4 * 32, N5 = 16 * 32, N6 = 16 * 128, N7 = 64 * 32;
    constexpr int NITEMS = N0 + N1 + N2 + N3 + N4 + N5 + N6 + N7;
    for (int it = gw; it < NITEMS; it += NGW) {
        int r = it;
        if (r < N0) { const int kb = r / 192, nb = r % 192, d0 = nb * 32; const int src = d0 < 416 ? d0 : (d0 < 512 ? -1 : d0 - 96);
            tr_item(a.in[I_WIN] + (size_t)l * DM * NIN, NIN, kb * 64, src, a.in[I_NPRE] + l * DM, 1.f, (bf16_t*)(ws + WS_WIN), DM, d0, scr, lane); continue; } r -= N0;
        if (r < N1) { const int kb = r / 16, nb = r % 16;
            tr_item(a.in[I_WUQ] + (size_t)l * 256 * 384, 384, kb * 64, nb < 12 ? nb * 32 : -1, a.in[I_QN] + l * 256, QSCALE, (bf16_t*)(ws + WS_WUQ), 256, nb * 32, scr, lane); continue; } r -= N1;
        if (r < N2) { const int kb = r / 8, nb = r % 8;
            tr_item(a.in[I_WUKV] + (size_t)l * 128 * 512, 512, kb * 64, (nb >> 1) * 128 + (nb & 1) * 32, a.in[I_KVN] + l * 128, 1.f, (bf16_t*)(ws + WS_WK), 128, nb * 32, scr, lane); continue; } r -= N2;
        if (r < N3) { const int kb = r / 8, nb = r % 8;
            tr_item(a.in[I_WUKV] + (size_t)l * 128 * 512, 512, kb * 64, (nb >> 1) * 128 + 64 + (nb & 1) * 32, a.in[I_KVN] + l * 128, 1.f, (bf16_t*)(ws + WS_WV), 128, nb * 32, scr, lane); continue; } r -= N3;
        if (r < N4) { const int z = r / 128, rr = r % 128, kb = rr / 32, nb = rr % 32; const float* W = (z == 0 ? a.in[I_WBRMLA] : z == 1 ? a.in[I_WBRSG] : a.in[I_WBRCONV]) + (size_t)l * 256 * DM;
            tr_item(W, DM, kb * 64, nb * 32, nullptr, 1.f, (bf16_t*)(ws + WS_WBR) + (size_t)z * DM * 256, 256, nb * 32, scr, lane); continue; } r -= N4;
        if (r < N5) { const int kb = r / 32, nb = r % 32;
            tr_item(a.in[I_WOUT] + (size_t)l * DM * DM, DM, kb * 64, nb * 32, nullptr, 1.f, (bf16_t*)(ws + WS_WOUT), DM, nb * 32, scr, lane); continue; } r -= N5;
        if (r < N6) { const int kb = r / 128, nb = r % 128;
            tr_item(a.in[I_WFF1] + (size_t)l * DM * DFF, DFF, kb * 64, nb * 32, a.in[I_NFPRE] + l * DM, 1.f, (bf16_t*)(ws + WS_W1), DM, nb * 32, scr, lane); continue; } r -= N6;
        { const int kb = r / 32, nb = r % 32;
            tr_item(a.in[I_WFF2] + (size_t)l * DFF * DM, DM, kb * 64, nb * 32, nullptr, 1.f, (bf16_t*)(ws + WS_W2), DFF, nb * 32, scr, lane); }
    }
    const int gt = blockIdx.x * 512 + tid, NGT = G * 512;
    { const float* sw = a.in[I_SGW] + (size_t)l * 65536; bf16_t* o = (bf16_t*)(ws + WS_SGW);
      for (int i = gt; i < 65536; i += NGT) { const int t = (i >> 7) & 127, s = i & 127; o[i] = (bf16_t)f2bf(s <= t ? sw[i] : 0.f); } }
    { const float* wp = a.in[I_POOLW] + (size_t)l * 4 * 64 * 64; const float* sc = a.in[I_POOLS] + l * 256; const float* wb = a.in[I_WBRPOOL] + (size_t)l * 256 * DM;
      bf16_t* o = (bf16_t*)(ws + WS_WBR) + (size_t)3 * DM * 256;
      for (int i = gt; i < 256 * DM; i += NGT) { const int n = i & 1023, cp = i >> 10, g = cp >> 6, c = cp & 63; float acc = 0.f;
          for (int d = 0; d < 64; ++d) acc += wp[(g * 64 + c) * 64 + d] * sc[g * 64 + d] * wb[(size_t)(g * 64 + d) * DM + n];
          o[(size_t)n * 256 + cp] = (bf16_t)f2bf(acc); } }
}

__device__ __forceinline__ void phase_s0(const Args& a, LAS unsigned char* lds, int tid) {
    const int G = gridDim.x, gt = blockIdx.x * 512 + tid, NGT = G * 512;
    const int* pos = (const int*)a.in[I_POS];
    float* rc = (float*)(a.ws + WS_ROPEC); float* rsn = (float*)(a.ws + WS_ROPES);
    for (int i = gt; i < MTOK * 16; i += NGT) { const int tok = i >> 4, k = i & 15;
        const int k3 = k & 3, k2 = k >> 2;
        const double b = k3 == 0 ? 1.0 : k3 == 1 ? 0.5623413251903491 : k3 == 2 ? 0.31622776601683794 : 0.1778279410038923;
        const double p10 = k2 == 0 ? 1.0 : k2 == 1 ? 0.1 : k2 == 2 ? 0.01 : 0.001;
        const double rev = (double)pos[tok] * (b * p10) * 0.15915494309189535;
        const float fr = (float)(rev - __builtin_rint(rev));
        rc[i] = __builtin_amdgcn_cosf(fr); rsn[i] = __builtin_amdgcn_sinf(fr); }
    const int lane = tid & 63, wave = tid >> 6, gw = blockIdx.x * 8 + wave, NGW = G * 8;
    const float* x = a.in[I_X]; float* xo = a.out; bf16_t* xb = (bf16_t*)(a.ws + WS_XBF); float* rs = (float*)(a.ws + WS_RS);
    for (int row = gw; row < MTOK; row += NGW) {
        const float* xr = x + (size_t)row * DM + 8 * lane; float* xw = xo + (size_t)row * DM + 8 * lane; bf16_t* bw = xb + (size_t)row * DM + 8 * lane;
        float ss = 0.f;
#pragma unroll
        for (int j = 0; j < 2; ++j) { const f32x4 v0 = *(const f32x4*)(xr + 512 * j), v1 = *(const f32x4*)(xr + 512 * j + 4);
            ss += v0.x * v0.x + v0.y * v0.y + v0.z * v0.z + v0.w * v0.w + v1.x * v1.x + v1.y * v1.y + v1.z * v1.z + v1.w * v1.w;
            *(f32x4*)(xw + 512 * j) = v0; *(f32x4*)(xw + 512 * j + 4) = v1;
            u32x4 o; o.x = pk2(v0.x, v0.y); o.y = pk2(v0.z, v0.w); o.z = pk2(v1.x, v1.y); o.w = pk2(v1.z, v1.w); *(u32x4*)(bw + 512 * j) = o; }
        ss = wave_sum(ss);
        if (lane == 0) rs[row] = 1.0f / sqrtf(ss * (1.0f / DM) + EPS);
    }
}

__device__ __forceinline__ void phase_nr(const Args& a, const float* gpost, int tid) {
    const int G = gridDim.x, lane = tid & 63, wave = tid >> 6, gw = blockIdx.x * 8 + wave, NGW = G * 8;
    float* xo = a.out; bf16_t* xb = (bf16_t*)(a.ws + WS_XBF); float* rs = (float*)(a.ws + WS_RS); const bf16_t* y = (const bf16_t*)(a.ws + WS_BR);
    for (int row = gw; row < MTOK; row += NGW) {
        float* xw = xo + (size_t)row * DM + 8 * lane; bf16_t* bw = xb + (size_t)row * DM + 8 * lane; const bf16_t* yr = y + (size_t)row * DM + 8 * lane;
        float yv[2][8]; float ss = 0.f;
#pragma unroll
        for (int j = 0; j < 2; ++j) { const u32x4 w = *(const u32x4*)(yr + 512 * j);
            yv[j][0] = bflo(w.x); yv[j][1] = bfhi(w.x); yv[j][2] = bflo(w.y); yv[j][3] = bfhi(w.y); yv[j][4] = bflo(w.z); yv[j][5] = bfhi(w.z); yv[j][6] = bflo(w.w); yv[j][7] = bfhi(w.w);
#pragma unroll
            for (int e = 0; e < 8; ++e) ss += yv[j][e] * yv[j][e]; }
        ss = wave_sum(ss);
        const float ry = 1.0f / sqrtf(ss * (1.0f / DM) + EPS);
        float xs = 0.f; float xn[2][8];
#pragma unroll
        for (int j = 0; j < 2; ++j) { const f32x4 x0 = *(const f32x4*)(xw + 512 * j), x1 = *(const f32x4*)(xw + 512 * j + 4);
            const f32x4 g0 = *(const f32x4*)(gpost + 8 * lane + 512 * j), g1 = *(const f32x4*)(gpost + 8 * lane + 512 * j + 4);
#pragma unroll
            for (int e = 0; e < 4; ++e) { xn[j][e] = x0[e] + yv[j][e] * ry * g0[e]; xn[j][4 + e] = x1[e] + yv[j][4 + e] * ry * g1[e]; }
#pragma unroll
            for (int e = 0; e < 8; ++e) xs += xn[j][e] * xn[j][e];
            *(f32x4*)(xw + 512 * j) = (f32x4){xn[j][0], xn[j][1], xn[j][2], xn[j][3]}; *(f32x4*)(xw + 512 * j + 4) = (f32x4){xn[j][4], xn[j][5], xn[j][6], xn[j][7]};
            u32x4 o; o.x = pk2(xn[j][0], xn[j][1]); o.y = pk2(xn[j][2], xn[j][3]); o.z = pk2(xn[j][4], xn[j][5]); o.w = pk2(xn[j][6], xn[j][7]); *(u32x4*)(bw + 512 * j) = o; }
        xs = wave_sum(xs);
        if (lane == 0) rs[row] = 1.0f / sqrtf(xs * (1.0f / DM) + EPS);
    }
}

__device__ __forceinline__ void unpack8(const u32x4 w, float (&f)[8]) { f[0] = bflo(w.x); f[1] = bfhi(w.x); f[2] = bflo(w.y); f[3] = bfhi(w.y); f[4] = bflo(w.z); f[5] = bfhi(w.z); f[6] = bflo(w.w); f[7] = bfhi(w.w); }
__device__ __forceinline__ u32x4 pack8(const float (&f)[8]) { u32x4 o; o.x = pk2(f[0], f[1]); o.y = pk2(f[2], f[3]); o.z = pk2(f[4], f[5]); o.w = pk2(f[6], f[7]); return o; }

__device__ __forceinline__ void phase_e1(const Args& a, int l, LAS unsigned char* lds, int tid) {
    const int lane = tid & 63, wid = __builtin_amdgcn_readfirstlane(tid >> 6), r32 = lane & 31, hi = lane >> 5;
    unsigned char* ws = a.ws;
    const bf16_t* P = (const bf16_t*)(ws + WS_PROJ); bf16_t* CQN = (bf16_t*)(ws + WS_CQN); bf16_t* CKVN = (bf16_t*)(ws + WS_CKVN); bf16_t* KR = (bf16_t*)(ws + WS_KR);
    bf16_t* BR = (bf16_t*)(ws + WS_BR); const float* rc = (const float*)(ws + WS_ROPEC); const float* rsn = (const float*)(ws + WS_ROPES);
    const bf16_t* SGWB = (const bf16_t*)(ws + WS_SGW);
    const float* convw = a.in[I_CONVW] + l * 3 * 256; const float* lng = a.in[I_LNG] + l * 256; const float* lnb = a.in[I_LNB] + l * 256; const float* sgb = a.in[I_SGB] + l * 512;
    for (int tile = blockIdx.x; tile < MTOK / 128; tile += gridDim.x) {
        const int R0 = tile * 128, s0 = R0 & (SEQ - 1);
        for (int i = 0; i < 16; ++i) { const int row = R0 + wid * 16 + i; const bf16_t* pr = P + (size_t)row * 2048;
            const u32x2 cq = *(const u32x2*)(pr + 4 * lane); const float q0 = bflo(cq.x), q1 = bfhi(cq.x), q2 = bflo(cq.y), q3 = bfhi(cq.y);
            const unsigned ck = *(const unsigned*)(pr + 256 + 2 * lane); const float k0 = bflo(ck), k1 = bfhi(ck);
            const float sq = wave_sum(q0 * q0 + q1 * q1 + q2 * q2 + q3 * q3), sk = wave_sum(k0 * k0 + k1 * k1);
            const float rq = 1.0f / sqrtf(sq * (1.0f / 256.0f) + EPS), rk = 1.0f / sqrtf(sk * (1.0f / 128.0f) + EPS);
            u32x2 oq; oq.x = pk2(q0 * rq, q1 * rq); oq.y = pk2(q2 * rq, q3 * rq); *(u32x2*)(CQN + (size_t)row * 256 + 4 * lane) = oq;
            *(unsigned*)(CKVN + (size_t)row * 128 + 2 * lane) = pk2(k0 * rk, k1 * rk);
            if (lane < 16) { const float x1 = bf2f(pr[384 + lane]), x2 = bf2f(pr[400 + lane]); const float c = rc[(size_t)row * 16 + lane], s = rsn[(size_t)row * 16 + lane];
                KR[(size_t)row * 32 + lane] = (bf16_t)f2bf(x1 * c - x2 * s); KR[(size_t)row * 32 + 16 + lane] = (bf16_t)f2bf(x2 * c + x1 * s); } }
        for (int it = 0; it < 8; ++it) { const int id = it * 512 + tid, ch = id & 31, t = id >> 5, row = R0 + t, s = s0 + t; const bf16_t* pr = P + (size_t)row * 2048 + 8 * ch;
            { float bg[8], y[8]; unpack8(*(const u32x4*)(pr + 1280), bg);
#pragma unroll
              for (int e = 0; e < 8; ++e) y[e] = 0.f;
#pragma unroll
              for (int k = 0; k < 3; ++k) { const int dt = k - 2; if (s + dt >= 0) { float xv[8], cv[8]; unpack8(*(const u32x4*)(pr + dt * 2048 + 1024), xv); unpack8(*(const u32x4*)(pr + dt * 2048 + 1536), cv);
                      const f32x4 w0 = *(const f32x4*)(convw + k * 256 + 8 * ch), w1 = *(const f32x4*)(convw + k * 256 + 8 * ch + 4);
#pragma unroll
                      for (int e = 0; e < 4; ++e) { y[e] += w0[e] * (xv[e] * cv[e]); y[4 + e] += w1[e] * (xv[4 + e] * cv[4 + e]); } } }
#pragma unroll
              for (int e = 0; e < 8; ++e) y[e] *= bg[e];
              *(u32x4*)(BR + (size_t)row * DM + 512 + 8 * ch) = pack8(y); }
            { const int g = ch >> 3, win = 2 << g; float acc[8], pt[8]; unpack8(*(const u32x4*)(pr + 1792), pt);
#pragma unroll
              for (int e = 0; e < 8; ++e) acc[e] = pt[e];
              const int cnt = (s + 1) < win ? (s + 1) : win;
              for (int i = 1; i < cnt; ++i) { float pv[8]; unpack8(*(const u32x4*)(pr - i * 2048 + 1792), pv);
#pragma unroll
                  for (int e = 0; e < 8; ++e) acc[e] += pv[e]; }
              const float ic = 1.0f / (float)cnt;
#pragma unroll
              for (int e = 0; e < 8; ++e) acc[e] = acc[e] * ic - pt[e];
              *(u32x4*)(BR + (size_t)row * DM + 768 + 8 * ch) = pack8(acc); } }
        { const int srow = tid >> 2, qt = tid & 3; const bf16_t* vp = P + (size_t)(R0 + srow) * 2048 + 768 + qt * 64;
          float v[64]; float sum = 0.f;
#pragma unroll
          for (int j = 0; j < 8; ++j) { const u32x4 w = *(const u32x4*)(vp + 8 * j);
              v[8 * j + 0] = bflo(w.x); v[8 * j + 1] = bfhi(w.x); v[8 * j + 2] = bflo(w.y); v[8 * j + 3] = bfhi(w.y); v[8 * j + 4] = bflo(w.z); v[8 * j + 5] = bfhi(w.z); v[8 * j + 6] = bflo(w.w); v[8 * j + 7] = bfhi(w.w); }
#pragma unroll
          for (int j = 0; j < 64; ++j) sum += v[j];
          sum += __shfl_xor(sum, 1); sum += __shfl_xor(sum, 2);
          const float mean = sum * (1.0f / 256.0f); float var = 0.f;
#pragma unroll
          for (int j = 0; j < 64; ++j) { v[j] -= mean; var += v[j] * v[j]; }
          var += __shfl_xor(var, 1); var += __shfl_xor(var, 2);
          const float rstd = 1.0f / sqrtf(var * (1.0f / 256.0f) + EPS);
          LAS bf16_t* vT = (LAS bf16_t*)lds;
#pragma unroll
          for (int j = 0; j < 64; ++j) { const int c = qt * 64 + j; vT[c * 136 + srow] = (bf16_t)f2bf(v[j] * rstd * lng[c] + lnb[c]); } }
        __syncthreads();
        { const int g = wid >> 1, th = wid & 1;
#pragma unroll
          for (int tb = 0; tb < 2; ++tb)
#pragma unroll
              for (int cb = 0; cb < 2; ++cb) { f32x16 acc;
#pragma unroll
                  for (int r = 0; r < 16; ++r) acc[r] = 0.f;
                  const bf16_t* ap = SGWB + (size_t)(g * 128 + 64 * th + 32 * tb + r32) * 128 + 8 * hi;
                  const LAS unsigned char* bp = lds + (g * 64 + 32 * cb + r32) * 272 + 16 * hi;
                  const int nks = (64 * th + 32 * tb + 32) >> 4;
                  for (int ks = 0; ks < nks; ++ks) { const bf16x8 A = *(const bf16x8*)(ap + 16 * ks); const bf16x8 B = *(const LAS bf16x8*)(bp + 32 * ks); acc = MFMA32(A, B, acc); }
#pragma unroll
                  for (int r = 0; r < 16; ++r) { const int t = 64 * th + 32 * tb + crow(r, hi), c = g * 64 + 32 * cb + r32;
                      const float val = acc[r] + sgb[g * 128 + t]; const float u = bf2f(P[(size_t)(R0 + t) * 2048 + 512 + c]);
                      BR[(size_t)(R0 + t) * DM + 256 + c] = (bf16_t)f2bf(u * val); } } }
        __syncthreads();
    }
}

constexpr int KPITCH = 208, VPITCH = 136, KBUF = 64 * KPITCH, VBUF = 64 * VPITCH, ATT_V0 = 2 * KBUF, ATT_WS = ATT_V0 + 2 * VBUF;
__device__ __forceinline__ void attn_unit(const Args& a, int b, int h, int qb, LAS unsigned char* lds, int tid) {
    const int lane = tid & 63, wid = __builtin_amdgcn_readfirstlane(tid >> 6), r32 = lane & 31, hi = lane >> 5;
    unsigned char* ws = a.ws;
    const bf16_t* Q = (const bf16_t*)(ws + WS_Q); const bf16_t* Kn = (const bf16_t*)(ws + WS_KN); const bf16_t* Kr = (const bf16_t*)(ws + WS_KR); const bf16_t* Vt = (const bf16_t*)(ws + WS_VT);
    bf16_t* O = (bf16_t*)(ws + WS_BR); const float* rc = (const float*)(ws + WS_ROPEC); const float* rsn = (const float*)(ws + WS_ROPES);
    const size_t rowbase = (size_t)b * SEQ; const int qw0 = qb * 256 + wid * 32;
    LAS float* wsf = (LAS float*)(lds + ATT_WS) + wid * 64;
    bf16x8 qf[6];
    { const size_t qrow = rowbase + qw0 + r32; const bf16_t* qp = Q + qrow * 512 + h * 96 + 8 * hi;
#pragma unroll
      for (int ks = 0; ks < 4; ++ks) qf[ks] = *(const bf16x8*)(qp + 16 * ks);
      const bf16x8 x1 = *(const bf16x8*)(qp + 64), x2 = *(const bf16x8*)(qp + 80);
      const float* cp = rc + qrow * 16 + 8 * hi; const float* sp = rsn + qrow * 16 + 8 * hi;
      const f32x4 c0 = *(const f32x4*)cp, c1 = *(const f32x4*)(cp + 4), s0 = *(const f32x4*)sp, s1 = *(const f32x4*)(sp + 4);
      bf16x8 o1, o2;
#pragma unroll
      for (int j = 0; j < 8; ++j) { const float xa = bf2f((bf16_t)x1[j]), xb = bf2f((bf16_t)x2[j]); const float c = j < 4 ? c0[j & 3] : c1[j & 3], s = j < 4 ? s0[j & 3] : s1[j & 3];
          o1[j] = (short)f2bf(xa * c - xb * s); o2[j] = (short)f2bf(xb * c + xa * s); }
      qf[4] = o1; qf[5] = o2; }
    const int krow = tid >> 3, kch = tid & 7;
    const bf16_t* knp = Kn + (rowbase + krow) * 256 + h * 64 + kch * 8;
    const bf16_t* krp = Kr + (rowbase + (tid >> 2)) * 32 + (tid & 3) * 8;
    const bf16_t* vtp = Vt + (size_t)(h * 64 + krow) * MTOK + rowbase + kch * 8;
    const bool rope_loader = wid < 4;
    u32x4 gk, gr, gv;
#define ATT_LOAD(t) do { gk = *(const u32x4*)(knp + (size_t)(t) * 64 * 256); if (rope_loader) gr = *(const u32x4*)(krp + (size_t)(t) * 64 * 32); gv = *(const u32x4*)(vtp + (size_t)(t) * 64); } while (0)
#define ATT_STORE(bf) do { *(LAS u32x4*)(lds + (bf) * KBUF + krow * KPITCH + kch * 16) = gk; if (rope_loader) *(LAS u32x4*)(lds + (bf) * KBUF + (tid >> 2) * KPITCH + 128 + (tid & 3) * 16) = gr; \
        *(LAS u32x2*)(lds + ATT_V0 + (bf) * VBUF + krow * VPITCH + kch * 16) = (u32x2){gv.x, gv.y}; *(LAS u32x2*)(lds + ATT_V0 + (bf) * VBUF + krow * VPITCH + kch * 16 + 8) = (u32x2){gv.z, gv.w}; } while (0)
    float mref = -INFINITY, lsum = 0.f; f32x16 o0, o1;
#pragma unroll
    for (int r = 0; r < 16; ++r) { o0[r] = 0.f; o1[r] = 0.f; }
    const int NT = 4 * qb + 4;
    ATT_LOAD(0); ATT_STORE(0); __syncthreads();
    for (int t = 0; t < NT; ++t) {
        const int buf = t & 1;
        if (t + 1 < NT) ATT_LOAD(t + 1);
        if (64 * t <= qw0 + 31) {
            f32x16 p0, p1;
#pragma unroll
            for (int r = 0; r < 16; ++r) { p0[r] = 0.f; p1[r] = 0.f; }
            const LAS unsigned char* kb = lds + buf * KBUF + r32 * KPITCH + hi * 16;
#pragma unroll
            for (int ks = 0; ks < 6; ++ks) { const bf16x8 a0 = *(const LAS bf16x8*)(kb + ks * 32), a1 = *(const LAS bf16x8*)(kb + 32 * KPITCH + ks * 32);
                p0 = MFMA32(a0, qf[ks], p0); p1 = MFMA32(a1, qf[ks], p1); }
            if (64 * t + 63 > qw0) { const int qg = qw0 + r32;
#pragma unroll
                for (int r = 0; r < 16; ++r) { const int kv = 64 * t + crow(r, hi); if (kv > qg) p0[r] = -INFINITY; if (kv + 32 > qg) p1[r] = -INFINITY; } }
            float rm = fmaxf(p0[0], p1[0]);
#pragma unroll
            for (int r = 1; r < 16; ++r) rm = fmaxf(rm, fmaxf(p0[r], p1[r]));
            rm = fmaxf(rm, __shfl_xor(rm, 32));
            if (__any(rm > mref + 8.0f)) {
                const float mnew = fmaxf(mref, rm); const float alpha = __builtin_amdgcn_exp2f(mref - mnew);
                lsum *= alpha; mref = mnew;
                if (hi == 0) wsf[r32] = alpha;
                asm volatile("s_waitcnt lgkmcnt(0)" ::: "memory");
#pragma unroll
                for (int r = 0; r < 16; ++r) { const float f = wsf[crow(r, hi)]; o0[r] *= f; o1[r] *= f; }
            }
            float ps = 0.f;
#pragma unroll
            for (int r = 0; r < 16; ++r) { p0[r] = __builtin_amdgcn_exp2f(p0[r] - mref); p1[r] = __builtin_amdgcn_exp2f(p1[r] - mref); ps += p0[r] + p1[r]; }
            lsum += ps;
            bf16x8 pa[4];
            { u32x4 w;
              w.x = pg8::cvt_pk_bf16(p0[0], p0[1]); w.y = pg8::cvt_pk_bf16(p0[2], p0[3]); w.z = pg8::cvt_pk_bf16(p0[4], p0[5]); w.w = pg8::cvt_pk_bf16(p0[6], p0[7]); pa[0] = __builtin_bit_cast(bf16x8, w);
              w.x = pg8::cvt_pk_bf16(p0[8], p0[9]); w.y = pg8::cvt_pk_bf16(p0[10], p0[11]); w.z = pg8::cvt_pk_bf16(p0[12], p0[13]); w.w = pg8::cvt_pk_bf16(p0[14], p0[15]); pa[1] = __builtin_bit_cast(bf16x8, w);
              w.x = pg8::cvt_pk_bf16(p1[0], p1[1]); w.y = pg8::cvt_pk_bf16(p1[2], p1[3]); w.z = pg8::cvt_pk_bf16(p1[4], p1[5]); w.w = pg8::cvt_pk_bf16(p1[6], p1[7]); pa[2] = __builtin_bit_cast(bf16x8, w);
              w.x = pg8::cvt_pk_bf16(p1[8], p1[9]); w.y = pg8::cvt_pk_bf16(p1[10], p1[11]); w.z = pg8::cvt_pk_bf16(p1[12], p1[13]); w.w = pg8::cvt_pk_bf16(p1[14], p1[15]); pa[3] = __builtin_bit_cast(bf16x8, w); }
            const LAS unsigned char* vb = lds + ATT_V0 + buf * VBUF + r32 * VPITCH + hi * 8;
#pragma unroll
            for (int kk = 0; kk < 4; ++kk) {
                const s16x4 l0 = *(const LAS s16x4*)(vb + kk * 32), h0 = *(const LAS s16x4*)(vb + kk * 32 + 16);
                const s16x4 l1 = *(const LAS s16x4*)(vb + 32 * VPITCH + kk * 32), h1 = *(const LAS s16x4*)(vb + 32 * VPITCH + kk * 32 + 16);
                const bf16x8 v0 = __builtin_shufflevector(l0, h0, 0, 1, 2, 3, 4, 5, 6, 7), v1 = __builtin_shufflevector(l1, h1, 0, 1, 2, 3, 4, 5, 6, 7);
                o0 = MFMA32(pa[kk], v0, o0); o1 = MFMA32(pa[kk], v1, o1); }
        }
        if (t + 1 < NT) ATT_STORE((t + 1) & 1);
        __syncthreads();
    }
#undef ATT_LOAD
#undef ATT_STORE
    lsum += __shfl_xor(lsum, 32);
    if (hi == 0) wsf[32 + r32] = 1.0f / lsum;
    asm volatile("s_waitcnt lgkmcnt(0)" ::: "memory");
#pragma unroll
    for (int r = 0; r < 16; ++r) { const int qr = crow(r, hi); const float inv = wsf[32 + qr]; bf16_t* op = O + (rowbase + qw0 + qr) * DM + h * 64 + r32;
        op[0] = (bf16_t)f2bf(o0[r] * inv); op[32] = (bf16_t)f2bf(o1[r] * inv); }
}
__device__ __forceinline__ void phase_attn(const Args& a, LAS unsigned char* lds, int tid) {
    const int G = gridDim.x, bx = blockIdx.x; const int v0 = (G % 8 == 0) ? (bx % 8) * (G / 8) + bx / 8 : bx;
    for (int v = v0; v < 256; v += G) { const int bh = v >> 4, s = v & 15;
        attn_unit(a, bh >> 2, bh & 3, 31 - s, lds, tid);
        attn_unit(a, bh >> 2, bh & 3, s, lds, tid); }
}

__global__ void __launch_bounds__(512, 2) mk_fwd(Args a) {
    extern __shared__ __attribute__((aligned(16))) unsigned char lds_raw[];
    LAS unsigned char* lds = (LAS unsigned char*)lds_raw;
    cg::grid_group grid = cg::this_grid();
    const int tid0 = threadIdx.x, G = gridDim.x, bx = blockIdx.x;
    for (int ph = a.lo; ph < a.hi; ++ph) {
        unsigned char* ws = a.ws; int tid = tid0;
        asm volatile("" : "+s"(ws), "+v"(tid));
        int l = 0, k = -1; if (ph > 0) { l = (ph - 1) / 11; k = (ph - 1) % 11; }
        const int ng = (k == 0 || k == 4 || k == 5 || k == 6 || k == 8 || k == 9) ? 1 : (k == 2 ? 3 : 0);
#ifndef PM
#define PM 0xFF
#endif
        if (PM & 1) for (int j = 0; j < ng; ++j) {
            size_t oA, oB, oO; int M_ = MTOK, N_ = DM, K_ = DM, lda = DM, ldb = DM, ldc = DM, mode = 0, nbr = 1, coff = 0, use_rs = 0;
            if (k == 0) {
                oA = WS_XBF; oB = WS_WIN; oO = WS_BIG; N_ = 2048; ldc = 2048; use_rs = 1; mode = 1;
            } else if (k == 2) {
                if (j == 0) { oA = WS_CQN; oB = WS_WUQ; oO = WS_Q; N_ = 512; K_ = 256; lda = 256; ldb = 256; ldc = 512; }
                else if (j == 1) { oA = WS_CKVN; oB = WS_WK; oO = WS_KN; N_ = 256; K_ = 128; lda = 128; ldb = 128; ldc = 256; }
                else { oA = WS_WV; oB = WS_CKVN; oO = WS_VT; M_ = 256; N_ = MTOK; K_ = 128; lda = 128; ldb = 128; ldc = MTOK; coff = G / 2; }
            } else if (k == 4) {
                oA = WS_XBF; oB = WS_WIN + (size_t)2048 * DM * 2; oO = WS_BIG; N_ = 4096; ldc = 4096; use_rs = 1; mode = 2;
            } else if (k == 5) {
                oA = WS_BR; oB = WS_WBR; oO = WS_XBF; K_ = 256; ldb = 256; mode = 4; nbr = 4;
            } else if (k == 6) {
                oA = WS_XBF; oB = WS_WOUT; oO = WS_BR;
            } else if (k == 8) {
                oA = WS_XBF; oB = WS_W1; oO = WS_BIG; N_ = DFF; ldc = DFF; use_rs = 1; mode = 3;
            } else {
                oA = WS_BIG; oB = WS_W2; oO = WS_BR; K_ = DFF; lda = DFF; ldb = DFF;
            }
            pg8::Gemm g{(const bf16_t*)(ws + oA), (const bf16_t*)(ws + oB), M_, N_, K_, lda, ldb};
            pg8::EpiRT E{(bf16_t*)(ws + oO), ldc, use_rs ? (const float*)(ws + WS_RS) : nullptr, a.in[I_GATEB] + l * 4096, (const bf16_t*)(ws + WS_BIG), mode};
            pg8::MergeOrder S; S.init(M_, N_, G, (bx + coff) % G, nbr);
            pg8::gemm_phase<pg8::EpiRT, pg8::MergeOrder, true, true>(lds, g, S, E, tid);
        }
        if ((PM & 2) && k == 1) phase_e1(a, l, lds, tid);
        if ((PM & 4) && k == 3) phase_attn(a, lds, tid);
        if ((PM & 8) && (k == 7 || k == 10)) phase_nr(a, (k == 7 ? a.in[I_NPOST] : a.in[I_NFPOST]) + l * DM, tid);
        if ((PM & 16) && ph == 0) phase_s0(a, lds, tid);
        if ((PM & 32) && (ph == 0 || (k == 10 && l + 1 < NLAYER))) prep_weights(a, ph == 0 ? 0 : l + 1, lds, tid);
        if (ph + 1 < a.hi) grid.sync();
    }
}

constexpr int NPHASE = 1 + 11 * NLAYER;
#ifndef MK_ONE_LAUNCH
#define MK_ONE_LAUNCH 0
#endif
extern "C" void kernel_launch(void* const* d_in, const int* in_sizes, int n_in, void* d_out, int out_size, void* d_ws, size_t ws_size, hipStream_t stream) {
    static int grid = 0;
    if (grid == 0) {
        if (n_in != 26 || out_size != MTOK * DM || ws_size < WS_END) { fprintf(stderr, "kernel_launch: unexpected shapes (n_in %d out %d ws %zu)\n", n_in, out_size, ws_size); grid = -1; return; }
        int dev = 0, cus = 0, per_cu = 0;
        hipGetDevice(&dev); hipDeviceGetAttribute(&cus, hipDeviceAttributeMultiprocessorCount, dev);
        hipFuncSetAttribute((const void*)mk_fwd, hipFuncAttributeMaxDynamicSharedMemorySize, LDS_BYTES);
        hipOccupancyMaxActiveBlocksPerMultiprocessor(&per_cu, (const void*)mk_fwd, 512, LDS_BYTES);
        if (per_cu < 1) { fprintf(stderr, "kernel_launch: occupancy query says %d blocks per CU\n", per_cu); per_cu = 1; }
        (void)hipGetLastError();
        grid = cus;
    }
    if (grid < 0) return;
    Args a{};
    for (int i = 0; i < 26; ++i) a.in[i] = (const float*)d_in[i];
    a.out = (float*)d_out; a.ws = (unsigned char*)d_ws;
#if MK_ONE_LAUNCH
    a.lo = 0; a.hi = NPHASE;
    { void* args[] = {&a}; hipError_t e = hipLaunchCooperativeKernel((const void*)mk_fwd, dim3(grid), dim3(512), args, LDS_BYTES, stream);
      if (e != hipSuccess) fprintf(stderr, "cooperative launch failed: %s (grid %d)\n", hipGetErrorString(e), grid); }
#else
    for (int ph = 0; ph < NPHASE; ++ph) { a.lo = ph; a.hi = ph + 1;
        void* args[] = {&a}; hipError_t e = hipLaunchCooperativeKernel((const void*)mk_fwd, dim3(grid), dim3(512), args, LDS_BYTES, stream);
        if (e != hipSuccess) { fprintf(stderr, "launch %d failed: %s (grid %d)\n", ph, hipGetErrorString(e), grid); break; } }
#endif
}
```

```cpp
#include <hip/hip_runtime.h>
#include <hip/hip_cooperative_groups.h>
#include <cstdio>
#include <cstdint>
namespace cg = cooperative_groups;

#define LAS __attribute__((address_space(3)))
typedef unsigned short bf16_t;
typedef short bf16x8 __attribute__((ext_vector_type(8)));
typedef short s16x4 __attribute__((ext_vector_type(4)));
typedef float f32x4 __attribute__((ext_vector_type(4)));
typedef float f32x2 __attribute__((ext_vector_type(2)));
typedef float f32x16 __attribute__((ext_vector_type(16)));
typedef unsigned u32x4 __attribute__((ext_vector_type(4)));
typedef unsigned u32x2 __attribute__((ext_vector_type(2)));

__device__ __forceinline__ unsigned f2bf(float f) { unsigned u = __builtin_bit_cast(unsigned, f); return (u + 0x7fffu + ((u >> 16) & 1u)) >> 16; }
__device__ __forceinline__ unsigned pk2(float lo, float hi) { return f2bf(lo) | (f2bf(hi) << 16); }
__device__ __forceinline__ float bflo(unsigned w) { return __builtin_bit_cast(float, w << 16); }
__device__ __forceinline__ float bfhi(unsigned w) { return __builtin_bit_cast(float, w & 0xffff0000u); }
__device__ __forceinline__ float bf2f(bf16_t h) { return __builtin_bit_cast(float, ((unsigned)h) << 16); }
__device__ __forceinline__ float wave_sum(float v) {
#pragma unroll
    for (int o = 1; o < 64; o <<= 1) v += __shfl_xor(v, o);
    return v;
}
__device__ __forceinline__ float fast_sigmoid(float v) { return __builtin_amdgcn_rcpf(1.0f + __builtin_amdgcn_exp2f(-1.4426950408889634f * v)); }
__device__ __forceinline__ float gelu_tanh(float x) { const float u = 0.7978845608028654f * (x + 0.044715f * x * x * x); return x * fast_sigmoid(2.0f * u); }

namespace pg8 {
#define PG8_LAS __attribute__((address_space(3)))
constexpr int BM = 256, BK = 64, HALF = 128, HTB = HALF * BK * 2  , STAGE_BYTES = 8 * HTB, NXCD = 8, WGM = 8;

__host__ __device__ __forceinline__ int lds_byte(int r, int c) { const int st = (r >> 4) * 2 + (c >> 5), rr = r & 15, cc = c & 31, ob = rr * 64 + cc * 2; return st * 1024 + (ob ^ (((ob >> 9) & 1) << 5)); }
__host__ __device__ __forceinline__ void stage_rc(int b, int& R, int& C) { const int st = b / 1024, sb = b % 1024, swz = sb ^ (((sb >> 9) & 1) << 5); R = (st >> 1) * 16 + swz / 64; C = (st & 1) * 32 + (swz % 64) / 2; }
__host__ __device__ __forceinline__ int perm32(int rho) { const int n = rho >> 4, i = rho & 15; return 8 * (i >> 2) + 4 * n + (i & 3); }

struct Unit { int pm, pn, bn, ak, z; };
struct Gemm { const bf16_t* A; const bf16_t* Bt; int M, N, K, lda, ldb; };

struct StaticOrder {
    int nM, nN, nwg, G, c;
    __host__ __device__ void init(int M, int N, int G_, int c_) { nM = M / BM; nN = N / BM; nwg = nM * nN; G = G_; c = c_; }
    __host__ __device__ bool map(long L, Unit& u) const {
        if (L >= nwg) return false;
        int wgid = (int)L; { const int q = nwg / NXCD, r = nwg % NXCD, xcd = wgid % NXCD, off = wgid / NXCD; wgid = (xcd < r ? xcd * (q + 1) : r * (q + 1) + (xcd - r) * q) + off; }
        const int nig = WGM * nN, gid = wgid / nig, fm = gid * WGM, gsz = (nM - fm) < WGM ? (nM - fm) : WGM;
        u.pm = fm + ((wgid % nig) % gsz); u.pn = (wgid % nig) / gsz; return true;
    }
    __host__ __device__ bool next(int i, Unit& u) const { u.ak = 0; u.z = 0; const bool ok = map((long)i * G + c, u); u.bn = u.pn; return ok; }
    __device__ __forceinline__ void a_ready(const Unit&) const {}
    __device__ __forceinline__ void done(const Unit&) const {}
};
struct MergeOrder {
    StaticOrder S; int nbr;
    __host__ __device__ void init(int M, int N, int G_, int c_, int nbr_) { S.init(M, N, G_, c_); nbr = nbr_; }
    __host__ __device__ bool next(int i, Unit& u) const { const int z = i % nbr; const bool ok = S.map((long)(i / nbr) * S.G + S.c, u); u.z = z; u.ak = z * 256; u.bn = z * S.nN + u.pn; return ok; }
    __device__ __forceinline__ void a_ready(const Unit&) const {}
    __device__ __forceinline__ void done(const Unit&) const {}
};

__device__ __forceinline__ unsigned cvt_pk_bf16(float lo, float hi) { unsigned r; asm volatile("v_cvt_pk_bf16_f32 %0, %1, %2" : "=v"(r) : "v"(lo), "v"(hi)); return r; }

struct EpiRT {
    static constexpr bool PERM = true, AFTER_DRAIN = false;
    bf16_t* O; int ldc; const float* rs; const float* bias; const bf16_t* gates; int mode;
    __device__ __forceinline__ void operator()(const f32x4 (&acc)[2][2][4][2], const Unit& u, int wr, int wc, int fr, int fq) const {
        const int row0 = u.pm * BM + wr * 64 + fr; const int col0 = u.pn * BM + wc * 32 + 8 * fq;
        const int m_eff = (mode == 1) ? ((u.pn == 2 || u.pn == 3) ? 1 : 0) : mode;
#pragma unroll
        for (int ai = 0; ai < 2; ++ai)
#pragma unroll
            for (int m = 0; m < 4; ++m) { const int row = row0 + ai * HALF + m * 16; bf16_t* rowp = O + (size_t)row * ldc + col0;
                const float sc = rs ? rs[row] : 1.0f;
#pragma unroll
                for (int bj = 0; bj < 2; ++bj) { f32x4 v0 = acc[ai][bj][m][0] * sc, v1 = acc[ai][bj][m][1] * sc;
                    if (m_eff == 1) {
#pragma unroll
                        for (int e = 0; e < 4; ++e) { v0[e] = gelu_tanh(v0[e]); v1[e] = gelu_tanh(v1[e]); }
                    } else if (m_eff == 2) { v0 = v0 + *(const f32x4*)(bias + col0 + bj * HALF); v1 = v1 + *(const f32x4*)(bias + col0 + bj * HALF + 4);
#pragma unroll
                        for (int e = 0; e < 4; ++e) { v0[e] = fast_sigmoid(v0[e]); v1[e] = fast_sigmoid(v1[e]); }
                    } else if (m_eff == 3) {
#pragma unroll
                        for (int e = 0; e < 4; ++e) { const float a = fmaxf(v0[e], 0.f), b = fmaxf(v1[e], 0.f); v0[e] = a * a; v1[e] = b * b; }
                    } else if (m_eff == 4) { const u32x4 gw = *(const u32x4*)(gates + (size_t)row * 4096 + u.z * 1024 + col0 + bj * HALF);
                        v0[0] *= bflo(gw.x); v0[1] *= bfhi(gw.x); v0[2] *= bflo(gw.y); v0[3] *= bfhi(gw.y);
                        v1[0] *= bflo(gw.z); v1[1] *= bfhi(gw.z); v1[2] *= bflo(gw.w); v1[3] *= bfhi(gw.w);
                        if (u.z != 0) { const u32x4 ow = *(const u32x4*)(rowp + bj * HALF);
                            v0[0] += bflo(ow.x); v0[1] += bfhi(ow.x); v0[2] += bflo(ow.y); v0[3] += bfhi(ow.y);
                            v1[0] += bflo(ow.z); v1[1] += bfhi(ow.z); v1[2] += bflo(ow.w); v1[3] += bfhi(ow.w); } }
                    u32x4 w; w.x = cvt_pk_bf16(v0[0], v0[1]); w.y = cvt_pk_bf16(v0[2], v0[3]); w.z = cvt_pk_bf16(v1[0], v1[1]); w.w = cvt_pk_bf16(v1[2], v1[3]);
                    *(u32x4*)(rowp + bj * HALF) = w; } }
    }
};

template <class Epi, class Sched, bool ALIGN_EPI = false, bool SP2 = false>
__device__ __forceinline__ void gemm_phase(PG8_LAS unsigned char* lds, const Gemm g, const Sched& S, const Epi& E, const int tid) {
    const int wid = __builtin_amdgcn_readfirstlane(tid >> 6), lane = tid & 63, wr = wid >> 2, wc = wid & 3, fr = lane & 15, fq = lane >> 4;
    const int K = g.K, nt = K / BK;
    unsigned voffA[2], voffB[2];
#pragma unroll
    for (int i = 0; i < 2; ++i) { int R, C; stage_rc(tid * 16 + i * 8192, R, C); const int Rb = Epi::PERM ? ((R & ~31) + perm32(R & 31)) : R;
        voffA[i] = (unsigned)(R * g.lda + C) * 2u; voffB[i] = (unsigned)(Rb * g.ldb + C) * 2u; }
    const size_t kstep = (size_t)(BK * 2);
    const size_t hstepA = (size_t)HALF * g.lda * 2, hstepB = (size_t)HALF * g.ldb * 2;
    const size_t tstepA = 2 * hstepA, tstepB = 2 * hstepB;
    const unsigned ldsw = (unsigned)wid * 1024u;
    const int aoff = lds_byte(wr * 64 + fr, fq * 8), boff = lds_byte(wc * 32 + fr, fq * 8);
#define PG8_SA(b, h) (((b) * 2 + (h)) * HTB)
#define PG8_SB(b, h) ((4 + (b) * 2 + (h)) * HTB)
#define PG8_STAGE(bufoff, gbase, voff) do { _Pragma("unroll") for (int _i = 0; _i < 2; ++_i) \
        __builtin_amdgcn_global_load_lds((const unsigned*)((const char*)(gbase) + (voff)[_i]), (PG8_LAS unsigned*)(lds + (bufoff) + ldsw + _i * 8192), 16, 0, 0); } while (0)
#define PG8_LDA(dst, b, h) do { _Pragma("unroll") for (int m = 0; m < 4; ++m) _Pragma("unroll") for (int k = 0; k < 2; ++k) dst[m][k] = *(const PG8_LAS bf16x8*)(lds + PG8_SA(b, h) + aoff + m * 2048 + k * 1024); } while (0)
#define PG8_LDB(dst, b, h) do { _Pragma("unroll") for (int n = 0; n < 2; ++n) _Pragma("unroll") for (int k = 0; k < 2; ++k) dst[n][k] = *(const PG8_LAS bf16x8*)(lds + PG8_SB(b, h) + boff + n * 2048 + k * 1024); } while (0)
#define PG8_MMA(ai, bj, At, Bt) do { __builtin_amdgcn_s_setprio(1); _Pragma("unroll") for (int m = 0; m < 4; ++m) _Pragma("unroll") for (int n = 0; n < 2; ++n) _Pragma("unroll") for (int k = 0; k < 2; ++k) \
        acc[ai][bj][m][n] = __builtin_amdgcn_mfma_f32_16x16x32_bf16(Bt[n][k], At[m][k], acc[ai][bj][m][n], 0, 0, 0); __builtin_amdgcn_s_setprio(0); } while (0)
#define PG8_WAIT_V(n) asm volatile("s_waitcnt vmcnt(" #n ")" ::: "memory")
#define PG8_WAIT_L(n) asm volatile("s_waitcnt lgkmcnt(" #n ")" ::: "memory")
#define PG8_BAR __builtin_amdgcn_s_barrier()
#define PG8_SCHED __builtin_amdgcn_sched_barrier(0)
    Unit cur, nxt; int ui = 0;
    if (!S.next(0, cur)) return;
    f32x4 acc[2][2][4][2];
#pragma unroll
    for (int a = 0; a < 2; ++a)
#pragma unroll
        for (int b = 0; b < 2; ++b)
#pragma unroll
            for (int m = 0; m < 4; ++m)
#pragma unroll
                for (int n = 0; n < 2; ++n) acc[a][b][m][n] = (f32x4){0.f, 0.f, 0.f, 0.f};
    bf16x8 At[4][2], B0[2][2], B1[2][2];
    const char* cA = (const char*)g.A + (size_t)cur.pm * tstepA + (size_t)cur.ak * 2; const char* cB = (const char*)g.Bt + (size_t)cur.bn * tstepB;
    S.a_ready(cur);
    if constexpr (SP2) {
        PG8_STAGE(PG8_SB(0, 0), cB, voffB); PG8_STAGE(PG8_SB(0, 1), cB + hstepB, voffB); PG8_STAGE(PG8_SA(0, 0), cA, voffA); PG8_STAGE(PG8_SA(0, 1), cA + hstepA, voffA);
        if (wr == 1) PG8_BAR;
        PG8_WAIT_V(2); PG8_BAR;
        PG8_STAGE(PG8_SB(1, 0), cB + kstep, voffB); PG8_STAGE(PG8_SA(1, 0), cA + kstep, voffA); PG8_STAGE(PG8_SB(1, 1), cB + hstepB + kstep, voffB);
        PG8_WAIT_V(6); PG8_BAR;
    } else {
        PG8_STAGE(PG8_SB(0, 0), cB, voffB); PG8_STAGE(PG8_SA(0, 0), cA, voffA); PG8_STAGE(PG8_SB(0, 1), cB + hstepB, voffB); PG8_STAGE(PG8_SA(0, 1), cA + hstepA, voffA);
        if (wr == 1) PG8_BAR;
        PG8_WAIT_V(4); PG8_BAR;
        PG8_STAGE(PG8_SB(1, 0), cB + kstep, voffB); PG8_STAGE(PG8_SA(1, 0), cA + kstep, voffA); PG8_STAGE(PG8_SB(1, 1), cB + hstepB + kstep, voffB);
        PG8_WAIT_V(6); PG8_BAR;
    }
    for (;;) {
        const bool has_next = S.next(ui + 1, nxt);
        const char* nA = has_next ? (const char*)g.A + (size_t)nxt.pm * tstepA + (size_t)nxt.ak * 2 : cA; const char* nB = has_next ? (const char*)g.Bt + (size_t)nxt.bn * tstepB : cB;
        for (int t = 0; t < nt; t += 2) {
            const bool last = (t == nt - 2);
            const char* a1 = cA + (size_t)(t + 1) * kstep;
            const char* a2 = last ? nA : cA + (size_t)(t + 2) * kstep; const char* b2 = last ? nB : cB + (size_t)(t + 2) * kstep;
            const char* a3 = a2 + kstep; const char* b3 = b2 + kstep;
            if (last && has_next) S.a_ready(nxt);
            if constexpr (SP2) {
            PG8_LDB(B0, 0, 0); PG8_LDB(B1, 0, 1); PG8_SCHED; PG8_LDA(At, 0, 0); PG8_STAGE(PG8_SA(1, 1), a1 + hstepA, voffA);
            PG8_WAIT_V(8); PG8_WAIT_L(0); PG8_BAR; PG8_MMA(0, 0, At, B0); PG8_MMA(0, 1, At, B1); PG8_BAR; PG8_SCHED;
            PG8_LDA(At, 0, 1); PG8_STAGE(PG8_SB(0, 0), b2, voffB); PG8_STAGE(PG8_SB(0, 1), b2 + hstepB, voffB); PG8_STAGE(PG8_SA(0, 0), a2, voffA);
            PG8_WAIT_V(8); PG8_WAIT_L(0); PG8_BAR; PG8_MMA(1, 0, At, B0); PG8_MMA(1, 1, At, B1); PG8_BAR; PG8_SCHED;
            PG8_LDB(B0, 1, 0); PG8_LDB(B1, 1, 1); PG8_SCHED; PG8_LDA(At, 1, 0); PG8_STAGE(PG8_SA(0, 1), a2 + hstepA, voffA);
            PG8_WAIT_V(8); PG8_WAIT_L(0); PG8_BAR; PG8_MMA(0, 0, At, B0); PG8_MMA(0, 1, At, B1); PG8_BAR; PG8_SCHED;
            PG8_LDA(At, 1, 1); PG8_STAGE(PG8_SB(1, 0), b3, voffB); PG8_STAGE(PG8_SB(1, 1), b3 + hstepB, voffB); PG8_STAGE(PG8_SA(1, 0), a3, voffA);
            PG8_WAIT_V(8); PG8_WAIT_L(0); PG8_BAR; PG8_MMA(1, 0, At, B0); PG8_MMA(1, 1, At, B1); PG8_BAR; PG8_SCHED;
            } else {
            PG8_LDB(B0, 0, 0); PG8_SCHED; PG8_LDA(At, 0, 0); PG8_STAGE(PG8_SA(1, 1), a1 + hstepA, voffA);
            PG8_WAIT_L(8); PG8_BAR; PG8_WAIT_L(0); PG8_MMA(0, 0, At, B0); PG8_BAR; PG8_SCHED;
            PG8_LDB(B1, 0, 1); PG8_STAGE(PG8_SB(0, 0), b2, voffB);
            PG8_BAR; PG8_WAIT_L(0); PG8_MMA(0, 1, At, B1); PG8_BAR;
            PG8_LDA(At, 0, 1); PG8_STAGE(PG8_SA(0, 0), a2, voffA);
            PG8_BAR; PG8_WAIT_L(0); PG8_MMA(1, 0, At, B0); PG8_BAR; PG8_SCHED;
            PG8_STAGE(PG8_SB(0, 1), b2 + hstepB, voffB);
            PG8_WAIT_V(6); PG8_BAR; PG8_MMA(1, 1, At, B1); PG8_BAR;
            PG8_LDB(B0, 1, 0); PG8_SCHED; PG8_LDA(At, 1, 0); PG8_STAGE(PG8_SA(0, 1), a2 + hstepA, voffA);
            PG8_WAIT_L(8); PG8_BAR; PG8_WAIT_L(0); PG8_MMA(0, 0, At, B0); PG8_BAR; PG8_SCHED;
            PG8_LDB(B1, 1, 1); PG8_STAGE(PG8_SB(1, 0), b3, voffB);
            PG8_BAR; PG8_WAIT_L(0); PG8_MMA(0, 1, At, B1); PG8_BAR;
            PG8_LDA(At, 1, 1); PG8_STAGE(PG8_SA(1, 0), a3, voffA);
            PG8_BAR; PG8_WAIT_L(0); PG8_MMA(1, 0, At, B0); PG8_BAR; PG8_SCHED;
            PG8_STAGE(PG8_SB(1, 1), b3 + hstepB, voffB);
            PG8_WAIT_V(6); PG8_BAR; PG8_MMA(1, 1, At, B1); PG8_BAR;
            }
        }
        if constexpr (ALIGN_EPI) { if (wr == 0) PG8_BAR; }
        if constexpr (!Epi::AFTER_DRAIN) { E(acc, cur, wr, wc, fr, fq); S.done(cur); }
        if (!has_next) break;
#pragma unroll
        for (int a = 0; a < 2; ++a)
#pragma unroll
            for (int b = 0; b < 2; ++b)
#pragma unroll
                for (int m = 0; m < 4; ++m)
#pragma unroll
                    for (int n = 0; n < 2; ++n) acc[a][b][m][n] = (f32x4){0.f, 0.f, 0.f, 0.f};
        cur = nxt; cA = nA; cB = nB; ++ui;
        if constexpr (ALIGN_EPI) { if (wr == 1) PG8_BAR; }
    }
    PG8_WAIT_V(0);
    if constexpr (!ALIGN_EPI) { if (wr == 0) PG8_BAR; }
    PG8_BAR;
    if constexpr (Epi::AFTER_DRAIN) { E.fused(acc, cur, wr, wc, fr, fq, lds, wid, lane); S.done(cur); }
#undef PG8_SA
#undef PG8_SB
#undef PG8_STAGE
#undef PG8_LDA
#undef PG8_LDB
#undef PG8_MMA
#undef PG8_WAIT_V
#undef PG8_WAIT_L
#undef PG8_BAR
#undef PG8_SCHED
}
}

constexpr int MTOK = 32768, DM = 1024, SEQ = 8192, NLAYER = 4, NIN = 6048, DFF = 4096;
constexpr float EPS = 1e-6f;
constexpr float QSCALE = 0.10206207261596575f * 1.4426950408889634f;
constexpr size_t MiB = 1u << 20;
constexpr size_t WS_RS = 1 * MiB, WS_ROPEC = 2 * MiB, WS_ROPES = 4 * MiB;
constexpr size_t WS_WIN = 6 * MiB, WS_WUQ = 18 * MiB, WS_WK = WS_WUQ + 256 * 1024, WS_WV = WS_WK + 64 * 1024, WS_SGW = WS_WUQ + 512 * 1024;
constexpr size_t WS_WBR = 19 * MiB, WS_WOUT = 21 * MiB, WS_W1 = 23 * MiB, WS_W2 = 31 * MiB;
constexpr size_t WS_XBF = 40 * MiB;
constexpr size_t WS_BR = 104 * MiB;
constexpr size_t WS_BIG = 168 * MiB;
constexpr size_t WS_PROJ = WS_BIG, WS_CQN = WS_BIG + 128 * MiB, WS_CKVN = WS_BIG + 144 * MiB, WS_KR = WS_BIG + 152 * MiB, WS_Q = WS_BIG + 154 * MiB, WS_KN = WS_BIG + 186 * MiB, WS_VT = WS_BIG + 202 * MiB;
constexpr size_t WS_END = 424 * MiB;
constexpr int LDS_BYTES = 147456;

struct Args { const float* in[26]; float* out; unsigned char* ws; int lo, hi; };
enum { I_X = 0, I_POS, I_NPRE, I_WIN, I_GATEB, I_QN, I_WUQ, I_KVN, I_WUKV, I_WBRMLA, I_LNG, I_LNB, I_SGW, I_SGB, I_WBRSG, I_CONVW, I_WBRCONV, I_POOLW, I_POOLS, I_WBRPOOL, I_WOUT, I_NPOST, I_NFPRE, I_WFF1, I_WFF2, I_NFPOST };

__device__ __forceinline__ int crow(int r, int hi) { return (r & 3) + 8 * (r >> 2) + 4 * hi; }
#define MFMA32(a, b, c) __builtin_amdgcn_mfma_f32_32x32x16_bf16((a), (b), (c), 0, 0, 0)

__device__ __forceinline__ void tr_item(const float* __restrict__ W, int ldw, int k0, int srcn0, const float* __restrict__ gk, float mul, bf16_t* WT, int ldt, int dstn0, LAS float* scr, int lane) {
#pragma unroll 8
    for (int i = 0; i < 32; ++i) { const int kk = 2 * i + (lane >> 5); float v = 0.f;
        if (srcn0 >= 0) { v = W[(size_t)(k0 + kk) * ldw + srcn0 + (lane & 31)] * mul; if (gk) v *= gk[k0 + kk]; }
        scr[kk * 33 + (lane & 31)] = v; }
    asm volatile("s_waitcnt lgkmcnt(0)" ::: "memory");
    const int c = lane & 7;
#pragma unroll
    for (int j = 0; j < 4; ++j) { const int n = (lane >> 3) + 8 * j; const LAS float* s = scr + (8 * c) * 33 + n;
        u32x4 o; o.x = pk2(s[0 * 33], s[1 * 33]); o.y = pk2(s[2 * 33], s[3 * 33]); o.z = pk2(s[4 * 33], s[5 * 33]); o.w = pk2(s[6 * 33], s[7 * 33]);
        *(u32x4*)(WT + (size_t)(dstn0 + n) * ldt + k0 + 8 * c) = o; }
    asm volatile("s_waitcnt lgkmcnt(0)" ::: "memory");
}

__device__ __forceinline__ void prep_weights(const Args& a, int l, LAS unsigned char* lds, int tid) {
    const int lane = tid & 63, wave = tid >> 6, G = gridDim.x;
    LAS float* scr = (LAS float*)(lds + wave * 8448);
    const int gw = blockIdx.x * 8 + wave, NGW = G * 8;
    unsigned char* ws = a.ws;
    constexpr int N0 = 16 * 192, N1 = 4 * 16, N2 = 2 * 8, N3 = 2 * 8, N4 = 3 * 4 * 32, N5 = 16 * 32, N6 = 16 * 128, N7 = 64 * 32;
    constexpr int NITEMS = N0 + N1 + N2 + N3 + N4 + N5 + N6 + N7;
    for (int it = gw; it < NITEMS; it += NGW) {
        int r = it;
        if (r < N0) { const int kb = r / 192, nb = r % 192, d0 = nb * 32; const int src = d0 < 416 ? d0 : (d0 < 512 ? -1 : d0 - 96);
            tr_item(a.in[I_WIN] + (size_t)l * DM * NIN, NIN, kb * 64, src, a.in[I_NPRE] + l * DM, 1.f, (bf16_t*)(ws + WS_WIN), DM, d0, scr, lane); continue; } r -= N0;
        if (r < N1) { const int kb = r / 16, nb = r % 16;
            tr_item(a.in[I_WUQ] + (size_t)l * 256 * 384, 384, kb * 64, nb < 12 ? nb * 32 : -1, a.in[I_QN] + l * 256, QSCALE, (bf16_t*)(ws + WS_WUQ), 256, nb * 32, scr, lane); continue; } r -= N1;
        if (r < N2) { const int kb = r / 8, nb = r % 8;
            tr_item(a.in[I_WUKV] + (size_t)l * 128 * 512, 512, kb * 64, (nb >> 1) * 128 + (nb & 1) * 32, a.in[I_KVN] + l * 128, 1.f, (bf16_t*)(ws + WS_WK), 128, nb * 32, scr, lane); continue; } r -= N2;
        if (r < N3) { const int kb = r / 8, nb = r % 8;
            tr_item(a.in[I_WUKV] + (size_t)l * 128 * 512, 512, kb * 64, (nb >> 1) * 128 + 64 + (nb & 1) * 32, a.in[I_KVN] + l * 128, 1.f, (bf16_t*)(ws + WS_WV), 128, nb * 32, scr, lane); continue; } r -= N3;
        if (r < N4) { const int z = r / 128, rr = r % 128, kb = rr / 32, nb = rr % 32; const float* W = (z == 0 ? a.in[I_WBRMLA] : z == 1 ? a.in[I_WBRSG] : a.in[I_WBRCONV]) + (size_t)l * 256 * DM;
            tr_item(W, DM, kb * 64, nb * 32, nullptr, 1.f, (bf16_t*)(ws + WS_WBR) + (size_t)z * DM * 256, 256, nb * 32, scr, lane); continue; } r -= N4;
        if (r < N5) { const int kb = r / 32, nb = r % 32;
            tr_item(a.in[I_WOUT] + (size_t)l * DM * DM, DM, kb * 64, nb * 32, nullptr, 1.f, (bf16_t*)(ws + WS_WOUT), DM, nb * 32, scr, lane); continue; } r -= N5;
        if (r < N6) { const int kb = r / 128, nb = r % 128;
            tr_item(a.in[I_WFF1] + (size_t)l * DM * DFF, DFF, kb * 64, nb * 32, a.in[I_NFPRE] + l * DM, 1.f, (bf16_t*)(ws + WS_W1), DM, nb * 32, scr, lane); continue; } r -= N6;
        { const int kb = r / 32, nb = r % 32;
            tr_item(a.in[I_WFF2] + (size_t)l * DFF * DM, DM, kb * 64, nb * 32, nullptr, 1.f, (bf16_t*)(ws + WS_W2), DFF, nb * 32, scr, lane); }
    }
    const int gt = blockIdx.x * 512 + tid, NGT = G * 512;
    { const float* sw = a.in[I_SGW] + (size_t)l * 65536; bf16_t* o = (bf16_t*)(ws + WS_SGW);
      for (int i = gt; i < 65536; i += NGT) { const int t = (i >> 7) & 127, s = i & 127; o[i] = (bf16_t)f2bf(s <= t ? sw[i] : 0.f); } }
    { const float* wp = a.in[I_POOLW] + (size_t)l * 4 * 64 * 64; const float* sc = a.in[I_POOLS] + l * 256; const float* wb = a.in[I_WBRPOOL] + (size_t)l * 256 * DM;
      bf16_t* o = (bf16_t*)(ws + WS_WBR) + (size_t)3 * DM * 256;
      for (int i = gt; i < 256 * DM; i += NGT) { const int n = i & 1023, cp = i >> 10, g = cp >> 6, c = cp & 63; float acc = 0.f;
          for (int d = 0; d < 64; ++d) acc += wp[(g * 64 + c) * 64 + d] * sc[g * 64 + d] * wb[(size_t)(g * 64 + d) * DM + n];
          o[(size_t)n * 256 + cp] = (bf16_t)f2bf(acc); } }
}

__device__ __forceinline__ void phase_s0(const Args& a, LAS unsigned char* lds, int tid) {
    const int G = gridDim.x, gt = blockIdx.x * 512 + tid, NGT = G * 512;
    const int* pos = (const int*)a.in[I_POS];
    float* rc = (float*)(a.ws + WS_ROPEC); float* rsn = (float*)(a.ws + WS_ROPES);
    for (int i = gt; i < MTOK * 16; i += NGT) { const int tok = i >> 4, k = i & 15;
        const int k3 = k & 3, k2 = k >> 2;
        const double b = k3 == 0 ? 1.0 : k3 == 1 ? 0.5623413251903491 : k3 == 2 ? 0.31622776601683794 : 0.1778279410038923;
        const double p10 = k2 == 0 ? 1.0 : k2 == 1 ? 0.1 : k2 == 2 ? 0.01 : 0.001;
        const double rev = (double)pos[tok] * (b * p10) * 0.15915494309189535;
        const float fr = (float)(rev - __builtin_rint(rev));
        rc[i] = __builtin_amdgcn_cosf(fr); rsn[i] = __builtin_amdgcn_sinf(fr); }
    const int lane = tid & 63, wave = tid >> 6, gw = blockIdx.x * 8 + wave, NGW = G * 8;
    const float* x = a.in[I_X]; float* xo = a.out; bf16_t* xb = (bf16_t*)(a.ws + WS_XBF); float* rs = (float*)(a.ws + WS_RS);
    for (int row = gw; row < MTOK; row += NGW) {
        const float* xr = x + (size_t)row * DM + 8 * lane; float* xw = xo + (size_t)row * DM + 8 * lane; bf16_t* bw = xb + (size_t)row * DM + 8 * lane;
        float ss = 0.f;
#pragma unroll
        for (int j = 0; j < 2; ++j) { const f32x4 v0 = *(const f32x4*)(xr + 512 * j), v1 = *(const f32x4*)(xr + 512 * j + 4);
            ss += v0.x * v0.x + v0.y * v0.y + v0.z * v0.z + v0.w * v0.w + v1.x * v1.x + v1.y * v1.y + v1.z * v1.z + v1.w * v1.w;
            *(f32x4*)(xw + 512 * j) = v0; *(f32x4*)(xw + 512 * j + 4) = v1;
            u32x4 o; o.x = pk2(v0.x, v0.y); o.y = pk2(v0.z, v0.w); o.z = pk2(v1.x, v1.y); o.w = pk2(v1.z, v1.w); *(u32x4*)(bw + 512 * j) = o; }
        ss = wave_sum(ss);
        if (lane == 0) rs[row] = 1.0f / sqrtf(ss * (1.0f / DM) + EPS);
    }
}

__device__ __forceinline__ void phase_nr(const Args& a, const float* gpost, int tid) {
    const int G = gridDim.x, lane = tid & 63, wave = tid >> 6, gw = blockIdx.x * 8 + wave, NGW = G * 8;
    float* xo = a.out; bf16_t* xb = (bf16_t*)(a.ws + WS_XBF); float* rs = (float*)(a.ws + WS_RS); const bf16_t* y = (const bf16_t*)(a.ws + WS_BR);
    for (int row = gw; row < MTOK; row += NGW) {
        float* xw = xo + (size_t)row * DM + 8 * lane; bf16_t* bw = xb + (size_t)row * DM + 8 * lane; const bf16_t* yr = y + (size_t)row * DM + 8 * lane;
        float yv[2][8]; float ss = 0.f;
#pragma unroll
        for (int j = 0; j < 2; ++j) { const u32x4 w = *(const u32x4*)(yr + 512 * j);
            yv[j][0] = bflo(w.x); yv[j][1] = bfhi(w.x); yv[j][2] = bflo(w.y); yv[j][3] = bfhi(w.y); yv[j][4] = bflo(w.z); yv[j][5] = bfhi(w.z); yv[j][6] = bflo(w.w); yv[j][7] = bfhi(w.w);
#pragma unroll
            for (int e = 0; e < 8; ++e) ss += yv[j][e] * yv[j][e]; }
        ss = wave_sum(ss);
        const float ry = 1.0f / sqrtf(ss * (1.0f / DM) + EPS);
        float xs = 0.f; float xn[2][8];
#pragma unroll
        for (int j = 0; j < 2; ++j) { const f32x4 x0 = *(const f32x4*)(xw + 512 * j), x1 = *(const f32x4*)(xw + 512 * j + 4);
            const f32x4 g0 = *(const f32x4*)(gpost + 8 * lane + 512 * j), g1 = *(const f32x4*)(gpost + 8 * lane + 512 * j + 4);
#pragma unroll
            for (int e = 0; e < 4; ++e) { xn[j][e] = x0[e] + yv[j][e] * ry * g0[e]; xn[j][4 + e] = x1[e] + yv[j][4 + e] * ry * g1[e]; }
#pragma unroll
            for (int e = 0; e < 8; ++e) xs += xn[j][e] * xn[j][e];
            *(f32x4*)(xw + 512 * j) = (f32x4){xn[j][0], xn[j][1], xn[j][2], xn[j][3]}; *(f32x4*)(xw + 512 * j + 4) = (f32x4){xn[j][4], xn[j][5], xn[j][6], xn[j][7]};
            u32x4 o; o.x = pk2(xn[j][0], xn[j][1]); o.y = pk2(xn[j][2], xn[j][3]); o.z = pk2(xn[j][4], xn[j][5]); o.w = pk2(xn[j][6], xn[j][7]); *(u32x4*)(bw + 512 * j) = o; }
        xs = wave_sum(xs);
        if (lane == 0) rs[row] = 1.0f / sqrtf(xs * (1.0f / DM) + EPS);
    }
}

__device__ __forceinline__ void unpack8(const u32x4 w, float (&f)[8]) { f[0] = bflo(w.x); f[1] = bfhi(w.x); f[2] = bflo(w.y); f[3] = bfhi(w.y); f[4] = bflo(w.z); f[5] = bfhi(w.z); f[6] = bflo(w.w); f[7] = bfhi(w.w); }
__device__ __forceinline__ u32x4 pack8(const float (&f)[8]) { u32x4 o; o.x = pk2(f[0], f[1]); o.y = pk2(f[2], f[3]); o.z = pk2(f[4], f[5]); o.w = pk2(f[6], f[7]); return o; }

__device__ __forceinline__ void phase_e1(const Args& a, int l, LAS unsigned char* lds, int tid) {
    const int lane = tid & 63, wid = __builtin_amdgcn_readfirstlane(tid >> 6), r32 = lane & 31, hi = lane >> 5;
    unsigned char* ws = a.ws;
    const bf16_t* P = (const bf16_t*)(ws + WS_PROJ); bf16_t* CQN = (bf16_t*)(ws + WS_CQN); bf16_t* CKVN = (bf16_t*)(ws + WS_CKVN); bf16_t* KR = (bf16_t*)(ws + WS_KR);
    bf16_t* BR = (bf16_t*)(ws + WS_BR); const float* rc = (const float*)(ws + WS_ROPEC); const float* rsn = (const float*)(ws + WS_ROPES);
    const bf16_t* SGWB = (const bf16_t*)(ws + WS_SGW);
    const float* convw = a.in[I_CONVW] + l * 3 * 256; const float* lng = a.in[I_LNG] + l * 256; const float* lnb = a.in[I_LNB] + l * 256; const float* sgb = a.in[I_SGB] + l * 512;
    for (int tile = blockIdx.x; tile < MTOK / 128; tile += gridDim.x) {
        const int R0 = tile * 128, s0 = R0 & (SEQ - 1);
        for (int i = 0; i < 16; ++i) { const int row = R0 + wid * 16 + i; const bf16_t* pr = P + (size_t)row * 2048;
            const u32x2 cq = *(const u32x2*)(pr + 4 * lane); const float q0 = bflo(cq.x), q1 = bfhi(cq.x), q2 = bflo(cq.y), q3 = bfhi(cq.y);
            const unsigned ck = *(const unsigned*)(pr + 256 + 2 * lane); const float k0 = bflo(ck), k1 = bfhi(ck);
            const float sq = wave_sum(q0 * q0 + q1 * q1 + q2 * q2 + q3 * q3), sk = wave_sum(k0 * k0 + k1 * k1);
            const float rq = 1.0f / sqrtf(sq * (1.0f / 256.0f) + EPS), rk = 1.0f / sqrtf(sk * (1.0f / 128.0f) + EPS);
            u32x2 oq; oq.x = pk2(q0 * rq, q1 * rq); oq.y = pk2(q2 * rq, q3 * rq); *(u32x2*)(CQN + (size_t)row * 256 + 4 * lane) = oq;
            *(unsigned*)(CKVN + (size_t)row * 128 + 2 * lane) = pk2(k0 * rk, k1 * rk);
            if (lane < 16) { const float x1 = bf2f(pr[384 + lane]), x2 = bf2f(pr[400 + lane]); const float c = rc[(size_t)row * 16 + lane], s = rsn[(size_t)row * 16 + lane];
                KR[(size_t)row * 32 + lane] = (bf16_t)f2bf(x1 * c - x2 * s); KR[(size_t)row * 32 + 16 + lane] = (bf16_t)f2bf(x2 * c + x1 * s); } }
        for (int it = 0; it < 8; ++it) { const int id = it * 512 + tid, ch = id & 31, t = id >> 5, row = R0 + t, s = s0 + t; const bf16_t* pr = P + (size_t)row * 2048 + 8 * ch;
            { float bg[8], y[8]; unpack8(*(const u32x4*)(pr + 1280), bg);
#pragma unroll
              for (int e = 0; e < 8; ++e) y[e] = 0.f;
#pragma unroll
              for (int k = 0; k < 3; ++k) { const int dt = k - 2; if (s + dt >= 0) { float xv[8], cv[8]; unpack8(*(const u32x4*)(pr + dt * 2048 + 1024), xv); unpack8(*(const u32x4*)(pr + dt * 2048 + 1536), cv);
                      const f32x4 w0 = *(const f32x4*)(convw + k * 256 + 8 * ch), w1 = *(const f32x4*)(convw + k * 256 + 8 * ch + 4);
#pragma unroll
                      for (int e = 0; e < 4; ++e) { y[e] += w0[e] * (xv[e] * cv[e]); y[4 + e] += w1[e] * (xv[4 + e] * cv[4 + e]); } } }
#pragma unroll
              for (int e = 0; e < 8; ++e) y[e] *= bg[e];
              *(u32x4*)(BR + (size_t)row * DM + 512 + 8 * ch) = pack8(y); }
            { const int g = ch >> 3, win = 2 << g; float acc[8], pt[8]; unpack8(*(const u32x4*)(pr + 1792), pt);
#pragma unroll
              for (int e = 0; e < 8; ++e) acc[e] = pt[e];
              const int cnt = (s + 1) < win ? (s + 1) : win;
              for (int i = 1; i < cnt; ++i) { float pv[8]; unpack8(*(const u32x4*)(pr - i * 2048 + 1792), pv);
#pragma unroll
                  for (int e = 0; e < 8; ++e) acc[e] += pv[e]; }
              const float ic = 1.0f / (float)cnt;
#pragma unroll
              for (int e = 0; e < 8; ++e) acc[e] = acc[e] * ic - pt[e];
              *(u32x4*)(BR + (size_t)row * DM + 768 + 8 * ch) = pack8(acc); } }
        { const int srow = tid >> 2, qt = tid & 3; const bf16_t* vp = P + (size_t)(R0 + srow) * 2048 + 768 + qt * 64;
          float v[64]; float sum = 0.f;
#pragma unroll
          for (int j = 0; j < 8; ++j) { const u32x4 w = *(const u32x4*)(vp + 8 * j);
              v[8 * j + 0] = bflo(w.x); v[8 * j + 1] = bfhi(w.x); v[8 * j + 2] = bflo(w.y); v[8 * j + 3] = bfhi(w.y); v[8 * j + 4] = bflo(w.z); v[8 * j + 5] = bfhi(w.z); v[8 * j + 6] = bflo(w.w); v[8 * j + 7] = bfhi(w.w); }
#pragma unroll
          for (int j = 0; j < 64; ++j) sum += v[j];
          sum += __shfl_xor(sum, 1); sum += __shfl_xor(sum, 2);
          const float mean = sum * (1.0f / 256.0f); float var = 0.f;
#pragma unroll
          for (int j = 0; j < 64; ++j) { v[j] -= mean; var += v[j] * v[j]; }
          var += __shfl_xor(var, 1); var += __shfl_xor(var, 2);
          const float rstd = 1.0f / sqrtf(var * (1.0f / 256.0f) + EPS);
          LAS bf16_t* vT = (LAS bf16_t*)lds;
#pragma unroll
          for (int j = 0; j < 64; ++j) { const int c = qt * 64 + j; vT[c * 136 + srow] = (bf16_t)f2bf(v[j] * rstd * lng[c] + lnb[c]); } }
        __syncthreads();
        { const int g = wid >> 1, th = wid & 1;
#pragma unroll
          for (int tb = 0; tb < 2; ++tb)
#pragma unroll
              for (int cb = 0; cb < 2; ++cb) { f32x16 acc;
#pragma unroll
                  for (int r = 0; r < 16; ++r) acc[r] = 0.f;
                  const bf16_t* ap = SGWB + (size_t)(g * 128 + 64 * th + 32 * tb + r32) * 128 + 8 * hi;
                  const LAS unsigned char* bp = lds + (g * 64 + 32 * cb + r32) * 272 + 16 * hi;
                  const int nks = (64 * th + 32 * tb + 32) >> 4;
                  for (int ks = 0; ks < nks; ++ks) { const bf16x8 A = *(const bf16x8*)(ap + 16 * ks); const bf16x8 B = *(const LAS bf16x8*)(bp + 32 * ks); acc = MFMA32(A, B, acc); }
#pragma unroll
                  for (int r = 0; r < 16; ++r) { const int t = 64 * th + 32 * tb + crow(r, hi), c = g * 64 + 32 * cb + r32;
                      const float val = acc[r] + sgb[g * 128 + t]; const float u = bf2f(P[(size_t)(R0 + t) * 2048 + 512 + c]);
                      BR[(size_t)(R0 + t) * DM + 256 + c] = (bf16_t)f2bf(u * val); } } }
        __syncthreads();
    }
}

constexpr int KPITCH = 208, VPITCH = 136, KBUF = 64 * KPITCH, VBUF = 64 * VPITCH, ATT_V0 = 2 * KBUF, ATT_WS = ATT_V0 + 2 * VBUF;
__device__ __forceinline__ void attn_unit(const Args& a, int b, int h, int qb, LAS unsigned char* lds, int tid) {
    const int lane = tid & 63, wid = __builtin_amdgcn_readfirstlane(tid >> 6), r32 = lane & 31, hi = lane >> 5;
    unsigned char* ws = a.ws;
    const bf16_t* Q = (const bf16_t*)(ws + WS_Q); const bf16_t* Kn = (const bf16_t*)(ws + WS_KN); const bf16_t* Kr = (const bf16_t*)(ws + WS_KR); const bf16_t* Vt = (const bf16_t*)(ws + WS_VT);
    bf16_t* O = (bf16_t*)(ws + WS_BR); const float* rc = (const float*)(ws + WS_ROPEC); const float* rsn = (const float*)(ws + WS_ROPES);
    const size_t rowbase = (size_t)b * SEQ; const int qw0 = qb * 256 + wid * 32;
    LAS float* wsf = (LAS float*)(lds + ATT_WS) + wid * 64;
    bf16x8 qf[6];
    { const size_t qrow = rowbase + qw0 + r32; const bf16_t* qp = Q + qrow * 512 + h * 96 + 8 * hi;
#pragma unroll
      for (int ks = 0; ks < 4; ++ks) qf[ks] = *(const bf16x8*)(qp + 16 * ks);
      const bf16x8 x1 = *(const bf16x8*)(qp + 64), x2 = *(const bf16x8*)(qp + 80);
      const float* cp = rc + qrow * 16 + 8 * hi; const float* sp = rsn + qrow * 16 + 8 * hi;
      const f32x4 c0 = *(const f32x4*)cp, c1 = *(const f32x4*)(cp + 4), s0 = *(const f32x4*)sp, s1 = *(const f32x4*)(sp + 4);
      bf16x8 o1, o2;
#pragma unroll
      for (int j = 0; j < 8; ++j) { const float xa = bf2f((bf16_t)x1[j]), xb = bf2f((bf16_t)x2[j]); const float c = j < 4 ? c0[j & 3] : c1[j & 3], s = j < 4 ? s0[j & 3] : s1[j & 3];
          o1[j] = (short)f2bf(xa * c - xb * s); o2[j] = (short)f2bf(xb * c + xa * s); }
      qf[4] = o1; qf[5] = o2; }
    const int krow = tid >> 3, kch = tid & 7;
    const bf16_t* knp = Kn + (rowbase + krow) * 256 + h * 64 + kch * 8;
    const bf16_t* krp = Kr + (rowbase + (tid >> 2)) * 32 + (tid & 3) * 8;
    const bf16_t* vtp = Vt + (size_t)(h * 64 + krow) * MTOK + rowbase + kch * 8;
    const bool rope_loader = wid < 4;
    u32x4 gk, gr, gv;
#define ATT_LOAD(t) do { gk = *(const u32x4*)(knp + (size_t)(t) * 64 * 256); if (rope_loader) gr = *(const u32x4*)(krp + (size_t)(t) * 64 * 32); gv = *(const u32x4*)(vtp + (size_t)(t) * 64); } while (0)
#define ATT_STORE(bf) do { *(LAS u32x4*)(lds + (bf) * KBUF + krow * KPITCH + kch * 16) = gk; if (rope_loader) *(LAS u32x4*)(lds + (bf) * KBUF + (tid >> 2) * KPITCH + 128 + (tid & 3) * 16) = gr; \
        *(LAS u32x2*)(lds + ATT_V0 + (bf) * VBUF + krow * VPITCH + kch * 16) = (u32x2){gv.x, gv.y}; *(LAS u32x2*)(lds + ATT_V0 + (bf) * VBUF + krow * VPITCH + kch * 16 + 8) = (u32x2){gv.z, gv.w}; } while (0)
    float mref = -INFINITY, lsum = 0.f; f32x16 o0, o1;
#pragma unroll
    for (int r = 0; r < 16; ++r) { o0[r] = 0.f; o1[r] = 0.f; }
    const int NT = 4 * qb + 4;
    ATT_LOAD(0); ATT_STORE(0); __syncthreads();
    for (int t = 0; t < NT; ++t) {
        const int buf = t & 1;
        if (t + 1 < NT) ATT_LOAD(t + 1);
        if (64 * t <= qw0 + 31) {
            f32x16 p0, p1;
#pragma unroll
            for (int r = 0; r < 16; ++r) { p0[r] = 0.f; p1[r] = 0.f; }
            const LAS unsigned char* kb = lds + buf * KBUF + r32 * KPITCH + hi * 16;
#pragma unroll
            for (int ks = 0; ks < 6; ++ks) { const bf16x8 a0 = *(const LAS bf16x8*)(kb + ks * 32), a1 = *(const LAS bf16x8*)(kb + 32 * KPITCH + ks * 32);
                p0 = MFMA32(a0, qf[ks], p0); p1 = MFMA32(a1, qf[ks], p1); }
            if (64 * t + 63 > qw0) { const int qg = qw0 + r32;
#pragma unroll
                for (int r = 0; r < 16; ++r) { const int kv = 64 * t + crow(r, hi); if (kv > qg) p0[r] = -INFINITY; if (kv + 32 > qg) p1[r] = -INFINITY; } }
            float rm = fmaxf(p0[0], p1[0]);
#pragma unroll
            for (int r = 1; r < 16; ++r) rm = fmaxf(rm, fmaxf(p0[r], p1[r]));
            rm = fmaxf(rm, __shfl_xor(rm, 32));
            if (__any(rm > mref + 8.0f)) {
                const float mnew = fmaxf(mref, rm); const float alpha = __builtin_amdgcn_exp2f(mref - mnew);
                lsum *= alpha; mref = mnew;
                if (hi == 0) wsf[r32] = alpha;
                asm volatile("s_waitcnt lgkmcnt(0)" ::: "memory");
#pragma unroll
                for (int r = 0; r < 16; ++r) { const float f = wsf[crow(r, hi)]; o0[r] *= f; o1[r] *= f; }
            }
            float ps = 0.f;
#pragma unroll
            for (int r = 0; r < 16; ++r) { p0[r] = __builtin_amdgcn_exp2f(p0[r] - mref); p1[r] = __builtin_amdgcn_exp2f(p1[r] - mref); ps += p0[r] + p1[r]; }
            lsum += ps;
            bf16x8 pa[4];
            { u32x4 w;
              w.x = pg8::cvt_pk_bf16(p0[0], p0[1]); w.y = pg8::cvt_pk_bf16(p0[2], p0[3]); w.z = pg8::cvt_pk_bf16(p0[4], p0[5]); w.w = pg8::cvt_pk_bf16(p0[6], p0[7]); pa[0] = __builtin_bit_cast(bf16x8, w);
              w.x = pg8::cvt_pk_bf16(p0[8], p0[9]); w.y = pg8::cvt_pk_bf16(p0[10], p0[11]); w.z = pg8::cvt_pk_bf16(p0[12], p0[13]); w.w = pg8::cvt_pk_bf16(p0[14], p0[15]); pa[1] = __builtin_bit_cast(bf16x8, w);
              w.x = pg8::cvt_pk_bf16(p1[0], p1[1]); w.y = pg8::cvt_pk_bf16(p1[2], p1[3]); w.z = pg8::cvt_pk_bf16(p1[4], p1[5]); w.w = pg8::cvt_pk_bf16(p1[6], p1[7]); pa[2] = __builtin_bit_cast(bf16x8, w);
              w.x = pg8::cvt_pk_bf16(p1[8], p1[9]); w.y = pg8::cvt_pk_bf16(p1[10], p1[11]); w.z = pg8::cvt_pk_bf16(p1[12], p1[13]); w.w = pg8::cvt_pk_bf16(p1[14], p1[15]); pa[3] = __builtin_bit_cast(bf16x8, w); }
            const LAS unsigned char* vb = lds + ATT_V0 + buf * VBUF + r32 * VPITCH + hi * 8;
#pragma unroll
            for (int kk = 0; kk < 4; ++kk) {
                const s16x4 l0 = *(const LAS s16x4*)(vb + kk * 32), h0 = *(const LAS s16x4*)(vb + kk * 32 + 16);
                const s16x4 l1 = *(const LAS s16x4*)(vb + 32 * VPITCH + kk * 32), h1 = *(const LAS s16x4*)(vb + 32 * VPITCH + kk * 32 + 16);
                const bf16x8 v0 = __builtin_shufflevector(l0, h0, 0, 1, 2, 3, 4, 5, 6, 7), v1 = __builtin_shufflevector(l1, h1, 0, 1, 2, 3, 4, 5, 6, 7);
                o0 = MFMA32(pa[kk], v0, o0); o1 = MFMA32(pa[kk], v1, o1); }
        }
        if (t + 1 < NT) ATT_STORE((t + 1) & 1);
        __syncthreads();
    }
#undef ATT_LOAD
#undef ATT_STORE
    lsum += __shfl_xor(lsum, 32);
    if (hi == 0) wsf[32 + r32] = 1.0f / lsum;
    asm volatile("s_waitcnt lgkmcnt(0)" ::: "memory");
#pragma unroll
    for (int r = 0; r < 16; ++r) { const int qr = crow(r, hi); const float inv = wsf[32 + qr]; bf16_t* op = O + (rowbase + qw0 + qr) * DM + h * 64 + r32;
        op[0] = (bf16_t)f2bf(o0[r] * inv); op[32] = (bf16_t)f2bf(o1[r] * inv); }
}
__device__ __forceinline__ void phase_attn(const Args& a, LAS unsigned char* lds, int tid) {
    const int G = gridDim.x, bx = blockIdx.x; const int v0 = (G % 8 == 0) ? (bx % 8) * (G / 8) + bx / 8 : bx;
    for (int v = v0; v < 256; v += G) { const int bh = v >> 4, s = v & 15;
        attn_unit(a, bh >> 2, bh & 3, 31 - s, lds, tid);
        attn_unit(a, bh >> 2, bh & 3, s, lds, tid); }
}

__global__ void __launch_bounds__(512, 2) mk_fwd(Args a) {
    extern __shared__ __attribute__((aligned(16))) unsigned char lds_raw[];
    LAS unsigned char* lds = (LAS unsigned char*)lds_raw;
    cg::grid_group grid = cg::this_grid();
    const int tid0 = threadIdx.x, G = gridDim.x, bx = blockIdx.x;
    for (int ph = a.lo; ph < a.hi; ++ph) {
        unsigned char* ws = a.ws; int tid = tid0;
        asm volatile("" : "+s"(ws), "+v"(tid));
        int l = 0, k = -1; if (ph > 0) { l = (ph - 1) / 11; k = (ph - 1) % 11; }
        const int ng = (k == 0 || k == 4 || k == 5 || k == 6 || k == 8 || k == 9) ? 1 : (k == 2 ? 3 : 0);
#ifndef PM
#define PM 0xFF
#endif
        if (PM & 1) for (int j = 0; j < ng; ++j) {
            size_t oA, oB, oO; int M_ = MTOK, N_ = DM, K_ = DM, lda = DM, ldb = DM, ldc = DM, mode = 0, nbr = 1, coff = 0, use_rs = 0;
            if (k == 0) {
                oA = WS_XBF; oB = WS_WIN; oO = WS_BIG; N_ = 2048; ldc = 2048; use_rs = 1; mode = 1;
            } else if (k == 2) {
                if (j == 0) { oA = WS_CQN; oB = WS_WUQ; oO = WS_Q; N_ = 512; K_ = 256; lda = 256; ldb = 256; ldc = 512; }
                else if (j == 1) { oA = WS_CKVN; oB = WS_WK; oO = WS_KN; N_ = 256; K_ = 128; lda = 128; ldb = 128; ldc = 256; }
                else { oA = WS_WV; oB = WS_CKVN; oO = WS_VT; M_ = 256; N_ = MTOK; K_ = 128; lda = 128; ldb = 128; ldc = MTOK; coff = G / 2; }
            } else if (k == 4) {
                oA = WS_XBF; oB = WS_WIN + (size_t)2048 * DM * 2; oO = WS_BIG; N_ = 4096; ldc = 4096; use_rs = 1; mode = 2;
            } else if (k == 5) {
                oA = WS_BR; oB = WS_WBR; oO = WS_XBF; K_ = 256; ldb = 256; mode = 4; nbr = 4;
            } else if (k == 6) {
                oA = WS_XBF; oB = WS_WOUT; oO = WS_BR;
            } else if (k == 8) {
                oA = WS_XBF; oB = WS_W1; oO = WS_BIG; N_ = DFF; ldc = DFF; use_rs = 1; mode = 3;
            } else {
                oA = WS_BIG; oB = WS_W2; oO = WS_BR; K_ = DFF; lda = DFF; ldb = DFF;
            }
            pg8::Gemm g{(const bf16_t*)(ws + oA), (const bf16_t*)(ws + oB), M_, N_, K_, lda, ldb};
            pg8::EpiRT E{(bf16_t*)(ws + oO), ldc, use_rs ? (const float*)(ws + WS_RS) : nullptr, a.in[I_GATEB] + l * 4096, (const bf16_t*)(ws + WS_BIG), mode};
            pg8::MergeOrder S; S.init(M_, N_, G, (bx + coff) % G, nbr);
            pg8::gemm_phase<pg8::EpiRT, pg8::MergeOrder, true, true>(lds, g, S, E, tid);
        }
        if ((PM & 2) && k == 1) phase_e1(a, l, lds, tid);
        if ((PM & 4) && k == 3) phase_attn(a, lds, tid);
        if ((PM & 8) && (k == 7 || k == 10)) phase_nr(a, (k == 7 ? a.in[I_NPOST] : a.in[I_NFPOST]) + l * DM, tid);
        if ((PM & 16) && ph == 0) phase_s0(a, lds, tid);
        if ((PM & 32) && (ph == 0 || (k == 10 && l + 1 < NLAYER))) prep_weights(a, ph == 0 ? 0 : l + 1, lds, tid);
        if (ph + 1 < a.hi) grid.sync();
    }
}

constexpr int NPHASE = 1 + 11 * NLAYER;
#ifndef MK_ONE_LAUNCH
#define MK_ONE_LAUNCH 1
#endif
extern "C" void kernel_launch(void* const* d_in, const int* in_sizes, int n_in, void* d_out, int out_size, void* d_ws, size_t ws_size, hipStream_t stream) {
    static int grid = 0;
    if (grid == 0) {
        if (n_in != 26 || out_size != MTOK * DM || ws_size < WS_END) { fprintf(stderr, "kernel_launch: unexpected shapes (n_in %d out %d ws %zu)\n", n_in, out_size, ws_size); grid = -1; return; }
        int dev = 0, cus = 0, per_cu = 0;
        hipGetDevice(&dev); hipDeviceGetAttribute(&cus, hipDeviceAttributeMultiprocessorCount, dev);
        hipFuncSetAttribute((const void*)mk_fwd, hipFuncAttributeMaxDynamicSharedMemorySize, LDS_BYTES);
        hipOccupancyMaxActiveBlocksPerMultiprocessor(&per_cu, (const void*)mk_fwd, 512, LDS_BYTES);
        if (per_cu < 1) { fprintf(stderr, "kernel_launch: occupancy query says %d blocks per CU\n", per_cu); per_cu = 1; }
        (void)hipGetLastError();
        grid = cus;
    }
    if (grid < 0) return;
    Args a{};
    for (int i = 0; i < 26; ++i) a.in[i] = (const float*)d_in[i];
    a.out = (float*)d_out; a.ws = (unsigned char*)d_ws;
#if MK_ONE_LAUNCH
    a.lo = 0; a.hi = NPHASE;
    { void* args[] = {&a}; hipError_t e = hipLaunchCooperativeKernel((const void*)mk_fwd, dim3(grid), dim3(512), args, LDS_BYTES, stream);
      if (e != hipSuccess) fprintf(stderr, "cooperative launch failed: %s (grid %d)\n", hipGetErrorString(e), grid); }
#else
    for (int ph = 0; ph < NPHASE; ++ph) { a.lo = ph; a.hi = ph + 1;
        void* args[] = {&a}; hipError_t e = hipLaunchCooperativeKernel((const void*)mk_fwd, dim3(grid), dim3(512), args, LDS_BYTES, stream);
        if (e != hipSuccess) { fprintf(stderr, "launch %d failed: %s (grid %d)\n", ph, hipGetErrorString(e), grid); break; } }
#endif
}
```

```cpp
#include <hip/hip_runtime.h>
#include <hip/hip_cooperative_groups.h>
#include <cstdio>
#include <cstdint>
namespace cg = cooperative_groups;

#define LAS __attribute__((address_space(3)))
typedef unsigned short bf16_t;
typedef short bf16x8 __attribute__((ext_vector_type(8)));
typedef short s16x4 __attribute__((ext_vector_type(4)));
typedef float f32x4 __attribute__((ext_vector_type(4)));
typedef float f32x2 __attribute__((ext_vector_type(2)));
typedef float f32x16 __attribute__((ext_vector_type(16)));
typedef unsigned u32x4 __attribute__((ext_vector_type(4)));
typedef unsigned u32x2 __attribute__((ext_vector_type(2)));

__device__ __forceinline__ unsigned f2bf(float f) { unsigned u = __builtin_bit_cast(unsigned, f); return (u + 0x7fffu + ((u >> 16) & 1u)) >> 16; }
__device__ __forceinline__ unsigned pk2(float lo, float hi) { return f2bf(lo) | (f2bf(hi) << 16); }
__device__ __forceinline__ float bflo(unsigned w) { return __builtin_bit_cast(float, w << 16); }
__device__ __forceinline__ float bfhi(unsigned w) { return __builtin_bit_cast(float, w & 0xffff0000u); }
__device__ __forceinline__ float bf2f(bf16_t h) { return __builtin_bit_cast(float, ((unsigned)h) << 16); }
__device__ __forceinline__ float wave_sum(float v) {
#pragma unroll
    for (int o = 1; o < 64; o <<= 1) v += __shfl_xor(v, o);
    return v;
}
__device__ __forceinline__ float fast_sigmoid(float v) { return __builtin_amdgcn_rcpf(1.0f + __builtin_amdgcn_exp2f(-1.4426950408889634f * v)); }
__device__ __forceinline__ float gelu_tanh(float x) { const float u = 0.7978845608028654f * (x + 0.044715f * x * x * x); return x * fast_sigmoid(2.0f * u); }

namespace pg8 {
#define PG8_LAS __attribute__((address_space(3)))
constexpr int BM = 256, BK = 64, HALF = 128, HTB = HALF * BK * 2  , STAGE_BYTES = 8 * HTB, NXCD = 8, WGM = 8;

__host__ __device__ __forceinline__ int lds_byte(int r, int c) { const int st = (r >> 4) * 2 + (c >> 5), rr = r & 15, cc = c & 31, ob = rr * 64 + cc * 2; return st * 1024 + (ob ^ (((ob >> 9) & 1) << 5)); }
__host__ __device__ __forceinline__ void stage_rc(int b, int& R, int& C) { const int st = b / 1024, sb = b % 1024, swz = sb ^ (((sb >> 9) & 1) << 5); R = (st >> 1) * 16 + swz / 64; C = (st & 1) * 32 + (swz % 64) / 2; }
__host__ __device__ __forceinline__ int perm32(int rho) { const int n = rho >> 4, i = rho & 15; return 8 * (i >> 2) + 4 * n + (i & 3); }

struct Unit { int pm, pn, bn, ak, z; };
struct Gemm { const bf16_t* A; const bf16_t* Bt; int M, N, K, lda, ldb, bmode; };

struct StaticOrder {
    int nM, nN, nwg, G, c;
    __host__ __device__ void init(int M, int N, int G_, int c_) { nM = M / BM; nN = N / BM; nwg = nM * nN; G = G_; c = c_; }
    __host__ __device__ bool map(long L, Unit& u) const {
        if (L >= nwg) return false;
        int wgid = (int)L; { const int q = nwg / NXCD, r = nwg % NXCD, xcd = wgid % NXCD, off = wgid / NXCD; wgid = (xcd < r ? xcd * (q + 1) : r * (q + 1) + (xcd - r) * q) + off; }
        const int nig = WGM * nN, gid = wgid / nig, fm = gid * WGM, gsz = (nM - fm) < WGM ? (nM - fm) : WGM;
        u.pm = fm + ((wgid % nig) % gsz); u.pn = (wgid % nig) / gsz; return true;
    }
    __host__ __device__ bool next(int i, Unit& u) const { u.ak = 0; u.z = 0; const bool ok = map((long)i * G + c, u); u.bn = u.pn; return ok; }
    __device__ __forceinline__ void a_ready(const Unit&) const {}
    __device__ __forceinline__ void done(const Unit&) const {}
};
struct MergeOrder {
    StaticOrder S; int nbr;
    __host__ __device__ void init(int M, int N, int G_, int c_, int nbr_) { S.init(M, N, G_, c_); nbr = nbr_; }
    __host__ __device__ bool next(int i, Unit& u) const { const int z = i % nbr; const bool ok = S.map((long)(i / nbr) * S.G + S.c, u); u.z = z; u.ak = z * 256; u.bn = z * S.nN + u.pn; return ok; }
    __device__ __forceinline__ void a_ready(const Unit&) const {}
    __device__ __forceinline__ void done(const Unit&) const {}
};

__device__ __forceinline__ unsigned cvt_pk_bf16(float lo, float hi) { unsigned r; asm volatile("v_cvt_pk_bf16_f32 %0, %1, %2" : "=v"(r) : "v"(lo), "v"(hi)); return r; }

struct EpiRT {
    static constexpr bool PERM = true, AFTER_DRAIN = false;
    bf16_t* O; int ldc; const float* rs; const float* bias; const bf16_t* gates; int mode, zs;
    __device__ __forceinline__ void operator()(const f32x4 (&acc)[2][2][4][2], const Unit& u, int wr, int wc, int fr, int fq) const {
        if (mode == 5) {
            const int row0 = u.pm * BM + wr * 64 + fr; const int col = u.pn * 64 + wc * 16 + 4 * fq;
#pragma unroll
            for (int ai = 0; ai < 2; ++ai)
#pragma unroll
                for (int m = 0; m < 4; ++m) { const int row = row0 + ai * HALF + m * 16; const float sc = rs[row]; const bf16_t* yp = gates + (size_t)row * 4096 + col;
                    f32x4 tot = (f32x4){0.f, 0.f, 0.f, 0.f};
#pragma unroll
                    for (int bj = 0; bj < 2; ++bj)
#pragma unroll
                        for (int n = 0; n < 2; ++n) { const int z = 2 * bj + n; const f32x4 v = acc[ai][bj][m][n] * sc + *(const f32x4*)(bias + z * 1024 + col); const u32x2 yw = *(const u32x2*)(yp + z * 1024);
                            tot[0] += fast_sigmoid(v[0]) * bflo(yw.x); tot[1] += fast_sigmoid(v[1]) * bfhi(yw.x); tot[2] += fast_sigmoid(v[2]) * bflo(yw.y); tot[3] += fast_sigmoid(v[3]) * bfhi(yw.y); }
                    u32x2 w; w.x = cvt_pk_bf16(tot[0], tot[1]); w.y = cvt_pk_bf16(tot[2], tot[3]);
                    *(u32x2*)(O + (size_t)row * ldc + col) = w; }
            return;
        }
        const int row0 = u.pm * BM + wr * 64 + fr; const int col0 = u.pn * BM + wc * 32 + 8 * fq + u.z * zs;
        const int m_eff = (mode == 1) ? ((u.pn == 2 || u.pn == 3) ? 1 : 0) : mode;
#pragma unroll
        for (int ai = 0; ai < 2; ++ai)
#pragma unroll
            for (int m = 0; m < 4; ++m) { const int row = row0 + ai * HALF + m * 16; bf16_t* rowp = O + (size_t)row * ldc + col0;
                const float sc = rs ? rs[row] : 1.0f;
#pragma unroll
                for (int bj = 0; bj < 2; ++bj) { f32x4 v0 = acc[ai][bj][m][0] * sc, v1 = acc[ai][bj][m][1] * sc;
                    if (m_eff == 1) {
#pragma unroll
                        for (int e = 0; e < 4; ++e) { v0[e] = gelu_tanh(v0[e]); v1[e] = gelu_tanh(v1[e]); }
                    } else if (m_eff == 3) {
#pragma unroll
                        for (int e = 0; e < 4; ++e) { const float a = fmaxf(v0[e], 0.f), b = fmaxf(v1[e], 0.f); v0[e] = a * a; v1[e] = b * b; }
                    }
                    u32x4 w; w.x = cvt_pk_bf16(v0[0], v0[1]); w.y = cvt_pk_bf16(v0[2], v0[3]); w.z = cvt_pk_bf16(v1[0], v1[1]); w.w = cvt_pk_bf16(v1[2], v1[3]);
                    *(u32x4*)(rowp + bj * HALF) = w; } }
    }
};

template <class Epi, class Sched, bool ALIGN_EPI = false, bool SP2 = false>
__device__ __forceinline__ void gemm_phase(PG8_LAS unsigned char* lds, const Gemm g, const Sched& S, const Epi& E, const int tid) {
    const int wid = __builtin_amdgcn_readfirstlane(tid >> 6), lane = tid & 63, wr = wid >> 2, wc = wid & 3, fr = lane & 15, fq = lane >> 4;
    const int K = g.K, nt = K / BK;
    unsigned voffA[2], voffB[2];
#pragma unroll
    for (int i = 0; i < 2; ++i) { int R, C; stage_rc(tid * 16 + i * 8192, R, C); const int Rb = g.bmode ? (((R >> 4) & 1) * 1024 + (R >> 5) * 16 + (R & 15)) : ((R & ~31) + perm32(R & 31));
        voffA[i] = (unsigned)(R * g.lda + C) * 2u; voffB[i] = (unsigned)(Rb * g.ldb + C) * 2u; }
    const size_t kstep = (size_t)(BK * 2);
    const size_t hstepA = (size_t)HALF * g.lda * 2, hstepB = (size_t)(g.bmode ? 2048 : HALF) * g.ldb * 2;
    const size_t tstepA = 2 * hstepA, tstepB = (size_t)(g.bmode ? 64 : 256) * g.ldb * 2;
    const unsigned ldsw = (unsigned)wid * 1024u;
    const int aoff = lds_byte(wr * 64 + fr, fq * 8), boff = lds_byte(wc * 32 + fr, fq * 8);
#define PG8_SA(b, h) (((b) * 2 + (h)) * HTB)
#define PG8_SB(b, h) ((4 + (b) * 2 + (h)) * HTB)
#define PG8_STAGE(bufoff, gbase, voff) do { _Pragma("unroll") for (int _i = 0; _i < 2; ++_i) \
        __builtin_amdgcn_global_load_lds((const unsigned*)((const char*)(gbase) + (voff)[_i]), (PG8_LAS unsigned*)(lds + (bufoff) + ldsw + _i * 8192), 16, 0, 0); } while (0)
#define PG8_LDA(dst, b, h) do { _Pragma("unroll") for (int m = 0; m < 4; ++m) _Pragma("unroll") for (int k = 0; k < 2; ++k) dst[m][k] = *(const PG8_LAS bf16x8*)(lds + PG8_SA(b, h) + aoff + m * 2048 + k * 1024); } while (0)
#define PG8_LDB(dst, b, h) do { _Pragma("unroll") for (int n = 0; n < 2; ++n) _Pragma("unroll") for (int k = 0; k < 2; ++k) dst[n][k] = *(const PG8_LAS bf16x8*)(lds + PG8_SB(b, h) + boff + n * 2048 + k * 1024); } while (0)
#define PG8_MMA(ai, bj, At, Bt) do { __builtin_amdgcn_s_setprio(1); _Pragma("unroll") for (int m = 0; m < 4; ++m) _Pragma("unroll") for (int n = 0; n < 2; ++n) _Pragma("unroll") for (int k = 0; k < 2; ++k) \
        acc[ai][bj][m][n] = __builtin_amdgcn_mfma_f32_16x16x32_bf16(Bt[n][k], At[m][k], acc[ai][bj][m][n], 0, 0, 0); __builtin_amdgcn_s_setprio(0); } while (0)
#define PG8_WAIT_V(n) asm volatile("s_waitcnt vmcnt(" #n ")" ::: "memory")
#define PG8_WAIT_L(n) asm volatile("s_waitcnt lgkmcnt(" #n ")" ::: "memory")
#define PG8_BAR __builtin_amdgcn_s_barrier()
#define PG8_SCHED __builtin_amdgcn_sched_barrier(0)
    Unit cur, nxt; int ui = 0;
    if (!S.next(0, cur)) return;
    f32x4 acc[2][2][4][2];
#pragma unroll
    for (int a = 0; a < 2; ++a)
#pragma unroll
        for (int b = 0; b < 2; ++b)
#pragma unroll
            for (int m = 0; m < 4; ++m)
#pragma unroll
                for (int n = 0; n < 2; ++n) acc[a][b][m][n] = (f32x4){0.f, 0.f, 0.f, 0.f};
    bf16x8 At[4][2], B0[2][2], B1[2][2];
    const char* cA = (const char*)g.A + (size_t)cur.pm * tstepA + (size_t)cur.ak * 2; const char* cB = (const char*)g.Bt + (size_t)cur.bn * tstepB;
    S.a_ready(cur);
    if constexpr (SP2) {
        PG8_STAGE(PG8_SB(0, 0), cB, voffB); PG8_STAGE(PG8_SB(0, 1), cB + hstepB, voffB); PG8_STAGE(PG8_SA(0, 0), cA, voffA); PG8_STAGE(PG8_SA(0, 1), cA + hstepA, voffA);
        if (wr == 1) PG8_BAR;
        PG8_WAIT_V(2); PG8_BAR;
        PG8_STAGE(PG8_SB(1, 0), cB + kstep, voffB); PG8_STAGE(PG8_SA(1, 0), cA + kstep, voffA); PG8_STAGE(PG8_SB(1, 1), cB + hstepB + kstep, voffB);
        PG8_WAIT_V(6); PG8_BAR;
    } else {
        PG8_STAGE(PG8_SB(0, 0), cB, voffB); PG8_STAGE(PG8_SA(0, 0), cA, voffA); PG8_STAGE(PG8_SB(0, 1), cB + hstepB, voffB); PG8_STAGE(PG8_SA(0, 1), cA + hstepA, voffA);
        if (wr == 1) PG8_BAR;
        PG8_WAIT_V(4); PG8_BAR;
        PG8_STAGE(PG8_SB(1, 0), cB + kstep, voffB); PG8_STAGE(PG8_SA(1, 0), cA + kstep, voffA); PG8_STAGE(PG8_SB(1, 1), cB + hstepB + kstep, voffB);
        PG8_WAIT_V(6); PG8_BAR;
    }
    for (;;) {
        const bool has_next = S.next(ui + 1, nxt);
        const char* nA = has_next ? (const char*)g.A + (size_t)nxt.pm * tstepA + (size_t)nxt.ak * 2 : cA; const char* nB = has_next ? (const char*)g.Bt + (size_t)nxt.bn * tstepB : cB;
        for (int t = 0; t < nt; t += 2) {
            const bool last = (t == nt - 2);
            const char* a1 = cA + (size_t)(t + 1) * kstep;
            const char* a2 = last ? nA : cA + (size_t)(t + 2) * kstep; const char* b2 = last ? nB : cB + (size_t)(t + 2) * kstep;
            const char* a3 = a2 + kstep; const char* b3 = b2 + kstep;
            if (last && has_next) S.a_ready(nxt);
            if constexpr (SP2) {
            PG8_LDB(B0, 0, 0); PG8_LDB(B1, 0, 1); PG8_SCHED; PG8_LDA(At, 0, 0); PG8_STAGE(PG8_SA(1, 1), a1 + hstepA, voffA);
            PG8_WAIT_V(8); PG8_WAIT_L(0); PG8_BAR; PG8_MMA(0, 0, At, B0); PG8_MMA(0, 1, At, B1); PG8_BAR; PG8_SCHED;
            PG8_LDA(At, 0, 1); PG8_STAGE(PG8_SB(0, 0), b2, voffB); PG8_STAGE(PG8_SB(0, 1), b2 + hstepB, voffB); PG8_STAGE(PG8_SA(0, 0), a2, voffA);
            PG8_WAIT_V(8); PG8_WAIT_L(0); PG8_BAR; PG8_MMA(1, 0, At, B0); PG8_MMA(1, 1, At, B1); PG8_BAR; PG8_SCHED;
            PG8_LDB(B0, 1, 0); PG8_LDB(B1, 1, 1); PG8_SCHED; PG8_LDA(At, 1, 0); PG8_STAGE(PG8_SA(0, 1), a2 + hstepA, voffA);
            PG8_WAIT_V(8); PG8_WAIT_L(0); PG8_BAR; PG8_MMA(0, 0, At, B0); PG8_MMA(0, 1, At, B1); PG8_BAR; PG8_SCHED;
            PG8_LDA(At, 1, 1); PG8_STAGE(PG8_SB(1, 0), b3, voffB); PG8_STAGE(PG8_SB(1, 1), b3 + hstepB, voffB); PG8_STAGE(PG8_SA(1, 0), a3, voffA);
            PG8_WAIT_V(8); PG8_WAIT_L(0); PG8_BAR; PG8_MMA(1, 0, At, B0); PG8_MMA(1, 1, At, B1); PG8_BAR; PG8_SCHED;
            } else {
            PG8_LDB(B0, 0, 0); PG8_SCHED; PG8_LDA(At, 0, 0); PG8_STAGE(PG8_SA(1, 1), a1 + hstepA, voffA);
            PG8_WAIT_L(8); PG8_BAR; PG8_WAIT_L(0); PG8_MMA(0, 0, At, B0); PG8_BAR; PG8_SCHED;
            PG8_LDB(B1, 0, 1); PG8_STAGE(PG8_SB(0, 0), b2, voffB);
            PG8_BAR; PG8_WAIT_L(0); PG8_MMA(0, 1, At, B1); PG8_BAR;
            PG8_LDA(At, 0, 1); PG8_STAGE(PG8_SA(0, 0), a2, voffA);
            PG8_BAR; PG8_WAIT_L(0); PG8_MMA(1, 0, At, B0); PG8_BAR; PG8_SCHED;
            PG8_STAGE(PG8_SB(0, 1), b2 + hstepB, voffB);
            PG8_WAIT_V(6); PG8_BAR; PG8_MMA(1, 1, At, B1); PG8_BAR;
            PG8_LDB(B0, 1, 0); PG8_SCHED; PG8_LDA(At, 1, 0); PG8_STAGE(PG8_SA(0, 1), a2 + hstepA, voffA);
            PG8_WAIT_L(8); PG8_BAR; PG8_WAIT_L(0); PG8_MMA(0, 0, At, B0); PG8_BAR; PG8_SCHED;
            PG8_LDB(B1, 1, 1); PG8_STAGE(PG8_SB(1, 0), b3, voffB);
            PG8_BAR; PG8_WAIT_L(0); PG8_MMA(0, 1, At, B1); PG8_BAR;
            PG8_LDA(At, 1, 1); PG8_STAGE(PG8_SA(1, 0), a3, voffA);
            PG8_BAR; PG8_WAIT_L(0); PG8_MMA(1, 0, At, B0); PG8_BAR; PG8_SCHED;
            PG8_STAGE(PG8_SB(1, 1), b3 + hstepB, voffB);
            PG8_WAIT_V(6); PG8_BAR; PG8_MMA(1, 1, At, B1); PG8_BAR;
            }
        }
        if constexpr (ALIGN_EPI) { if (wr == 0) PG8_BAR; }
        if constexpr (!Epi::AFTER_DRAIN) { E(acc, cur, wr, wc, fr, fq); S.done(cur); }
        if (!has_next) break;
#pragma unroll
        for (int a = 0; a < 2; ++a)
#pragma unroll
            for (int b = 0; b < 2; ++b)
#pragma unroll
                for (int m = 0; m < 4; ++m)
#pragma unroll
                    for (int n = 0; n < 2; ++n) acc[a][b][m][n] = (f32x4){0.f, 0.f, 0.f, 0.f};
        cur = nxt; cA = nA; cB = nB; ++ui;
        if constexpr (ALIGN_EPI) { if (wr == 1) PG8_BAR; }
    }
    PG8_WAIT_V(0);
    if constexpr (!ALIGN_EPI) { if (wr == 0) PG8_BAR; }
    PG8_BAR;
    if constexpr (Epi::AFTER_DRAIN) { E.fused(acc, cur, wr, wc, fr, fq, lds, wid, lane); S.done(cur); }
#undef PG8_SA
#undef PG8_SB
#undef PG8_STAGE
#undef PG8_LDA
#undef PG8_LDB
#undef PG8_MMA
#undef PG8_WAIT_V
#undef PG8_WAIT_L
#undef PG8_BAR
#undef PG8_SCHED
}
}

constexpr int MTOK = 32768, DM = 1024, SEQ = 8192, NLAYER = 4, NIN = 6048, DFF = 4096;
constexpr float EPS = 1e-6f;
constexpr float QSCALE = 0.10206207261596575f * 1.4426950408889634f;
constexpr size_t MiB = 1u << 20;
constexpr size_t WS_RS = 1 * MiB, WS_ROPEC = 2 * MiB, WS_ROPES = 4 * MiB;
constexpr size_t WS_WIN = 6 * MiB, WS_WUQ = 18 * MiB, WS_WK = WS_WUQ + 256 * 1024, WS_WV = WS_WK + 64 * 1024, WS_SGW = WS_WUQ + 512 * 1024;
constexpr size_t WS_WBR = 19 * MiB, WS_WOUT = 21 * MiB, WS_W1 = 23 * MiB, WS_W2 = 31 * MiB;
constexpr size_t WS_XBF = 40 * MiB;
constexpr size_t WS_BR = 104 * MiB;
constexpr size_t WS_BIG = 168 * MiB;
constexpr size_t WS_PROJ = WS_BIG, WS_CQN = WS_BIG + 128 * MiB, WS_CKVN = WS_BIG + 144 * MiB, WS_KR = WS_BIG + 152 * MiB, WS_Q = WS_BIG + 154 * MiB, WS_KN = WS_BIG + 186 * MiB, WS_VT = WS_BIG + 202 * MiB;
constexpr size_t WS_END = 424 * MiB;
constexpr int LDS_BYTES = 147456;

struct Args { const float* in[26]; float* out; unsigned char* ws; int lo, hi; };
enum { I_X = 0, I_POS, I_NPRE, I_WIN, I_GATEB, I_QN, I_WUQ, I_KVN, I_WUKV, I_WBRMLA, I_LNG, I_LNB, I_SGW, I_SGB, I_WBRSG, I_CONVW, I_WBRCONV, I_POOLW, I_POOLS, I_WBRPOOL, I_WOUT, I_NPOST, I_NFPRE, I_WFF1, I_WFF2, I_NFPOST };

__device__ __forceinline__ int crow(int r, int hi) { return (r & 3) + 8 * (r >> 2) + 4 * hi; }
#define MFMA32(a, b, c) __builtin_amdgcn_mfma_f32_32x32x16_bf16((a), (b), (c), 0, 0, 0)

__device__ __forceinline__ void tr_item(const float* __restrict__ W, int ldw, int k0, int srcn0, const float* __restrict__ gk, float mul, bf16_t* WT, int ldt, int dstn0, LAS float* scr, int lane) {
#pragma unroll 8
    for (int i = 0; i < 32; ++i) { const int kk = 2 * i + (lane >> 5); float v = 0.f;
        if (srcn0 >= 0) { v = W[(size_t)(k0 + kk) * ldw + srcn0 + (lane & 31)] * mul; if (gk) v *= gk[k0 + kk]; }
        scr[kk * 33 + (lane & 31)] = v; }
    asm volatile("s_waitcnt lgkmcnt(0)" ::: "memory");
    const int c = lane & 7;
#pragma unroll
    for (int j = 0; j < 4; ++j) { const int n = (lane >> 3) + 8 * j; const LAS float* s = scr + (8 * c) * 33 + n;
        u32x4 o; o.x = pk2(s[0 * 33], s[1 * 33]); o.y = pk2(s[2 * 33], s[3 * 33]); o.z = pk2(s[4 * 33], s[5 * 33]); o.w = pk2(s[6 * 33], s[7 * 33]);
        *(u32x4*)(WT + (size_t)(dstn0 + n) * ldt + k0 + 8 * c) = o; }
    asm volatile("s_waitcnt lgkmcnt(0)" ::: "memory");
}

__device__ __forceinline__ void prep_weights(const Args& a, int l, LAS unsigned char* lds, int tid) {
    const int lane = tid & 63, wave = tid >> 6, G = gridDim.x;
    LAS float* scr = (LAS float*)(lds + wave * 8448);
    const int gw = blockIdx.x * 8 + wave, NGW = G * 8;
    unsigned char* ws = a.ws;
    constexpr int N0 = 16 * 192, N1 = 4 * 16, N2 = 2 * 8, N3 = 2 * 8, N4 = 3 * 4 * 32, N5 = 16 * 32, N6 = 16 * 128, N7 = 64 * 32;
    constexpr int NITEMS = N0 + N1 + N2 + N3 + N4 + N5 + N6 + N7;
    for (int it = gw; it < NITEMS; it += NGW) {
        int r = it;
        if (r < N0) { const int kb = r / 192, nb = r % 192, d0 = nb * 32; const int src = d0 < 416 ? d0 : (d0 < 512 ? -1 : d0 - 96);
            tr_item(a.in[I_WIN] + (size_t)l * DM * NIN, NIN, kb * 64, src, a.in[I_NPRE] + l * DM, 1.f, (bf16_t*)(ws + WS_WIN), DM, d0, scr, lane); continue; } r -= N0;
        if (r < N1) { const int kb = r / 16, nb = r % 16;
            tr_item(a.in[I_WUQ] + (size_t)l * 256 * 384, 384, kb * 64, nb < 12 ? nb * 32 : -1, a.in[I_QN] + l * 256, QSCALE, (bf16_t*)(ws + WS_WUQ), 256, nb * 32, scr, lane); continue; } r -= N1;
        if (r < N2) { const int kb = r / 8, nb = r % 8;
            tr_item(a.in[I_WUKV] + (size_t)l * 128 * 512, 512, kb * 64, (nb >> 1) * 128 + (nb & 1) * 32, a.in[I_KVN] + l * 128, 1.f, (bf16_t*)(ws + WS_WK), 128, nb * 32, scr, lane); continue; } r -= N2;
        if (r < N3) { const int kb = r / 8, nb = r % 8;
            tr_item(a.in[I_WUKV] + (size_t)l * 128 * 512, 512, kb * 64, (nb >> 1) * 128 + 64 + (nb & 1) * 32, a.in[I_KVN] + l * 128, 1.f, (bf16_t*)(ws + WS_WV), 128, nb * 32, scr, lane); continue; } r -= N3;
        if (r < N4) { const int z = r / 128, rr = r % 128, kb = rr / 32, nb = rr % 32; const float* W = (z == 0 ? a.in[I_WBRMLA] : z == 1 ? a.in[I_WBRSG] : a.in[I_WBRCONV]) + (size_t)l * 256 * DM;
            tr_item(W, DM, kb * 64, nb * 32, nullptr, 1.f, (bf16_t*)(ws + WS_WBR) + (size_t)z * DM * 256, 256, nb * 32, scr, lane); continue; } r -= N4;
        if (r < N5) { const int kb = r / 32, nb = r % 32;
            tr_item(a.in[I_WOUT] + (size_t)l * DM * DM, DM, kb * 64, nb * 32, nullptr, 1.f, (bf16_t*)(ws + WS_WOUT), DM, nb * 32, scr, lane); continue; } r -= N5;
        if (r < N6) { const int kb = r / 128, nb = r % 128;
            tr_item(a.in[I_WFF1] + (size_t)l * DM * DFF, DFF, kb * 64, nb * 32, a.in[I_NFPRE] + l * DM, 1.f, (bf16_t*)(ws + WS_W1), DM, nb * 32, scr, lane); continue; } r -= N6;
        { const int kb = r / 32, nb = r % 32;
            tr_item(a.in[I_WFF2] + (size_t)l * DFF * DM, DM, kb * 64, nb * 32, nullptr, 1.f, (bf16_t*)(ws + WS_W2), DFF, nb * 32, scr, lane); }
    }
    const int gt = blockIdx.x * 512 + tid, NGT = G * 512;
    { const float* sw = a.in[I_SGW] + (size_t)l * 65536; bf16_t* o = (bf16_t*)(ws + WS_SGW);
      for (int i = gt; i < 65536; i += NGT) { const int t = (i >> 7) & 127, s = i & 127; o[i] = (bf16_t)f2bf(s <= t ? sw[i] : 0.f); } }
    { const float* wp = a.in[I_POOLW] + (size_t)l * 4 * 64 * 64; const float* sc = a.in[I_POOLS] + l * 256; const float* wb = a.in[I_WBRPOOL] + (size_t)l * 256 * DM;
      bf16_t* o = (bf16_t*)(ws + WS_WBR) + (size_t)3 * DM * 256;
      for (int i = gt; i < 256 * DM; i += NGT) { const int n = i & 1023, cp = i >> 10, g = cp >> 6, c = cp & 63; float acc = 0.f;
          for (int d = 0; d < 64; ++d) acc += wp[(g * 64 + c) * 64 + d] * sc[g * 64 + d] * wb[(size_t)(g * 64 + d) * DM + n];
          o[(size_t)n * 256 + cp] = (bf16_t)f2bf(acc); } }
}

__device__ __forceinline__ void phase_s0(const Args& a, LAS unsigned char* lds, int tid) {
    const int G = gridDim.x, gt = blockIdx.x * 512 + tid, NGT = G * 512;
    const int* pos = (const int*)a.in[I_POS];
    float* rc = (float*)(a.ws + WS_ROPEC); float* rsn = (float*)(a.ws + WS_ROPES);
    for (int i = gt; i < MTOK * 16; i += NGT) { const int tok = i >> 4, k = i & 15;
        const int k3 = k & 3, k2 = k >> 2;
        const double b = k3 == 0 ? 1.0 : k3 == 1 ? 0.5623413251903491 : k3 == 2 ? 0.31622776601683794 : 0.1778279410038923;
        const double p10 = k2 == 0 ? 1.0 : k2 == 1 ? 0.1 : k2 == 2 ? 0.01 : 0.001;
        const double rev = (double)pos[tok] * (b * p10) * 0.15915494309189535;
        const float fr = (float)(rev - __builtin_rint(rev));
        rc[i] = __builtin_amdgcn_cosf(fr); rsn[i] = __builtin_amdgcn_sinf(fr); }
    const int lane = tid & 63, wave = tid >> 6, gw = blockIdx.x * 8 + wave, NGW = G * 8;
    const float* x = a.in[I_X]; float* xo = a.out; bf16_t* xb = (bf16_t*)(a.ws + WS_XBF); float* rs = (float*)(a.ws + WS_RS);
    for (int row = gw; row < MTOK; row += NGW) {
        const float* xr = x + (size_t)row * DM + 8 * lane; float* xw = xo + (size_t)row * DM + 8 * lane; bf16_t* bw = xb + (size_t)row * DM + 8 * lane;
        float ss = 0.f;
#pragma unroll
        for (int j = 0; j < 2; ++j) { const f32x4 v0 = *(const f32x4*)(xr + 512 * j), v1 = *(const f32x4*)(xr + 512 * j + 4);
            ss += v0.x * v0.x + v0.y * v0.y + v0.z * v0.z + v0.w * v0.w + v1.x * v1.x + v1.y * v1.y + v1.z * v1.z + v1.w * v1.w;
            *(f32x4*)(xw + 512 * j) = v0; *(f32x4*)(xw + 512 * j + 4) = v1;
            u32x4 o; o.x = pk2(v0.x, v0.y); o.y = pk2(v0.z, v0.w); o.z = pk2(v1.x, v1.y); o.w = pk2(v1.z, v1.w); *(u32x4*)(bw + 512 * j) = o; }
        ss = wave_sum(ss);
        if (lane == 0) rs[row] = 1.0f / sqrtf(ss * (1.0f / DM) + EPS);
    }
}

__device__ __forceinline__ void phase_nr(const Args& a, const float* gpost, size_t ysrc, int tid) {
    const int G = gridDim.x, lane = tid & 63, wave = tid >> 6, gw = blockIdx.x * 8 + wave, NGW = G * 8;
    float* xo = a.out; bf16_t* xb = (bf16_t*)(a.ws + WS_XBF); float* rs = (float*)(a.ws + WS_RS); const bf16_t* y = (const bf16_t*)(a.ws + ysrc);
    for (int row = gw; row < MTOK; row += NGW) {
        float* xw = xo + (size_t)row * DM + 8 * lane; bf16_t* bw = xb + (size_t)row * DM + 8 * lane; const bf16_t* yr = y + (size_t)row * DM + 8 * lane;
        float yv[2][8]; float ss = 0.f;
#pragma unroll
        for (int j = 0; j < 2; ++j) { const u32x4 w = *(const u32x4*)(yr + 512 * j);
            yv[j][0] = bflo(w.x); yv[j][1] = bfhi(w.x); yv[j][2] = bflo(w.y); yv[j][3] = bfhi(w.y); yv[j][4] = bflo(w.z); yv[j][5] = bfhi(w.z); yv[j][6] = bflo(w.w); yv[j][7] = bfhi(w.w);
#pragma unroll
            for (int e = 0; e < 8; ++e) ss += yv[j][e] * yv[j][e]; }
        ss = wave_sum(ss);
        const float ry = 1.0f / sqrtf(ss * (1.0f / DM) + EPS);
        float xs = 0.f; float xn[2][8];
#pragma unroll
        for (int j = 0; j < 2; ++j) { const f32x4 x0 = *(const f32x4*)(xw + 512 * j), x1 = *(const f32x4*)(xw + 512 * j + 4);
            const f32x4 g0 = *(const f32x4*)(gpost + 8 * lane + 512 * j), g1 = *(const f32x4*)(gpost + 8 * lane + 512 * j + 4);
#pragma unroll
            for (int e = 0; e < 4; ++e) { xn[j][e] = x0[e] + yv[j][e] * ry * g0[e]; xn[j][4 + e] = x1[e] + yv[j][4 + e] * ry * g1[e]; }
#pragma unroll
            for (int e = 0; e < 8; ++e) xs += xn[j][e] * xn[j][e];
            *(f32x4*)(xw + 512 * j) = (f32x4){xn[j][0], xn[j][1], xn[j][2], xn[j][3]}; *(f32x4*)(xw + 512 * j + 4) = (f32x4){xn[j][4], xn[j][5], xn[j][6], xn[j][7]};
            u32x4 o; o.x = pk2(xn[j][0], xn[j][1]); o.y = pk2(xn[j][2], xn[j][3]); o.z = pk2(xn[j][4], xn[j][5]); o.w = pk2(xn[j][6], xn[j][7]); *(u32x4*)(bw + 512 * j) = o; }
        xs = wave_sum(xs);
        if (lane == 0) rs[row] = 1.0f / sqrtf(xs * (1.0f / DM) + EPS);
    }
}

__device__ __forceinline__ void unpack8(const u32x4 w, float (&f)[8]) { f[0] = bflo(w.x); f[1] = bfhi(w.x); f[2] = bflo(w.y); f[3] = bfhi(w.y); f[4] = bflo(w.z); f[5] = bfhi(w.z); f[6] = bflo(w.w); f[7] = bfhi(w.w); }
__device__ __forceinline__ u32x4 pack8(const float (&f)[8]) { u32x4 o; o.x = pk2(f[0], f[1]); o.y = pk2(f[2], f[3]); o.z = pk2(f[4], f[5]); o.w = pk2(f[6], f[7]); return o; }

__device__ __forceinline__ void phase_e1(const Args& a, int l, LAS unsigned char* lds, int tid) {
    const int lane = tid & 63, wid = __builtin_amdgcn_readfirstlane(tid >> 6), r32 = lane & 31, hi = lane >> 5;
    unsigned char* ws = a.ws;
    const bf16_t* P = (const bf16_t*)(ws + WS_PROJ); bf16_t* CQN = (bf16_t*)(ws + WS_CQN); bf16_t* CKVN = (bf16_t*)(ws + WS_CKVN); bf16_t* KR = (bf16_t*)(ws + WS_KR);
    bf16_t* BR = (bf16_t*)(ws + WS_BR); const float* rc = (const float*)(ws + WS_ROPEC); const float* rsn = (const float*)(ws + WS_ROPES);
    const bf16_t* SGWB = (const bf16_t*)(ws + WS_SGW);
    const float* convw = a.in[I_CONVW] + l * 3 * 256; const float* lng = a.in[I_LNG] + l * 256; const float* lnb = a.in[I_LNB] + l * 256; const float* sgb = a.in[I_SGB] + l * 512;
    for (int tile = blockIdx.x; tile < MTOK / 128; tile += gridDim.x) {
        const int R0 = tile * 128, s0 = R0 & (SEQ - 1);
        for (int i = 0; i < 16; ++i) { const int row = R0 + wid * 16 + i; const bf16_t* pr = P + (size_t)row * 2048;
            const u32x2 cq = *(const u32x2*)(pr + 4 * lane); const float q0 = bflo(cq.x), q1 = bfhi(cq.x), q2 = bflo(cq.y), q3 = bfhi(cq.y);
            const unsigned ck = *(const unsigned*)(pr + 256 + 2 * lane); const float k0 = bflo(ck), k1 = bfhi(ck);
            const float sq = wave_sum(q0 * q0 + q1 * q1 + q2 * q2 + q3 * q3), sk = wave_sum(k0 * k0 + k1 * k1);
            const float rq = 1.0f / sqrtf(sq * (1.0f / 256.0f) + EPS), rk = 1.0f / sqrtf(sk * (1.0f / 128.0f) + EPS);
            u32x2 oq; oq.x = pk2(q0 * rq, q1 * rq); oq.y = pk2(q2 * rq, q3 * rq); *(u32x2*)(CQN + (size_t)row * 256 + 4 * lane) = oq;
            *(unsigned*)(CKVN + (size_t)row * 128 + 2 * lane) = pk2(k0 * rk, k1 * rk);
            if (lane < 16) { const float x1 = bf2f(pr[384 + lane]), x2 = bf2f(pr[400 + lane]); const float c = rc[(size_t)row * 16 + lane], s = rsn[(size_t)row * 16 + lane];
                KR[(size_t)row * 32 + lane] = (bf16_t)f2bf(x1 * c - x2 * s); KR[(size_t)row * 32 + 16 + lane] = (bf16_t)f2bf(x2 * c + x1 * s); } }
        for (int it = 0; it < 8; ++it) { const int id = it * 512 + tid, ch = id & 31, t = id >> 5, row = R0 + t, s = s0 + t; const bf16_t* pr = P + (size_t)row * 2048 + 8 * ch;
            { float bg[8], y[8]; unpack8(*(const u32x4*)(pr + 1280), bg);
#pragma unroll
              for (int e = 0; e < 8; ++e) y[e] = 0.f;
#pragma unroll
              for (int k = 0; k < 3; ++k) { const int dt = k - 2; if (s + dt >= 0) { float xv[8], cv[8]; unpack8(*(const u32x4*)(pr + dt * 2048 + 1024), xv); unpack8(*(const u32x4*)(pr + dt * 2048 + 1536), cv);
                      const f32x4 w0 = *(const f32x4*)(convw + k * 256 + 8 * ch), w1 = *(const f32x4*)(convw + k * 256 + 8 * ch + 4);
#pragma unroll
                      for (int e = 0; e < 4; ++e) { y[e] += w0[e] * (xv[e] * cv[e]); y[4 + e] += w1[e] * (xv[4 + e] * cv[4 + e]); } } }
#pragma unroll
              for (int e = 0; e < 8; ++e) y[e] *= bg[e];
              *(u32x4*)(BR + (size_t)row * DM + 512 + 8 * ch) = pack8(y); }
            { const int g = ch >> 3, win = 2 << g; float acc[8], pt[8]; unpack8(*(const u32x4*)(pr + 1792), pt);
#pragma unroll
              for (int e = 0; e < 8; ++e) acc[e] = pt[e];
              const int cnt = (s + 1) < win ? (s + 1) : win;
              for (int i = 1; i < cnt; ++i) { float pv[8]; unpack8(*(const u32x4*)(pr - i * 2048 + 1792), pv);
#pragma unroll
                  for (int e = 0; e < 8; ++e) acc[e] += pv[e]; }
              const float ic = 1.0f / (float)cnt;
#pragma unroll
              for (int e = 0; e < 8; ++e) acc[e] = acc[e] * ic - pt[e];
              *(u32x4*)(BR + (size_t)row * DM + 768 + 8 * ch) = pack8(acc); } }
        { const int srow = tid >> 2, qt = tid & 3; const bf16_t* vp = P + (size_t)(R0 + srow) * 2048 + 768 + qt * 64;
          float v[64]; float sum = 0.f;
#pragma unroll
          for (int j = 0; j < 8; ++j) { const u32x4 w = *(const u32x4*)(vp + 8 * j);
              v[8 * j + 0] = bflo(w.x); v[8 * j + 1] = bfhi(w.x); v[8 * j + 2] = bflo(w.y); v[8 * j + 3] = bfhi(w.y); v[8 * j + 4] = bflo(w.z); v[8 * j + 5] = bfhi(w.z); v[8 * j + 6] = bflo(w.w); v[8 * j + 7] = bfhi(w.w); }
#pragma unroll
          for (int j = 0; j < 64; ++j) sum += v[j];
          sum += __shfl_xor(sum, 1); sum += __shfl_xor(sum, 2);
          const float mean = sum * (1.0f / 256.0f); float var = 0.f;
#pragma unroll
          for (int j = 0; j < 64; ++j) { v[j] -= mean; var += v[j] * v[j]; }
          var += __shfl_xor(var, 1); var += __shfl_xor(var, 2);
          const float rstd = 1.0f / sqrtf(var * (1.0f / 256.0f) + EPS);
          LAS bf16_t* vT = (LAS bf16_t*)lds;
#pragma unroll
          for (int j = 0; j < 64; ++j) { const int c = qt * 64 + j; vT[c * 136 + srow] = (bf16_t)f2bf(v[j] * rstd * lng[c] + lnb[c]); } }
        __syncthreads();
        { const int g = wid >> 1, th = wid & 1;
#pragma unroll
          for (int tb = 0; tb < 2; ++tb)
#pragma unroll
              for (int cb = 0; cb < 2; ++cb) { f32x16 acc;
#pragma unroll
                  for (int r = 0; r < 16; ++r) acc[r] = 0.f;
                  const bf16_t* ap = SGWB + (size_t)(g * 128 + 64 * th + 32 * tb + r32) * 128 + 8 * hi;
                  const LAS unsigned char* bp = lds + (g * 64 + 32 * cb + r32) * 272 + 16 * hi;
                  const int nks = (64 * th + 32 * tb + 32) >> 4;
                  for (int ks = 0; ks < nks; ++ks) { const bf16x8 A = *(const bf16x8*)(ap + 16 * ks); const bf16x8 B = *(const LAS bf16x8*)(bp + 32 * ks); acc = MFMA32(A, B, acc); }
#pragma unroll
                  for (int r = 0; r < 16; ++r) { const int t = 64 * th + 32 * tb + crow(r, hi), c = g * 64 + 32 * cb + r32;
                      const float val = acc[r] + sgb[g * 128 + t]; const float u = bf2f(P[(size_t)(R0 + t) * 2048 + 512 + c]);
                      BR[(size_t)(R0 + t) * DM + 256 + c] = (bf16_t)f2bf(u * val); } } }
        __syncthreads();
    }
}

constexpr int KPITCH = 208, VPITCH = 136, KBUF = 64 * KPITCH, VBUF = 64 * VPITCH, ATT_V0 = 2 * KBUF, ATT_WS = ATT_V0 + 2 * VBUF;
__device__ __forceinline__ void attn_unit(const Args& a, int b, int h, int qb, LAS unsigned char* lds, int tid) {
    const int lane = tid & 63, wid = __builtin_amdgcn_readfirstlane(tid >> 6), r32 = lane & 31, hi = lane >> 5;
    unsigned char* ws = a.ws;
    const bf16_t* Q = (const bf16_t*)(ws + WS_Q); const bf16_t* Kn = (const bf16_t*)(ws + WS_KN); const bf16_t* Kr = (const bf16_t*)(ws + WS_KR); const bf16_t* Vt = (const bf16_t*)(ws + WS_VT);
    bf16_t* O = (bf16_t*)(ws + WS_BR); const float* rc = (const float*)(ws + WS_ROPEC); const float* rsn = (const float*)(ws + WS_ROPES);
    const size_t rowbase = (size_t)b * SEQ; const int qw0 = qb * 256 + wid * 32;
    LAS float* wsf = (LAS float*)(lds + ATT_WS) + wid * 64;
    bf16x8 qf[6];
    { const size_t qrow = rowbase + qw0 + r32; const bf16_t* qp = Q + qrow * 512 + h * 96 + 8 * hi;
#pragma unroll
      for (int ks = 0; ks < 4; ++ks) qf[ks] = *(const bf16x8*)(qp + 16 * ks);
      const bf16x8 x1 = *(const bf16x8*)(qp + 64), x2 = *(const bf16x8*)(qp + 80);
      const float* cp = rc + qrow * 16 + 8 * hi; const float* sp = rsn + qrow * 16 + 8 * hi;
      const f32x4 c0 = *(const f32x4*)cp, c1 = *(const f32x4*)(cp + 4), s0 = *(const f32x4*)sp, s1 = *(const f32x4*)(sp + 4);
      bf16x8 o1, o2;
#pragma unroll
      for (int j = 0; j < 8; ++j) { const float xa = bf2f((bf16_t)x1[j]), xb = bf2f((bf16_t)x2[j]); const float c = j < 4 ? c0[j & 3] : c1[j & 3], s = j < 4 ? s0[j & 3] : s1[j & 3];
          o1[j] = (short)f2bf(xa * c - xb * s); o2[j] = (short)f2bf(xb * c + xa * s); }
      qf[4] = o1; qf[5] = o2; }
    const int krow = tid >> 3, kch = tid & 7;
    const bf16_t* knp = Kn + (rowbase + krow) * 256 + h * 64 + kch * 8;
    const bf16_t* krp = Kr + (rowbase + (tid >> 2)) * 32 + (tid & 3) * 8;
    const bf16_t* vtp = Vt + (size_t)(h * 64 + krow) * MTOK + rowbase + kch * 8;
    const bool rope_loader = wid < 4;
    u32x4 gk, gr, gv;
#define ATT_LOAD(t) do { gk = *(const u32x4*)(knp + (size_t)(t) * 64 * 256); if (rope_loader) gr = *(const u32x4*)(krp + (size_t)(t) * 64 * 32); gv = *(const u32x4*)(vtp + (size_t)(t) * 64); } while (0)
#define ATT_STORE(bf) do { *(LAS u32x4*)(lds + (bf) * KBUF + krow * KPITCH + kch * 16) = gk; if (rope_loader) *(LAS u32x4*)(lds + (bf) * KBUF + (tid >> 2) * KPITCH + 128 + (tid & 3) * 16) = gr; \
        *(LAS u32x2*)(lds + ATT_V0 + (bf) * VBUF + krow * VPITCH + kch * 16) = (u32x2){gv.x, gv.y}; *(LAS u32x2*)(lds + ATT_V0 + (bf) * VBUF + krow * VPITCH + kch * 16 + 8) = (u32x2){gv.z, gv.w}; } while (0)
    float mref = -INFINITY, lsum = 0.f; f32x16 o0, o1;
#pragma unroll
    for (int r = 0; r < 16; ++r) { o0[r] = 0.f; o1[r] = 0.f; }
    const int NT = 4 * qb + 4;
    ATT_LOAD(0); ATT_STORE(0); __syncthreads();
    for (int t = 0; t < NT; ++t) {
        const int buf = t & 1;
        if (t + 1 < NT) ATT_LOAD(t + 1);
        if (64 * t <= qw0 + 31) {
            f32x16 p0, p1;
#pragma unroll
            for (int r = 0; r < 16; ++r) { p0[r] = 0.f; p1[r] = 0.f; }
            const LAS unsigned char* kb = lds + buf * KBUF + r32 * KPITCH + hi * 16;
#pragma unroll
            for (int ks = 0; ks < 6; ++ks) { const bf16x8 a0 = *(const LAS bf16x8*)(kb + ks * 32), a1 = *(const LAS bf16x8*)(kb + 32 * KPITCH + ks * 32);
                p0 = MFMA32(a0, qf[ks], p0); p1 = MFMA32(a1, qf[ks], p1); }
            if (64 * t + 63 > qw0) { const int qg = qw0 + r32;
#pragma unroll
                for (int r = 0; r < 16; ++r) { const int kv = 64 * t + crow(r, hi); if (kv > qg) p0[r] = -INFINITY; if (kv + 32 > qg) p1[r] = -INFINITY; } }
            float rm = fmaxf(p0[0], p1[0]);
#pragma unroll
            for (int r = 1; r < 16; ++r) rm = fmaxf(rm, fmaxf(p0[r], p1[r]));
            rm = fmaxf(rm, __shfl_xor(rm, 32));
            if (__any(rm > mref + 8.0f)) {
                const float mnew = fmaxf(mref, rm); const float alpha = __builtin_amdgcn_exp2f(mref - mnew);
                lsum *= alpha; mref = mnew;
                if (hi == 0) wsf[r32] = alpha;
                asm volatile("s_waitcnt lgkmcnt(0)" ::: "memory");
#pragma unroll
                for (int r = 0; r < 16; ++r) { const float f = wsf[crow(r, hi)]; o0[r] *= f; o1[r] *= f; }
            }
            float ps = 0.f;
#pragma unroll
            for (int r = 0; r < 16; ++r) { p0[r] = __builtin_amdgcn_exp2f(p0[r] - mref); p1[r] = __builtin_amdgcn_exp2f(p1[r] - mref); ps += p0[r] + p1[r]; }
            lsum += ps;
            bf16x8 pa[4];
            { u32x4 w;
              w.x = pg8::cvt_pk_bf16(p0[0], p0[1]); w.y = pg8::cvt_pk_bf16(p0[2], p0[3]); w.z = pg8::cvt_pk_bf16(p0[4], p0[5]); w.w = pg8::cvt_pk_bf16(p0[6], p0[7]); pa[0] = __builtin_bit_cast(bf16x8, w);
              w.x = pg8::cvt_pk_bf16(p0[8], p0[9]); w.y = pg8::cvt_pk_bf16(p0[10], p0[11]); w.z = pg8::cvt_pk_bf16(p0[12], p0[13]); w.w = pg8::cvt_pk_bf16(p0[14], p0[15]); pa[1] = __builtin_bit_cast(bf16x8, w);
              w.x = pg8::cvt_pk_bf16(p1[0], p1[1]); w.y = pg8::cvt_pk_bf16(p1[2], p1[3]); w.z = pg8::cvt_pk_bf16(p1[4], p1[5]); w.w = pg8::cvt_pk_bf16(p1[6], p1[7]); pa[2] = __builtin_bit_cast(bf16x8, w);
              w.x = pg8::cvt_pk_bf16(p1[8], p1[9]); w.y = pg8::cvt_pk_bf16(p1[10], p1[11]); w.z = pg8::cvt_pk_bf16(p1[12], p1[13]); w.w = pg8::cvt_pk_bf16(p1[14], p1[15]); pa[3] = __builtin_bit_cast(bf16x8, w); }
            const LAS unsigned char* vb = lds + ATT_V0 + buf * VBUF + r32 * VPITCH + hi * 8;
#pragma unroll
            for (int kk = 0; kk < 4; ++kk) {
                const s16x4 l0 = *(const LAS s16x4*)(vb + kk * 32), h0 = *(const LAS s16x4*)(vb + kk * 32 + 16);
                const s16x4 l1 = *(const LAS s16x4*)(vb + 32 * VPITCH + kk * 32), h1 = *(const LAS s16x4*)(vb + 32 * VPITCH + kk * 32 + 16);
                const bf16x8 v0 = __builtin_shufflevector(l0, h0, 0, 1, 2, 3, 4, 5, 6, 7), v1 = __builtin_shufflevector(l1, h1, 0, 1, 2, 3, 4, 5, 6, 7);
                o0 = MFMA32(pa[kk], v0, o0); o1 = MFMA32(pa[kk], v1, o1); }
        }
        if (t + 1 < NT) ATT_STORE((t + 1) & 1);
        __syncthreads();
    }
#undef ATT_LOAD
#undef ATT_STORE
    lsum += __shfl_xor(lsum, 32);
    if (hi == 0) wsf[32 + r32] = 1.0f / lsum;
    asm volatile("s_waitcnt lgkmcnt(0)" ::: "memory");
#pragma unroll
    for (int r = 0; r < 16; ++r) { const int qr = crow(r, hi); const float inv = wsf[32 + qr]; bf16_t* op = O + (rowbase + qw0 + qr) * DM + h * 64 + r32;
        op[0] = (bf16_t)f2bf(o0[r] * inv); op[32] = (bf16_t)f2bf(o1[r] * inv); }
}
__device__ __forceinline__ void phase_attn(const Args& a, LAS unsigned char* lds, int tid) {
    const int G = gridDim.x, bx = blockIdx.x; const int v0 = (G % 8 == 0) ? (bx % 8) * (G / 8) + bx / 8 : bx;
    for (int v = v0; v < 256; v += G) { const int bh = v >> 4, s = v & 15;
        attn_unit(a, bh >> 2, bh & 3, 31 - s, lds, tid);
        attn_unit(a, bh >> 2, bh & 3, s, lds, tid); }
}

#define XB_TMO      128
#define XB_XCNT(j)  (256  + 64 * (j))
#define XB_XSUB(j)  (1280 + 64 * (j))
#define XB_XGEN(j)  (2304 + 64 * (j))
#define XB_TOP      3328
#define XB_TOPGEN   3392
#define XCD_BAR_WORDS 3456
#define XB_SPIN_CAP (1u << 18)

__device__ __forceinline__ unsigned xb_ld(unsigned* p)              { return __hip_atomic_load(p, __ATOMIC_RELAXED, __HIP_MEMORY_SCOPE_AGENT); }
__device__ __forceinline__ unsigned xb_add(unsigned* p, unsigned v) { return __hip_atomic_fetch_add(p, v, __ATOMIC_RELAXED, __HIP_MEMORY_SCOPE_AGENT); }
__device__ __forceinline__ unsigned xb_xcc_id() { return (unsigned)__builtin_amdgcn_s_getreg((3 << 11) | 20) & 0xFu; }
#define XB_SPIN(cond, bar) do { unsigned _sp = 0; while (cond) { __builtin_amdgcn_s_sleep(1); \
    if ((++_sp & 255u) == 0u) { if (xb_ld(&(bar)[XB_TMO])) break; if (_sp > XB_SPIN_CAP) { atomicAdd(&(bar)[XB_TMO], 1u); break; } } } } while (0)

struct XcdBarrier {
    unsigned* bar; unsigned x;
    volatile LAS unsigned* st;
};

__device__ __forceinline__ XcdBarrier xcd_barrier_post(unsigned* bar, volatile LAS unsigned* st) {
    XcdBarrier b; b.bar = bar; b.x = xb_xcc_id(); b.st = st;
    if (threadIdx.x == 0) (void)xb_add(&bar[XB_XCNT(b.x)], 1u);
    return b;
}
__device__ __forceinline__ void xcd_barrier_complete(unsigned* bar, unsigned x, unsigned& nloc, unsigned& nx) {
    const unsigned G = gridDim.x * gridDim.y * gridDim.z;
    unsigned sum, cnt, mine, sp = 0u;
    for (;;) {
        sum = 0u; cnt = 0u; mine = 0u;
#pragma unroll
        for (unsigned j = 0; j < 16; ++j) { const unsigned c = xb_ld(&bar[XB_XCNT(j)]); sum += c; cnt += (c > 0u) ? 1u : 0u; mine = (j == x) ? c : mine; }
        if (sum == G) break;
        __builtin_amdgcn_s_sleep(1);
        if ((++sp & 255u) == 0u) { if (xb_ld(&bar[XB_TMO])) break; if (sp > XB_SPIN_CAP) { atomicAdd(&bar[XB_TMO], 1u); break; } }
    }
    nloc = mine > 0u ? mine : 1u; nx = cnt > 0u ? cnt : 1u;
}

__device__ __forceinline__ void xcd_barrier(const XcdBarrier& b) {
    asm volatile("s_waitcnt vmcnt(0)" ::: "memory");
    __syncthreads();
    if (threadIdx.x == 0) {
        unsigned* bar = b.bar;
        __builtin_amdgcn_s_waitcnt(0);
        unsigned nloc = b.st[0], nx = b.st[1];
        if (nloc == 0u) { xcd_barrier_complete(bar, b.x, nloc, nx); b.st[0] = nloc; b.st[1] = nx; }
        const unsigned old = xb_add(&bar[XB_XSUB(b.x)], 1u);
        const unsigned gen = old / nloc;
        if (old + 1u == (gen + 1u) * nloc) {
            __builtin_amdgcn_fence(__ATOMIC_RELEASE, "agent");
            asm volatile("s_waitcnt vmcnt(0)" ::: "memory");
            const unsigned og = xb_add(&bar[XB_TOP], 1u);
            const unsigned tg = og / nx;
            if (og + 1u == (tg + 1u) * nx) xb_add(&bar[XB_TOPGEN], 1u);
            else XB_SPIN(xb_ld(&bar[XB_TOPGEN]) == tg, bar);
            __builtin_amdgcn_fence(__ATOMIC_ACQUIRE, "agent");
            xb_add(&bar[XB_XGEN(b.x)], 1u);
            asm volatile("s_waitcnt vmcnt(0)" ::: "memory");
        } else {
            XB_SPIN(xb_ld(&bar[XB_XGEN(b.x)]) == gen, bar);
            __builtin_amdgcn_fence(__ATOMIC_ACQUIRE, "agent");
            asm volatile("s_waitcnt vmcnt(0)" ::: "memory");
        }
    }
    __syncthreads();
}

__global__ void __launch_bounds__(512, 2) mk_fwd(Args a) {
    extern __shared__ __attribute__((aligned(16))) unsigned char lds_raw[];
    LAS unsigned char* lds = (LAS unsigned char*)lds_raw;
    cg::grid_group grid = cg::this_grid();
    const int tid0 = threadIdx.x, G = gridDim.x, bx = blockIdx.x;
    { volatile LAS unsigned* st0 = (volatile LAS unsigned*)(lds + 131072 + 64); if (tid0 == 0) { st0[0] = 0u; st0[1] = 0u; } }
    __syncthreads();
    XcdBarrier xbar = xcd_barrier_post((unsigned*)a.ws, (volatile LAS unsigned*)(lds + 131072 + 64));
    for (int ph = a.lo; ph < a.hi; ++ph) {
        unsigned char* ws = a.ws; int tid = tid0;
        asm volatile("" : "+s"(ws), "+v"(tid));
        int l = 0, k = -1; if (ph > 0) { l = (ph - 1) / 11; k = (ph - 1) % 11; }
        const int ng = (k == 0 || k == 4 || k == 5 || k == 6 || k == 8 || k == 9) ? 1 : (k == 2 ? 3 : 0);
#ifndef PM
#define PM 0xFF
#endif
        if (PM & 1) for (int j = 0; j < ng; ++j) {
            size_t oA, oB, oO; int M_ = MTOK, N_ = DM, K_ = DM, lda = DM, ldb = DM, ldc = DM, mode = 0, nbr = 1, coff = 0, use_rs = 0, zs = 0, bmode = 0;
            if (k == 0) {
                oA = WS_XBF; oB = WS_WIN; oO = WS_BIG; N_ = 2048; ldc = 2048; use_rs = 1; mode = 1;
            } else if (k == 2) {
                if (j == 0) { oA = WS_CQN; oB = WS_WUQ; oO = WS_Q; N_ = 512; K_ = 256; lda = 256; ldb = 256; ldc = 512; }
                else if (j == 1) { oA = WS_CKVN; oB = WS_WK; oO = WS_KN; N_ = 256; K_ = 128; lda = 128; ldb = 128; ldc = 256; }
                else { oA = WS_WV; oB = WS_CKVN; oO = WS_VT; M_ = 256; N_ = MTOK; K_ = 128; lda = 128; ldb = 128; ldc = MTOK; coff = G / 2; }
            } else if (k == 4) {
                oA = WS_BR; oB = WS_WBR; oO = WS_BIG; K_ = 256; ldb = 256; ldc = 4096; nbr = 4; zs = 1024;
            } else if (k == 5) {
                oA = WS_XBF; oB = WS_WIN + (size_t)2048 * DM * 2; oO = WS_BR; N_ = 4096; use_rs = 1; mode = 5; bmode = 1;
            } else if (k == 6) {
                oA = WS_BR; oB = WS_WOUT; oO = WS_BIG;
            } else if (k == 8) {
                oA = WS_XBF; oB = WS_W1; oO = WS_BIG; N_ = DFF; ldc = DFF; use_rs = 1; mode = 3;
            } else {
                oA = WS_BIG; oB = WS_W2; oO = WS_BR; K_ = DFF; lda = DFF; ldb = DFF;
            }
            pg8::Gemm g{(const bf16_t*)(ws + oA), (const bf16_t*)(ws + oB), M_, N_, K_, lda, ldb, bmode};
            pg8::EpiRT E{(bf16_t*)(ws + oO), ldc, use_rs ? (const float*)(ws + WS_RS) : nullptr, a.in[I_GATEB] + l * 4096, (const bf16_t*)(ws + WS_BIG), mode, zs};
            pg8::MergeOrder S; S.init(M_, N_, G, (bx + coff) % G, nbr);
            pg8::gemm_phase<pg8::EpiRT, pg8::MergeOrder, true, true>(lds, g, S, E, tid);
        }
        if ((PM & 2) && k == 1) phase_e1(a, l, lds, tid);
        if ((PM & 4) && k == 3) phase_attn(a, lds, tid);
        if ((PM & 8) && (k == 7 || k == 10)) phase_nr(a, (k == 7 ? a.in[I_NPOST] : a.in[I_NFPOST]) + l * DM, k == 7 ? WS_BIG : WS_BR, tid);
        if ((PM & 16) && ph == 0) phase_s0(a, lds, tid);
        if ((PM & 32) && (ph == 0 || (k == 10 && l + 1 < NLAYER))) prep_weights(a, ph == 0 ? 0 : l + 1, lds, tid);
        if (ph + 1 < a.hi) { if (ph == a.lo) grid.sync(); else xcd_barrier(xbar); }
    }
}

constexpr int NPHASE = 1 + 11 * NLAYER;
#ifndef MK_ONE_LAUNCH
#define MK_ONE_LAUNCH 1
#endif
extern "C" void kernel_launch(void* const* d_in, const int* in_sizes, int n_in, void* d_out, int out_size, void* d_ws, size_t ws_size, hipStream_t stream) {
    static int grid = 0;
    if (grid == 0) {
        if (n_in != 26 || out_size != MTOK * DM || ws_size < WS_END) { fprintf(stderr, "kernel_launch: unexpected shapes (n_in %d out %d ws %zu)\n", n_in, out_size, ws_size); grid = -1; return; }
        int dev = 0, cus = 0, per_cu = 0;
        hipGetDevice(&dev); hipDeviceGetAttribute(&cus, hipDeviceAttributeMultiprocessorCount, dev);
        hipFuncSetAttribute((const void*)mk_fwd, hipFuncAttributeMaxDynamicSharedMemorySize, LDS_BYTES);
        hipOccupancyMaxActiveBlocksPerMultiprocessor(&per_cu, (const void*)mk_fwd, 512, LDS_BYTES);
        if (per_cu < 1) { fprintf(stderr, "kernel_launch: occupancy query says %d blocks per CU\n", per_cu); per_cu = 1; }
        (void)hipGetLastError();
        grid = cus;
    }
    if (grid < 0) return;
    Args a{};
    for (int i = 0; i < 26; ++i) a.in[i] = (const float*)d_in[i];
    a.out = (float*)d_out; a.ws = (unsigned char*)d_ws;
    if (hipMemsetAsync(d_ws, 0, 16384, stream) != hipSuccess) { fprintf(stderr, "memset failed\n"); return; }
#if MK_ONE_LAUNCH
    a.lo = 0; a.hi = NPHASE;
    { void* args[] = {&a}; hipError_t e = hipLaunchCooperativeKernel((const void*)mk_fwd, dim3(grid), dim3(512), args, LDS_BYTES, stream);
      if (e != hipSuccess) fprintf(stderr, "cooperative launch failed: %s (grid %d)\n", hipGetErrorString(e), grid); }
#else
    for (int ph = 0; ph < NPHASE; ++ph) { a.lo = ph; a.hi = ph + 1;
        void* args[] = {&a}; hipError_t e = hipLaunchCooperativeKernel((const void*)mk_fwd, dim3(grid), dim3(512), args, LDS_BYTES, stream);
        if (e != hipSuccess) { fprintf(stderr, "launch %d failed: %s (grid %d)\n", ph, hipGetErrorString(e), grid); break; } }
#endif
}
```

```cpp
#include <hip/hip_runtime.h>
#include <hip/hip_cooperative_groups.h>
#include <cstdio>
#include <cstdint>
namespace cg = cooperative_groups;

#define LAS __attribute__((address_space(3)))
typedef unsigned short bf16_t;
typedef short bf16x8 __attribute__((ext_vector_type(8)));
typedef short s16x4 __attribute__((ext_vector_type(4)));
typedef float f32x4 __attribute__((ext_vector_type(4)));
typedef float f32x2 __attribute__((ext_vector_type(2)));
typedef float f32x16 __attribute__((ext_vector_type(16)));
typedef unsigned u32x4 __attribute__((ext_vector_type(4)));
typedef unsigned u32x2 __attribute__((ext_vector_type(2)));

__device__ __forceinline__ unsigned f2bf(float f) { unsigned u = __builtin_bit_cast(unsigned, f); return (u + 0x7fffu + ((u >> 16) & 1u)) >> 16; }
__device__ __forceinline__ unsigned pk2(float lo, float hi) { return f2bf(lo) | (f2bf(hi) << 16); }
__device__ __forceinline__ float bflo(unsigned w) { return __builtin_bit_cast(float, w << 16); }
__device__ __forceinline__ float bfhi(unsigned w) { return __builtin_bit_cast(float, w & 0xffff0000u); }
__device__ __forceinline__ float bf2f(bf16_t h) { return __builtin_bit_cast(float, ((unsigned)h) << 16); }
__device__ __forceinline__ float wave_sum(float v) {
#pragma unroll
    for (int o = 1; o < 64; o <<= 1) v += __shfl_xor(v, o);
    return v;
}
__device__ __forceinline__ float fast_sigmoid(float v) { return __builtin_amdgcn_rcpf(1.0f + __builtin_amdgcn_exp2f(-1.4426950408889634f * v)); }
__device__ __forceinline__ float gelu_tanh(float x) { const float u = 0.7978845608028654f * (x + 0.044715f * x * x * x); return x * fast_sigmoid(2.0f * u); }

namespace pg8 {
#define PG8_LAS __attribute__((address_space(3)))
constexpr int BM = 256, BK = 64, HALF = 128, HTB = HALF * BK * 2  , STAGE_BYTES = 8 * HTB, NXCD = 8, WGM = 8;

__host__ __device__ __forceinline__ int lds_byte(int r, int c) { const int st = (r >> 4) * 2 + (c >> 5), rr = r & 15, cc = c & 31, ob = rr * 64 + cc * 2; return st * 1024 + (ob ^ (((ob >> 9) & 1) << 5)); }
__host__ __device__ __forceinline__ void stage_rc(int b, int& R, int& C) { const int st = b / 1024, sb = b % 1024, swz = sb ^ (((sb >> 9) & 1) << 5); R = (st >> 1) * 16 + swz / 64; C = (st & 1) * 32 + (swz % 64) / 2; }
__host__ __device__ __forceinline__ int perm32(int rho) { const int n = rho >> 4, i = rho & 15; return 8 * (i >> 2) + 4 * n + (i & 3); }

struct Unit { int pm, pn, bn, ak, z; };
struct Gemm { const bf16_t* A; const bf16_t* Bt; int M, N, K, lda, ldb, bmode; };

struct StaticOrder {
    int nM, nN, nwg, G, c;
    __host__ __device__ void init(int M, int N, int G_, int c_) { nM = M / BM; nN = N / BM; nwg = nM * nN; G = G_; c = c_; }
    __host__ __device__ bool map(long L, Unit& u) const {
        if (L >= nwg) return false;
        int wgid = (int)L; { const int q = nwg / NXCD, r = nwg % NXCD, xcd = wgid % NXCD, off = wgid / NXCD; wgid = (xcd < r ? xcd * (q + 1) : r * (q + 1) + (xcd - r) * q) + off; }
        const int nig = WGM * nN, gid = wgid / nig, fm = gid * WGM, gsz = (nM - fm) < WGM ? (nM - fm) : WGM;
        u.pm = fm + ((wgid % nig) % gsz); u.pn = (wgid % nig) / gsz; return true;
    }
    __host__ __device__ bool next(int i, Unit& u) const { u.ak = 0; u.z = 0; const bool ok = map((long)i * G + c, u); u.bn = u.pn; return ok; }
    __device__ __forceinline__ void a_ready(const Unit&) const {}
    __device__ __forceinline__ void done(const Unit&) const {}
};
struct MergeOrder {
    StaticOrder S; int nbr;
    __host__ __device__ void init(int M, int N, int G_, int c_, int nbr_) { S.init(M, N, G_, c_); nbr = nbr_; }
    __host__ __device__ bool next(int i, Unit& u) const { const int z = i % nbr; const bool ok = S.map((long)(i / nbr) * S.G + S.c, u); u.z = z; u.ak = z * 256; u.bn = z * S.nN + u.pn; return ok; }
    __device__ __forceinline__ void a_ready(const Unit&) const {}
    __device__ __forceinline__ void done(const Unit&) const {}
};

__device__ __forceinline__ unsigned cvt_pk_bf16(float lo, float hi) { unsigned r; asm volatile("v_cvt_pk_bf16_f32 %0, %1, %2" : "=v"(r) : "v"(lo), "v"(hi)); return r; }

struct EpiRT {
    static constexpr bool PERM = true, AFTER_DRAIN = false;
    bf16_t* O; int ldc; const float* rs; const float* bias; const bf16_t* gates; int mode, zs;
    __device__ __forceinline__ void operator()(const f32x4 (&acc)[2][2][4][2], const Unit& u, int wr, int wc, int fr, int fq) const {
        if (mode == 5) {
            const int row0 = u.pm * BM + wr * 64 + fr; const int col = u.pn * 64 + wc * 16 + 4 * fq;
#pragma unroll
            for (int q = 0; q < 4; ++q) { const int ai = q >> 1, mb = (q & 1) * 2;
                u32x2 yw[2][4]; float sc[2];
#pragma unroll
                for (int mm = 0; mm < 2; ++mm) { const int row = row0 + ai * HALF + (mb + mm) * 16; sc[mm] = rs[row]; const bf16_t* yp = gates + (size_t)row * 4096 + col;
#pragma unroll
                    for (int z = 0; z < 4; ++z) yw[mm][z] = *(const u32x2*)(yp + z * 1024); }
#pragma unroll
                for (int mm = 0; mm < 2; ++mm) { const int m = mb + mm; const int row = row0 + ai * HALF + m * 16;
                    f32x4 tot = (f32x4){0.f, 0.f, 0.f, 0.f};
#pragma unroll
                    for (int bj = 0; bj < 2; ++bj)
#pragma unroll
                        for (int n = 0; n < 2; ++n) { const int z = 2 * bj + n; const f32x4 v = acc[ai][bj][m][n] * sc[mm] + *(const f32x4*)(bias + z * 1024 + col); const u32x2 y2 = yw[mm][z];
                            tot[0] += fast_sigmoid(v[0]) * bflo(y2.x); tot[1] += fast_sigmoid(v[1]) * bfhi(y2.x); tot[2] += fast_sigmoid(v[2]) * bflo(y2.y); tot[3] += fast_sigmoid(v[3]) * bfhi(y2.y); }
                    u32x2 w; w.x = cvt_pk_bf16(tot[0], tot[1]); w.y = cvt_pk_bf16(tot[2], tot[3]);
                    *(u32x2*)(O + (size_t)row * ldc + col) = w; }
            }
            return;
        }
        const int row0 = u.pm * BM + wr * 64 + fr; const int col0 = u.pn * BM + wc * 32 + 8 * fq + u.z * zs;
        const int m_eff = (mode == 1) ? ((u.pn == 2 || u.pn == 3) ? 1 : 0) : mode;
#pragma unroll
        for (int ai = 0; ai < 2; ++ai)
#pragma unroll
            for (int m = 0; m < 4; ++m) { const int row = row0 + ai * HALF + m * 16; bf16_t* rowp = O + (size_t)row * ldc + col0;
                const float sc = rs ? rs[row] : 1.0f;
#pragma unroll
                for (int bj = 0; bj < 2; ++bj) { f32x4 v0 = acc[ai][bj][m][0] * sc, v1 = acc[ai][bj][m][1] * sc;
                    if (m_eff == 1) {
#pragma unroll
                        for (int e = 0; e < 4; ++e) { v0[e] = gelu_tanh(v0[e]); v1[e] = gelu_tanh(v1[e]); }
                    } else if (m_eff == 3) {
#pragma unroll
                        for (int e = 0; e < 4; ++e) { const float a = fmaxf(v0[e], 0.f), b = fmaxf(v1[e], 0.f); v0[e] = a * a; v1[e] = b * b; }
                    }
                    u32x4 w; w.x = cvt_pk_bf16(v0[0], v0[1]); w.y = cvt_pk_bf16(v0[2], v0[3]); w.z = cvt_pk_bf16(v1[0], v1[1]); w.w = cvt_pk_bf16(v1[2], v1[3]);
                    *(u32x4*)(rowp + bj * HALF) = w; } }
    }
};

template <class Epi, class Sched, bool ALIGN_EPI = false, bool SP2 = false>
__device__ __forceinline__ void gemm_phase(PG8_LAS unsigned char* lds, const Gemm g, const Sched& S, const Epi& E, const int tid) {
    const int wid = __builtin_amdgcn_readfirstlane(tid >> 6), lane = tid & 63, wr = wid >> 2, wc = wid & 3, fr = lane & 15, fq = lane >> 4;
    const int K = g.K, nt = K / BK;
    unsigned voffA[2], voffB[2];
#pragma unroll
    for (int i = 0; i < 2; ++i) { int R, C; stage_rc(tid * 16 + i * 8192, R, C); const int Rb = g.bmode ? (((R >> 4) & 1) * 1024 + (R >> 5) * 16 + (R & 15)) : ((R & ~31) + perm32(R & 31));
        voffA[i] = (unsigned)(R * g.lda + C) * 2u; voffB[i] = (unsigned)(Rb * g.ldb + C) * 2u; }
    const size_t kstep = (size_t)(BK * 2);
    const size_t hstepA = (size_t)HALF * g.lda * 2, hstepB = (size_t)(g.bmode ? 2048 : HALF) * g.ldb * 2;
    const size_t tstepA = 2 * hstepA, tstepB = (size_t)(g.bmode ? 64 : 256) * g.ldb * 2;
    const unsigned ldsw = (unsigned)wid * 1024u;
    const int aoff = lds_byte(wr * 64 + fr, fq * 8), boff = lds_byte(wc * 32 + fr, fq * 8);
#define PG8_SA(b, h) (((b) * 2 + (h)) * HTB)
#define PG8_SB(b, h) ((4 + (b) * 2 + (h)) * HTB)
#define PG8_STAGE(bufoff, gbase, voff) do { _Pragma("unroll") for (int _i = 0; _i < 2; ++_i) \
        __builtin_amdgcn_global_load_lds((const unsigned*)((const char*)(gbase) + (voff)[_i]), (PG8_LAS unsigned*)(lds + (bufoff) + ldsw + _i * 8192), 16, 0, 0); } while (0)
#define PG8_LDA(dst, b, h) do { _Pragma("unroll") for (int m = 0; m < 4; ++m) _Pragma("unroll") for (int k = 0; k < 2; ++k) dst[m][k] = *(const PG8_LAS bf16x8*)(lds + PG8_SA(b, h) + aoff + m * 2048 + k * 1024); } while (0)
#define PG8_LDB(dst, b, h) do { _Pragma("unroll") for (int n = 0; n < 2; ++n) _Pragma("unroll") for (int k = 0; k < 2; ++k) dst[n][k] = *(const PG8_LAS bf16x8*)(lds + PG8_SB(b, h) + boff + n * 2048 + k * 1024); } while (0)
#define PG8_MMA(ai, bj, At, Bt) do { __builtin_amdgcn_s_setprio(1); _Pragma("unroll") for (int m = 0; m < 4; ++m) _Pragma("unroll") for (int n = 0; n < 2; ++n) _Pragma("unroll") for (int k = 0; k < 2; ++k) \
        acc[ai][bj][m][n] = __builtin_amdgcn_mfma_f32_16x16x32_bf16(Bt[n][k], At[m][k], acc[ai][bj][m][n], 0, 0, 0); __builtin_amdgcn_s_setprio(0); } while (0)
#define PG8_WAIT_V(n) asm volatile("s_waitcnt vmcnt(" #n ")" ::: "memory")
#define PG8_WAIT_L(n) asm volatile("s_waitcnt lgkmcnt(" #n ")" ::: "memory")
#define PG8_BAR __builtin_amdgcn_s_barrier()
#define PG8_SCHED __builtin_amdgcn_sched_barrier(0)
    Unit cur, nxt; int ui = 0;
    if (!S.next(0, cur)) return;
    f32x4 acc[2][2][4][2];
#pragma unroll
    for (int a = 0; a < 2; ++a)
#pragma unroll
        for (int b = 0; b < 2; ++b)
#pragma unroll
            for (int m = 0; m < 4; ++m)
#pragma unroll
                for (int n = 0; n < 2; ++n) acc[a][b][m][n] = (f32x4){0.f, 0.f, 0.f, 0.f};
    bf16x8 At[4][2], B0[2][2], B1[2][2];
    const char* cA = (const char*)g.A + (size_t)cur.pm * tstepA + (size_t)cur.ak * 2; const char* cB = (const char*)g.Bt + (size_t)cur.bn * tstepB;
    S.a_ready(cur);
    if constexpr (SP2) {
        PG8_STAGE(PG8_SB(0, 0), cB, voffB); PG8_STAGE(PG8_SB(0, 1), cB + hstepB, voffB); PG8_STAGE(PG8_SA(0, 0), cA, voffA); PG8_STAGE(PG8_SA(0, 1), cA + hstepA, voffA);
        if (wr == 1) PG8_BAR;
        PG8_WAIT_V(2); PG8_BAR;
        PG8_STAGE(PG8_SB(1, 0), cB + kstep, voffB); PG8_STAGE(PG8_SA(1, 0), cA + kstep, voffA); PG8_STAGE(PG8_SB(1, 1), cB + hstepB + kstep, voffB);
        PG8_WAIT_V(6); PG8_BAR;
    } else {
        PG8_STAGE(PG8_SB(0, 0), cB, voffB); PG8_STAGE(PG8_SA(0, 0), cA, voffA); PG8_STAGE(PG8_SB(0, 1), cB + hstepB, voffB); PG8_STAGE(PG8_SA(0, 1), cA + hstepA, voffA);
        if (wr == 1) PG8_BAR;
        PG8_WAIT_V(4); PG8_BAR;
        PG8_STAGE(PG8_SB(1, 0), cB + kstep, voffB); PG8_STAGE(PG8_SA(1, 0), cA + kstep, voffA); PG8_STAGE(PG8_SB(1, 1), cB + hstepB + kstep, voffB);
        PG8_WAIT_V(6); PG8_BAR;
    }
    for (;;) {
        const bool has_next = S.next(ui + 1, nxt);
        const char* nA = has_next ? (const char*)g.A + (size_t)nxt.pm * tstepA + (size_t)nxt.ak * 2 : cA; const char* nB = has_next ? (const char*)g.Bt + (size_t)nxt.bn * tstepB : cB;
        for (int t = 0; t < nt; t += 2) {
            const bool last = (t == nt - 2);
            const char* a1 = cA + (size_t)(t + 1) * kstep;
            const char* a2 = last ? nA : cA + (size_t)(t + 2) * kstep; const char* b2 = last ? nB : cB + (size_t)(t + 2) * kstep;
            const char* a3 = a2 + kstep; const char* b3 = b2 + kstep;
            if (last && has_next) S.a_ready(nxt);
            if constexpr (SP2) {
            PG8_LDB(B0, 0, 0); PG8_LDB(B1, 0, 1); PG8_SCHED; PG8_LDA(At, 0, 0); PG8_STAGE(PG8_SA(1, 1), a1 + hstepA, voffA);
            PG8_WAIT_V(8); PG8_WAIT_L(0); PG8_BAR; PG8_MMA(0, 0, At, B0); PG8_MMA(0, 1, At, B1); PG8_BAR; PG8_SCHED;
            PG8_LDA(At, 0, 1); PG8_STAGE(PG8_SB(0, 0), b2, voffB); PG8_STAGE(PG8_SB(0, 1), b2 + hstepB, voffB); PG8_STAGE(PG8_SA(0, 0), a2, voffA);
            PG8_WAIT_V(8); PG8_WAIT_L(0); PG8_BAR; PG8_MMA(1, 0, At, B0); PG8_MMA(1, 1, At, B1); PG8_BAR; PG8_SCHED;
            PG8_LDB(B0, 1, 0); PG8_LDB(B1, 1, 1); PG8_SCHED; PG8_LDA(At, 1, 0); PG8_STAGE(PG8_SA(0, 1), a2 + hstepA, voffA);
            PG8_WAIT_V(8); PG8_WAIT_L(0); PG8_BAR; PG8_MMA(0, 0, At, B0); PG8_MMA(0, 1, At, B1); PG8_BAR; PG8_SCHED;
            PG8_LDA(At, 1, 1); PG8_STAGE(PG8_SB(1, 0), b3, voffB); PG8_STAGE(PG8_SB(1, 1), b3 + hstepB, voffB); PG8_STAGE(PG8_SA(1, 0), a3, voffA);
            PG8_WAIT_V(8); PG8_WAIT_L(0); PG8_BAR; PG8_MMA(1, 0, At, B0); PG8_MMA(1, 1, At, B1); PG8_BAR; PG8_SCHED;
            } else {
            PG8_LDB(B0, 0, 0); PG8_SCHED; PG8_LDA(At, 0, 0); PG8_STAGE(PG8_SA(1, 1), a1 + hstepA, voffA);
            PG8_WAIT_L(8); PG8_BAR; PG8_WAIT_L(0); PG8_MMA(0, 0, At, B0); PG8_BAR; PG8_SCHED;
            PG8_LDB(B1, 0, 1); PG8_STAGE(PG8_SB(0, 0), b2, voffB);
            PG8_BAR; PG8_WAIT_L(0); PG8_MMA(0, 1, At, B1); PG8_BAR;
            PG8_LDA(At, 0, 1); PG8_STAGE(PG8_SA(0, 0), a2, voffA);
            PG8_BAR; PG8_WAIT_L(0); PG8_MMA(1, 0, At, B0); PG8_BAR; PG8_SCHED;
            PG8_STAGE(PG8_SB(0, 1), b2 + hstepB, voffB);
            PG8_WAIT_V(6); PG8_BAR; PG8_MMA(1, 1, At, B1); PG8_BAR;
            PG8_LDB(B0, 1, 0); PG8_SCHED; PG8_LDA(At, 1, 0); PG8_STAGE(PG8_SA(0, 1), a2 + hstepA, voffA);
            PG8_WAIT_L(8); PG8_BAR; PG8_WAIT_L(0); PG8_MMA(0, 0, At, B0); PG8_BAR; PG8_SCHED;
            PG8_LDB(B1, 1, 1); PG8_STAGE(PG8_SB(1, 0), b3, voffB);
            PG8_BAR; PG8_WAIT_L(0); PG8_MMA(0, 1, At, B1); PG8_BAR;
            PG8_LDA(At, 1, 1); PG8_STAGE(PG8_SA(1, 0), a3, voffA);
            PG8_BAR; PG8_WAIT_L(0); PG8_MMA(1, 0, At, B0); PG8_BAR; PG8_SCHED;
            PG8_STAGE(PG8_SB(1, 1), b3 + hstepB, voffB);
            PG8_WAIT_V(6); PG8_BAR; PG8_MMA(1, 1, At, B1); PG8_BAR;
            }
        }
        if constexpr (ALIGN_EPI) { if (wr == 0) PG8_BAR; }
        if constexpr (!Epi::AFTER_DRAIN) { E(acc, cur, wr, wc, fr, fq); S.done(cur); }
        if (!has_next) break;
#pragma unroll
        for (int a = 0; a < 2; ++a)
#pragma unroll
            for (int b = 0; b < 2; ++b)
#pragma unroll
                for (int m = 0; m < 4; ++m)
#pragma unroll
                    for (int n = 0; n < 2; ++n) acc[a][b][m][n] = (f32x4){0.f, 0.f, 0.f, 0.f};
        cur = nxt; cA = nA; cB = nB; ++ui;
        if constexpr (ALIGN_EPI) { if (wr == 1) PG8_BAR; }
    }
    PG8_WAIT_V(0);
    if constexpr (!ALIGN_EPI) { if (wr == 0) PG8_BAR; }
    PG8_BAR;
    if constexpr (Epi::AFTER_DRAIN) { E.fused(acc, cur, wr, wc, fr, fq, lds, wid, lane); S.done(cur); }
#undef PG8_SA
#undef PG8_SB
#undef PG8_STAGE
#undef PG8_LDA
#undef PG8_LDB
#undef PG8_MMA
#undef PG8_WAIT_V
#undef PG8_WAIT_L
#undef PG8_BAR
#undef PG8_SCHED
}
}

constexpr int MTOK = 32768, DM = 1024, SEQ = 8192, NLAYER = 4, NIN = 6048, DFF = 4096;
constexpr float EPS = 1e-6f;
constexpr float QSCALE = 0.10206207261596575f * 1.4426950408889634f;
constexpr size_t MiB = 1u << 20;
constexpr size_t WS_RS = 1 * MiB, WS_ROPEC = 2 * MiB, WS_ROPES = 4 * MiB;
constexpr size_t WS_WIN = 6 * MiB, WS_WUQ = 18 * MiB, WS_WK = WS_WUQ + 256 * 1024, WS_WV = WS_WK + 64 * 1024, WS_SGW = WS_WUQ + 512 * 1024;
constexpr size_t WS_WBR = 19 * MiB, WS_WOUT = 21 * MiB, WS_W1 = 23 * MiB, WS_W2 = 31 * MiB;
constexpr size_t WS_XBF = 40 * MiB;
constexpr size_t WS_BR = 104 * MiB;
constexpr size_t WS_BIG = 168 * MiB;
constexpr size_t WS_PROJ = WS_BIG, WS_CQN = WS_BIG + 128 * MiB, WS_CKVN = WS_BIG + 144 * MiB, WS_KR = WS_BIG + 152 * MiB, WS_Q = WS_BIG + 154 * MiB, WS_KN = WS_BIG + 186 * MiB, WS_VT = WS_BIG + 202 * MiB;
constexpr size_t WS_END = 424 * MiB;
constexpr int LDS_BYTES = 147456;

struct Args { const float* in[26]; float* out; unsigned char* ws; int lo, hi; };
enum { I_X = 0, I_POS, I_NPRE, I_WIN, I_GATEB, I_QN, I_WUQ, I_KVN, I_WUKV, I_WBRMLA, I_LNG, I_LNB, I_SGW, I_SGB, I_WBRSG, I_CONVW, I_WBRCONV, I_POOLW, I_POOLS, I_WBRPOOL, I_WOUT, I_NPOST, I_NFPRE, I_WFF1, I_WFF2, I_NFPOST };

__device__ __forceinline__ int crow(int r, int hi) { return (r & 3) + 8 * (r >> 2) + 4 * hi; }
#define MFMA32(a, b, c) __builtin_amdgcn_mfma_f32_32x32x16_bf16((a), (b), (c), 0, 0, 0)

__device__ __forceinline__ void tr_item(const float* __restrict__ W, int ldw, int k0, int srcn0, const float* __restrict__ gk, float mul, bf16_t* WT, int ldt, int dstn0, LAS float* scr, int lane) {
#pragma unroll 8
    for (int i = 0; i < 32; ++i) { const int kk = 2 * i + (lane >> 5); float v = 0.f;
        if (srcn0 >= 0) { v = W[(size_t)(k0 + kk) * ldw + srcn0 + (lane & 31)] * mul; if (gk) v *= gk[k0 + kk]; }
        scr[kk * 33 + (lane & 31)] = v; }
    asm volatile("s_waitcnt lgkmcnt(0)" ::: "memory");
    const int c = lane & 7;
#pragma unroll
    for (int j = 0; j < 4; ++j) { const int n = (lane >> 3) + 8 * j; const LAS float* s = scr + (8 * c) * 33 + n;
        u32x4 o; o.x = pk2(s[0 * 33], s[1 * 33]); o.y = pk2(s[2 * 33], s[3 * 33]); o.z = pk2(s[4 * 33], s[5 * 33]); o.w = pk2(s[6 * 33], s[7 * 33]);
        *(u32x4*)(WT + (size_t)(dstn0 + n) * ldt + k0 + 8 * c) = o; }
    asm volatile("s_waitcnt lgkmcnt(0)" ::: "memory");
}

__device__ __forceinline__ void prep_weights(const Args& a, int l, LAS unsigned char* lds, int tid) {
    const int lane = tid & 63, wave = tid >> 6, G = gridDim.x;
    LAS float* scr = (LAS float*)(lds + wave * 8448);
    const int gw = blockIdx.x * 8 + wave, NGW = G * 8;
    unsigned char* ws = a.ws;
    constexpr int N0 = 16 * 192, N1 = 4 * 16, N2 = 2 * 8, N3 = 2 * 8, N4 = 3 * 4 * 32, N5 = 16 * 32, N6 = 16 * 128, N7 = 64 * 32;
    constexpr int NITEMS = N0 + N1 + N2 + N3 + N4 + N5 + N6 + N7;
    for (int it = gw; it < NITEMS; it += NGW) {
        int r = it;
        if (r < N0) { const int kb = r / 192, nb = r % 192, d0 = nb * 32; const int src = d0 < 416 ? d0 : (d0 < 512 ? -1 : d0 - 96);
            tr_item(a.in[I_WIN] + (size_t)l * DM * NIN, NIN, kb * 64, src, a.in[I_NPRE] + l * DM, 1.f, (bf16_t*)(ws + WS_WIN), DM, d0, scr, lane); continue; } r -= N0;
        if (r < N1) { const int kb = r / 16, nb = r % 16;
            tr_item(a.in[I_WUQ] + (size_t)l * 256 * 384, 384, kb * 64, nb < 12 ? nb * 32 : -1, a.in[I_QN] + l * 256, QSCALE, (bf16_t*)(ws + WS_WUQ), 256, nb * 32, scr, lane); continue; } r -= N1;
        if (r < N2) { const int kb = r / 8, nb = r % 8;
            tr_item(a.in[I_WUKV] + (size_t)l * 128 * 512, 512, kb * 64, (nb >> 1) * 128 + (nb & 1) * 32, a.in[I_KVN] + l * 128, 1.f, (bf16_t*)(ws + WS_WK), 128, nb * 32, scr, lane); continue; } r -= N2;
        if (r < N3) { const int kb = r / 8, nb = r % 8;
            tr_item(a.in[I_WUKV] + (size_t)l * 128 * 512, 512, kb * 64, (nb >> 1) * 128 + 64 + (nb & 1) * 32, a.in[I_KVN] + l * 128, 1.f, (bf16_t*)(ws + WS_WV), 128, nb * 32, scr, lane); continue; } r -= N3;
        if (r < N4) { const int z = r / 128, rr = r % 128, kb = rr / 32, nb = rr % 32; const float* W = (z == 0 ? a.in[I_WBRMLA] : z == 1 ? a.in[I_WBRSG] : a.in[I_WBRCONV]) + (size_t)l * 256 * DM;
            tr_item(W, DM, kb * 64, nb * 32, nullptr, 1.f, (bf16_t*)(ws + WS_WBR) + (size_t)z * DM * 256, 256, nb * 32, scr, lane); continue; } r -= N4;
        if (r < N5) { const int kb = r / 32, nb = r % 32;
            tr_item(a.in[I_WOUT] + (size_t)l * DM * DM, DM, kb * 64, nb * 32, nullptr, 1.f, (bf16_t*)(ws + WS_WOUT), DM, nb * 32, scr, lane); continue; } r -= N5;
        if (r < N6) { const int kb = r / 128, nb = r % 128;
            tr_item(a.in[I_WFF1] + (size_t)l * DM * DFF, DFF, kb * 64, nb * 32, a.in[I_NFPRE] + l * DM, 1.f, (bf16_t*)(ws + WS_W1), DM, nb * 32, scr, lane); continue; } r -= N6;
        { const int kb = r / 32, nb = r % 32;
            tr_item(a.in[I_WFF2] + (size_t)l * DFF * DM, DM, kb * 64, nb * 32, nullptr, 1.f, (bf16_t*)(ws + WS_W2), DFF, nb * 32, scr, lane); }
    }
    const int gt = blockIdx.x * 512 + tid, NGT = G * 512;
    { const float* sw = a.in[I_SGW] + (size_t)l * 65536; bf16_t* o = (bf16_t*)(ws + WS_SGW);
      for (int i = gt; i < 65536; i += NGT) { const int t = (i >> 7) & 127, s = i & 127; o[i] = (bf16_t)f2bf(s <= t ? sw[i] : 0.f); } }
    { const float* wp = a.in[I_POOLW] + (size_t)l * 4 * 64 * 64; const float* sc = a.in[I_POOLS] + l * 256; const float* wb = a.in[I_WBRPOOL] + (size_t)l * 256 * DM;
      bf16_t* o = (bf16_t*)(ws + WS_WBR) + (size_t)3 * DM * 256;
      for (int i = gt; i < 256 * DM; i += NGT) { const int n = i & 1023, cp = i >> 10, g = cp >> 6, c = cp & 63; float acc = 0.f;
          for (int d = 0; d < 64; ++d) acc += wp[(g * 64 + c) * 64 + d] * sc[g * 64 + d] * wb[(size_t)(g * 64 + d) * DM + n];
          o[(size_t)n * 256 + cp] = (bf16_t)f2bf(acc); } }
}

__device__ __forceinline__ void phase_s0(const Args& a, LAS unsigned char* lds, int tid) {
    const int G = gridDim.x, gt = blockIdx.x * 512 + tid, NGT = G * 512;
    const int* pos = (const int*)a.in[I_POS];
    float* rc = (float*)(a.ws + WS_ROPEC); float* rsn = (float*)(a.ws + WS_ROPES);
    for (int i = gt; i < MTOK * 16; i += NGT) { const int tok = i & (MTOK - 1); const int k = __builtin_amdgcn_readfirstlane(i >> 15);
        const unsigned chi = (k == 0 ? 0x3fc45f30u : (k == 1 ? 0x3fb6e96eu : (k == 2 ? 0x3fa9c4c0u : (k == 3 ? 0x3f9cfb40u : (k == 4 ? 0x3f904c26u : (k == 5 ? 0x3f825458u : (k == 6 ? 0x3f749d66u : (k == 7 ? 0x3f672f66u : (k == 8 ? 0x3f5a1371u : (k == 9 ? 0x3f4d53c1u : (k == 10 ? 0x3f407debu : (k == 11 ? 0x3f328c52u : (k == 12 ? 0x3f24dc5au : (k == 13 ? 0x3f177634u : (k == 14 ? 0x3f0a6312u : (k == 15 ? 0x3efdad50u : 0u))))))))))))))));
        const unsigned clo = (k == 0 ? 0x6dc9c883u : (k == 1 ? 0xcaebf83fu : (k == 2 ? 0x200b604fu : (k == 3 ? 0x35fd7496u : (k == 4 ? 0xbe3b06cfu : (k == 5 ? 0xa2566033u : (k == 6 ? 0x800919d9u : (k == 7 ? 0x91979078u : (k == 8 ? 0x305e714cu : (k == 9 ? 0x03bd66b8u : (k == 10 ? 0x99a0e17au : (k == 11 ? 0x0e12d9f9u : (k == 12 ? 0x8d185aa3u : (k == 13 ? 0x02fdebc6u : (k == 14 ? 0x8f67cf2au : (k == 15 ? 0x16848ff5u : 0u))))))))))))))));
        const double cf = __hiloint2double((int)chi, (int)clo);
        const double rev = (double)pos[tok] * cf;
        const float fr = (float)(rev - __builtin_rint(rev));
        rc[tok * 16 + k] = __builtin_amdgcn_cosf(fr); rsn[tok * 16 + k] = __builtin_amdgcn_sinf(fr); }
    const int lane = tid & 63, wave = tid >> 6, gw = blockIdx.x * 8 + wave, NGW = G * 8;
    const float* x = a.in[I_X]; float* xo = a.out; bf16_t* xb = (bf16_t*)(a.ws + WS_XBF); float* rs = (float*)(a.ws + WS_RS);
    for (int row = gw; row < MTOK; row += NGW) {
        const float* xr = x + (size_t)row * DM + 8 * lane; bf16_t* bw = xb + (size_t)row * DM + 8 * lane;
        float ss = 0.f;
#pragma unroll
        for (int j = 0; j < 2; ++j) { const f32x4 v0 = *(const f32x4*)(xr + 512 * j), v1 = *(const f32x4*)(xr + 512 * j + 4);
            ss += v0.x * v0.x + v0.y * v0.y + v0.z * v0.z + v0.w * v0.w + v1.x * v1.x + v1.y * v1.y + v1.z * v1.z + v1.w * v1.w;
            u32x4 o; o.x = pk2(v0.x, v0.y); o.y = pk2(v0.z, v0.w); o.z = pk2(v1.x, v1.y); o.w = pk2(v1.z, v1.w); *(u32x4*)(bw + 512 * j) = o; }
        ss = wave_sum(ss);
        if (lane == 0) rs[row] = 1.0f / sqrtf(ss * (1.0f / DM) + EPS);
    }
}

__device__ __forceinline__ void phase_nr(const Args& a, const float* gpost, size_t ysrc, bool final_out, int tid) {
    const int G = gridDim.x, lane = tid & 63, wave = tid >> 6, gw = blockIdx.x * 8 + wave, NGW = G * 8;
    float* xo = a.out; bf16_t* xb = (bf16_t*)(a.ws + WS_XBF); float* rs = (float*)(a.ws + WS_RS); const bf16_t* y = (const bf16_t*)(a.ws + ysrc);
    f32x4 gv[4];
#pragma unroll
    for (int j = 0; j < 2; ++j) { gv[2 * j] = *(const f32x4*)(gpost + 8 * lane + 512 * j); gv[2 * j + 1] = *(const f32x4*)(gpost + 8 * lane + 512 * j + 4); }
    constexpr int NR = 4;
    for (int grp = gw; grp < MTOK / NR; grp += NGW) {
        u32x4 yw[NR][2], xw[NR][2];
#pragma unroll
        for (int r = 0; r < NR; ++r) { const size_t off = (size_t)(grp * NR + r) * DM + 8 * lane;
#pragma unroll
            for (int j = 0; j < 2; ++j) { yw[r][j] = *(const u32x4*)(y + off + 512 * j); xw[r][j] = *(const u32x4*)(xb + off + 512 * j); } }
        float ss[NR];
#pragma unroll
        for (int r = 0; r < NR; ++r) { float s_ = 0.f;
#pragma unroll
            for (int j = 0; j < 2; ++j) { const u32x4 w = yw[r][j]; const float e0 = bflo(w.x), e1 = bfhi(w.x), e2 = bflo(w.y), e3 = bfhi(w.y), e4 = bflo(w.z), e5 = bfhi(w.z), e6 = bflo(w.w), e7 = bfhi(w.w);
                s_ += e0 * e0 + e1 * e1 + e2 * e2 + e3 * e3 + e4 * e4 + e5 * e5 + e6 * e6 + e7 * e7; }
            ss[r] = s_; }
#pragma unroll
        for (int o = 1; o < 64; o <<= 1) {
#pragma unroll
            for (int r = 0; r < NR; ++r) ss[r] += __shfl_xor(ss[r], o); }
        float xs[NR];
#pragma unroll
        for (int r = 0; r < NR; ++r) { const float ry = 1.0f / sqrtf(ss[r] * (1.0f / DM) + EPS); float s_ = 0.f; const size_t off = (size_t)(grp * NR + r) * DM + 8 * lane;
#pragma unroll
            for (int j = 0; j < 2; ++j) { const u32x4 w = yw[r][j]; const u32x4 xx = xw[r][j]; f32x4 a0, a1;
                a0[0] = bflo(xx.x) + bflo(w.x) * ry * gv[2 * j][0]; a0[1] = bfhi(xx.x) + bfhi(w.x) * ry * gv[2 * j][1]; a0[2] = bflo(xx.y) + bflo(w.y) * ry * gv[2 * j][2]; a0[3] = bfhi(xx.y) + bfhi(w.y) * ry * gv[2 * j][3];
                a1[0] = bflo(xx.z) + bflo(w.z) * ry * gv[2 * j + 1][0]; a1[1] = bfhi(xx.z) + bfhi(w.z) * ry * gv[2 * j + 1][1]; a1[2] = bflo(xx.w) + bflo(w.w) * ry * gv[2 * j + 1][2]; a1[3] = bfhi(xx.w) + bfhi(w.w) * ry * gv[2 * j + 1][3];
                if (final_out) { *(f32x4*)(xo + off + 512 * j) = a0; *(f32x4*)(xo + off + 512 * j + 4) = a1; }
                else { u32x4 o; o.x = pk2(a0[0], a0[1]); o.y = pk2(a0[2], a0[3]); o.z = pk2(a1[0], a1[1]); o.w = pk2(a1[2], a1[3]); *(u32x4*)(xb + off + 512 * j) = o;
                    const float b0 = bflo(o.x), b1 = bfhi(o.x), b2 = bflo(o.y), b3 = bfhi(o.y), b4 = bflo(o.z), b5 = bfhi(o.z), b6 = bflo(o.w), b7 = bfhi(o.w);
                    s_ += b0 * b0 + b1 * b1 + b2 * b2 + b3 * b3 + b4 * b4 + b5 * b5 + b6 * b6 + b7 * b7; } }
            xs[r] = s_; }
        if (!final_out) {
#pragma unroll
            for (int o = 1; o < 64; o <<= 1) {
#pragma unroll
                for (int r = 0; r < NR; ++r) xs[r] += __shfl_xor(xs[r], o); }
            if (lane == 0) {
#pragma unroll
                for (int r = 0; r < NR; ++r) rs[grp * NR + r] = 1.0f / sqrtf(xs[r] * (1.0f / DM) + EPS); } }
    }
}

__device__ __forceinline__ void unpack8(const u32x4 w, float (&f)[8]) { f[0] = bflo(w.x); f[1] = bfhi(w.x); f[2] = bflo(w.y); f[3] = bfhi(w.y); f[4] = bflo(w.z); f[5] = bfhi(w.z); f[6] = bflo(w.w); f[7] = bfhi(w.w); }
__device__ __forceinline__ u32x4 pack8(const float (&f)[8]) { u32x4 o; o.x = pk2(f[0], f[1]); o.y = pk2(f[2], f[3]); o.z = pk2(f[4], f[5]); o.w = pk2(f[6], f[7]); return o; }

__device__ __forceinline__ void phase_e1(const Args& a, int l, LAS unsigned char* lds, int tid) {
    const int lane = tid & 63, wid = __builtin_amdgcn_readfirstlane(tid >> 6), r32 = lane & 31, hi = lane >> 5;
    unsigned char* ws = a.ws;
    const bf16_t* P = (const bf16_t*)(ws + WS_PROJ); bf16_t* CQN = (bf16_t*)(ws + WS_CQN); bf16_t* CKVN = (bf16_t*)(ws + WS_CKVN); bf16_t* KR = (bf16_t*)(ws + WS_KR);
    bf16_t* BR = (bf16_t*)(ws + WS_BR); const float* rc = (const float*)(ws + WS_ROPEC); const float* rsn = (const float*)(ws + WS_ROPES);
    const bf16_t* SGWB = (const bf16_t*)(ws + WS_SGW);
    const float* convw = a.in[I_CONVW] + l * 3 * 256; const float* lng = a.in[I_LNG] + l * 256; const float* lnb = a.in[I_LNB] + l * 256; const float* sgb = a.in[I_SGB] + l * 512;
    for (int tile = blockIdx.x; tile < MTOK / 128; tile += gridDim.x) {
        const int R0 = tile * 128, s0 = R0 & (SEQ - 1);
        for (int i = 0; i < 16; ++i) { const int row = R0 + wid * 16 + i; const bf16_t* pr = P + (size_t)row * 2048;
            const u32x2 cq = *(const u32x2*)(pr + 4 * lane); const float q0 = bflo(cq.x), q1 = bfhi(cq.x), q2 = bflo(cq.y), q3 = bfhi(cq.y);
            const unsigned ck = *(const unsigned*)(pr + 256 + 2 * lane); const float k0 = bflo(ck), k1 = bfhi(ck);
            const float sq = wave_sum(q0 * q0 + q1 * q1 + q2 * q2 + q3 * q3), sk = wave_sum(k0 * k0 + k1 * k1);
            const float rq = 1.0f / sqrtf(sq * (1.0f / 256.0f) + EPS), rk = 1.0f / sqrtf(sk * (1.0f / 128.0f) + EPS);
            u32x2 oq; oq.x = pk2(q0 * rq, q1 * rq); oq.y = pk2(q2 * rq, q3 * rq); *(u32x2*)(CQN + (size_t)row * 256 + 4 * lane) = oq;
            *(unsigned*)(CKVN + (size_t)row * 128 + 2 * lane) = pk2(k0 * rk, k1 * rk);
            if (lane < 16) { const float x1 = bf2f(pr[384 + lane]), x2 = bf2f(pr[400 + lane]); const float c = rc[(size_t)row * 16 + lane], s = rsn[(size_t)row * 16 + lane];
                KR[(size_t)row * 32 + lane] = (bf16_t)f2bf(x1 * c - x2 * s); KR[(size_t)row * 32 + 16 + lane] = (bf16_t)f2bf(x2 * c + x1 * s); } }
        for (int it = 0; it < 8; ++it) { const int id = it * 512 + tid, ch = id & 31, t = id >> 5, row = R0 + t, s = s0 + t; const bf16_t* pr = P + (size_t)row * 2048 + 8 * ch;
            { float bg[8], y[8]; unpack8(*(const u32x4*)(pr + 1280), bg);
#pragma unroll
              for (int e = 0; e < 8; ++e) y[e] = 0.f;
#pragma unroll
              for (int k = 0; k < 3; ++k) { const int dt = k - 2; if (s + dt >= 0) { float xv[8], cv[8]; unpack8(*(const u32x4*)(pr + dt * 2048 + 1024), xv); unpack8(*(const u32x4*)(pr + dt * 2048 + 1536), cv);
                      const f32x4 w0 = *(const f32x4*)(convw + k * 256 + 8 * ch), w1 = *(const f32x4*)(convw + k * 256 + 8 * ch + 4);
#pragma unroll
                      for (int e = 0; e < 4; ++e) { y[e] += w0[e] * (xv[e] * cv[e]); y[4 + e] += w1[e] * (xv[4 + e] * cv[4 + e]); } } }
#pragma unroll
              for (int e = 0; e < 8; ++e) y[e] *= bg[e];
              *(u32x4*)(BR + (size_t)row * DM + 512 + 8 * ch) = pack8(y); }
            { const int g = ch >> 3, win = 2 << g; float acc[8], pt[8]; unpack8(*(const u32x4*)(pr + 1792), pt);
#pragma unroll
              for (int e = 0; e < 8; ++e) acc[e] = pt[e];
              const int cnt = (s + 1) < win ? (s + 1) : win;
              for (int i = 1; i < cnt; ++i) { float pv[8]; unpack8(*(const u32x4*)(pr - i * 2048 + 1792), pv);
#pragma unroll
                  for (int e = 0; e < 8; ++e) acc[e] += pv[e]; }
              const float ic = 1.0f / (float)cnt;
#pragma unroll
              for (int e = 0; e < 8; ++e) acc[e] = acc[e] * ic - pt[e];
              *(u32x4*)(BR + (size_t)row * DM + 768 + 8 * ch) = pack8(acc); } }
        { const int srow = tid >> 2, qt = tid & 3; const bf16_t* vp = P + (size_t)(R0 + srow) * 2048 + 768 + qt * 64;
          float v[64]; float sum = 0.f;
#pragma unroll
          for (int j = 0; j < 8; ++j) { const u32x4 w = *(const u32x4*)(vp + 8 * j);
              v[8 * j + 0] = bflo(w.x); v[8 * j + 1] = bfhi(w.x); v[8 * j + 2] = bflo(w.y); v[8 * j + 3] = bfhi(w.y); v[8 * j + 4] = bflo(w.z); v[8 * j + 5] = bfhi(w.z); v[8 * j + 6] = bflo(w.w); v[8 * j + 7] = bfhi(w.w); }
#pragma unroll
          for (int j = 0; j < 64; ++j) sum += v[j];
          sum += __shfl_xor(sum, 1); sum += __shfl_xor(sum, 2);
          const float mean = sum * (1.0f / 256.0f); float var = 0.f;
#pragma unroll
          for (int j = 0; j < 64; ++j) { v[j] -= mean; var += v[j] * v[j]; }
          var += __shfl_xor(var, 1); var += __shfl_xor(var, 2);
          const float rstd = 1.0f / sqrtf(var * (1.0f / 256.0f) + EPS);
          LAS bf16_t* vT = (LAS bf16_t*)lds;
#pragma unroll
          for (int j = 0; j < 64; ++j) { const int c = qt * 64 + j; vT[c * 136 + srow] = (bf16_t)f2bf(v[j] * rstd * lng[c] + lnb[c]); } }
        __syncthreads();
        { const int g = wid >> 1, th = wid & 1;
#pragma unroll
          for (int tb = 0; tb < 2; ++tb)
#pragma unroll
              for (int cb = 0; cb < 2; ++cb) { f32x16 acc;
#pragma unroll
                  for (int r = 0; r < 16; ++r) acc[r] = 0.f;
                  const bf16_t* ap = SGWB + (size_t)(g * 128 + 64 * th + 32 * tb + r32) * 128 + 8 * hi;
                  const LAS unsigned char* bp = lds + (g * 64 + 32 * cb + r32) * 272 + 16 * hi;
                  const int nks = (64 * th + 32 * tb + 32) >> 4;
                  for (int ks = 0; ks < nks; ++ks) { const bf16x8 A = *(const bf16x8*)(ap + 16 * ks); const bf16x8 B = *(const LAS bf16x8*)(bp + 32 * ks); acc = MFMA32(A, B, acc); }
#pragma unroll
                  for (int r = 0; r < 16; ++r) { const int t = 64 * th + 32 * tb + crow(r, hi), c = g * 64 + 32 * cb + r32;
                      const float val = acc[r] + sgb[g * 128 + t]; const float u = bf2f(P[(size_t)(R0 + t) * 2048 + 512 + c]);
                      BR[(size_t)(R0 + t) * DM + 256 + c] = (bf16_t)f2bf(u * val); } } }
        __syncthreads();
    }
}

constexpr int KPITCH = 208, VPITCH = 136, KBUF = 64 * KPITCH, VBUF = 64 * VPITCH, ATT_V0 = 2 * KBUF, ATT_WS = ATT_V0 + 2 * VBUF;
__device__ __forceinline__ void attn_unit(const Args& a, int b, int h, int qb, LAS unsigned char* lds, int tid) {
    const int lane = tid & 63, wid = __builtin_amdgcn_readfirstlane(tid >> 6), r32 = lane & 31, hi = lane >> 5;
    unsigned char* ws = a.ws;
    const bf16_t* Q = (const bf16_t*)(ws + WS_Q); const bf16_t* Kn = (const bf16_t*)(ws + WS_KN); const bf16_t* Kr = (const bf16_t*)(ws + WS_KR); const bf16_t* Vt = (const bf16_t*)(ws + WS_VT);
    bf16_t* O = (bf16_t*)(ws + WS_BR); const float* rc = (const float*)(ws + WS_ROPEC); const float* rsn = (const float*)(ws + WS_ROPES);
    const size_t rowbase = (size_t)b * SEQ; const int qw0 = qb * 256 + wid * 32;
    LAS float* wsf = (LAS float*)(lds + ATT_WS) + wid * 64;
    bf16x8 qf[6];
    { const size_t qrow = rowbase + qw0 + r32; const bf16_t* qp = Q + qrow * 512 + h * 96 + 8 * hi;
#pragma unroll
      for (int ks = 0; ks < 4; ++ks) qf[ks] = *(const bf16x8*)(qp + 16 * ks);
      const bf16x8 x1 = *(const bf16x8*)(qp + 64), x2 = *(const bf16x8*)(qp + 80);
      const float* cp = rc + qrow * 16 + 8 * hi; const float* sp = rsn + qrow * 16 + 8 * hi;
      const f32x4 c0 = *(const f32x4*)cp, c1 = *(const f32x4*)(cp + 4), s0 = *(const f32x4*)sp, s1 = *(const f32x4*)(sp + 4);
      bf16x8 o1, o2;
#pragma unroll
      for (int j = 0; j < 8; ++j) { const float xa = bf2f((bf16_t)x1[j]), xb = bf2f((bf16_t)x2[j]); const float c = j < 4 ? c0[j & 3] : c1[j & 3], s = j < 4 ? s0[j & 3] : s1[j & 3];
          o1[j] = (short)f2bf(xa * c - xb * s); o2[j] = (short)f2bf(xb * c + xa * s); }
      qf[4] = o1; qf[5] = o2; }
    const int krow = tid >> 3, kch = tid & 7;
    const bf16_t* knp = Kn + (rowbase + krow) * 256 + h * 64 + kch * 8;
    const bf16_t* krp = Kr + (rowbase + (tid >> 2)) * 32 + (tid & 3) * 8;
    const bf16_t* vtp = Vt + (size_t)(h * 64 + krow) * MTOK + rowbase + kch * 8;
    const bool rope_loader = wid < 4;
    u32x4 gk, gr, gv;
#define ATT_LOAD(t) do { gk = *(const u32x4*)(knp + (size_t)(t) * 64 * 256); if (rope_loader) gr = *(const u32x4*)(krp + (size_t)(t) * 64 * 32); gv = *(const u32x4*)(vtp + (size_t)(t) * 64); } while (0)
#define ATT_STORE(bf) do { *(LAS u32x4*)(lds + (bf) * KBUF + krow * KPITCH + kch * 16) = gk; if (rope_loader) *(LAS u32x4*)(lds + (bf) * KBUF + (tid >> 2) * KPITCH + 128 + (tid & 3) * 16) = gr; \
        *(LAS u32x2*)(lds + ATT_V0 + (bf) * VBUF + krow * VPITCH + kch * 16) = (u32x2){gv.x, gv.y}; *(LAS u32x2*)(lds + ATT_V0 + (bf) * VBUF + krow * VPITCH + kch * 16 + 8) = (u32x2){gv.z, gv.w}; } while (0)
    float mref = -INFINITY, lsum = 0.f; f32x16 o0, o1;
#pragma unroll
    for (int r = 0; r < 16; ++r) { o0[r] = 0.f; o1[r] = 0.f; }
    const int NT = 4 * qb + 4;
    ATT_LOAD(0); ATT_STORE(0); __syncthreads();
    for (int t = 0; t < NT; ++t) {
        const int buf = t & 1;
        if (t + 1 < NT) ATT_LOAD(t + 1);
        if (64 * t <= qw0 + 31) {
            f32x16 p0, p1;
#pragma unroll
            for (int r = 0; r < 16; ++r) { p0[r] = 0.f; p1[r] = 0.f; }
            const LAS unsigned char* kb = lds + buf * KBUF + r32 * KPITCH + hi * 16;
#pragma unroll
            for (int ks = 0; ks < 6; ++ks) { const bf16x8 a0 = *(const LAS bf16x8*)(kb + ks * 32), a1 = *(const LAS bf16x8*)(kb + 32 * KPITCH + ks * 32);
                p0 = MFMA32(a0, qf[ks], p0); p1 = MFMA32(a1, qf[ks], p1); }
            if (64 * t + 63 > qw0) { const int qg = qw0 + r32;
#pragma unroll
                for (int r = 0; r < 16; ++r) { const int kv = 64 * t + crow(r, hi); if (kv > qg) p0[r] = -INFINITY; if (kv + 32 > qg) p1[r] = -INFINITY; } }
            float rm = fmaxf(p0[0], p1[0]);
#pragma unroll
            for (int r = 1; r < 16; ++r) rm = fmaxf(rm, fmaxf(p0[r], p1[r]));
            rm = fmaxf(rm, __shfl_xor(rm, 32));
            if (__any(rm > mref + 8.0f)) {
                const float mnew = fmaxf(mref, rm); const float alpha = __builtin_amdgcn_exp2f(mref - mnew);
                lsum *= alpha; mref = mnew;
                if (hi == 0) wsf[r32] = alpha;
                asm volatile("s_waitcnt lgkmcnt(0)" ::: "memory");
#pragma unroll
                for (int r = 0; r < 16; ++r) { const float f = wsf[crow(r, hi)]; o0[r] *= f; o1[r] *= f; }
            }
            float ps = 0.f;
#pragma unroll
            for (int r = 0; r < 16; ++r) { p0[r] = __builtin_amdgcn_exp2f(p0[r] - mref); p1[r] = __builtin_amdgcn_exp2f(p1[r] - mref); ps += p0[r] + p1[r]; }
            lsum += ps;
            bf16x8 pa[4];
            { u32x4 w;
              w.x = pg8::cvt_pk_bf16(p0[0], p0[1]); w.y = pg8::cvt_pk_bf16(p0[2], p0[3]); w.z = pg8::cvt_pk_bf16(p0[4], p0[5]); w.w = pg8::cvt_pk_bf16(p0[6], p0[7]); pa[0] = __builtin_bit_cast(bf16x8, w);
              w.x = pg8::cvt_pk_bf16(p0[8], p0[9]); w.y = pg8::cvt_pk_bf16(p0[10], p0[11]); w.z = pg8::cvt_pk_bf16(p0[12], p0[13]); w.w = pg8::cvt_pk_bf16(p0[14], p0[15]); pa[1] = __builtin_bit_cast(bf16x8, w);
              w.x = pg8::cvt_pk_bf16(p1[0], p1[1]); w.y = pg8::cvt_pk_bf16(p1[2], p1[3]); w.z = pg8::cvt_pk_bf16(p1[4], p1[5]); w.w = pg8::cvt_pk_bf16(p1[6], p1[7]); pa[2] = __builtin_bit_cast(bf16x8, w);
              w.x = pg8::cvt_pk_bf16(p1[8], p1[9]); w.y = pg8::cvt_pk_bf16(p1[10], p1[11]); w.z = pg8::cvt_pk_bf16(p1[12], p1[13]); w.w = pg8::cvt_pk_bf16(p1[14], p1[15]); pa[3] = __builtin_bit_cast(bf16x8, w); }
            const LAS unsigned char* vb = lds + ATT_V0 + buf * VBUF + r32 * VPITCH + hi * 8;
#pragma unroll
            for (int kk = 0; kk < 4; ++kk) {
                const s16x4 l0 = *(const LAS s16x4*)(vb + kk * 32), h0 = *(const LAS s16x4*)(vb + kk * 32 + 16);
                const s16x4 l1 = *(const LAS s16x4*)(vb + 32 * VPITCH + kk * 32), h1 = *(const LAS s16x4*)(vb + 32 * VPITCH + kk * 32 + 16);
                const bf16x8 v0 = __builtin_shufflevector(l0, h0, 0, 1, 2, 3, 4, 5, 6, 7), v1 = __builtin_shufflevector(l1, h1, 0, 1, 2, 3, 4, 5, 6, 7);
                o0 = MFMA32(pa[kk], v0, o0); o1 = MFMA32(pa[kk], v1, o1); }
        }
        if (t + 1 < NT) ATT_STORE((t + 1) & 1);
        __syncthreads();
    }
#undef ATT_LOAD
#undef ATT_STORE
    lsum += __shfl_xor(lsum, 32);
    if (hi == 0) wsf[32 + r32] = 1.0f / lsum;
    asm volatile("s_waitcnt lgkmcnt(0)" ::: "memory");
#pragma unroll
    for (int r = 0; r < 16; ++r) { const int qr = crow(r, hi); const float inv = wsf[32 + qr]; bf16_t* op = O + (rowbase + qw0 + qr) * DM + h * 64 + r32;
        op[0] = (bf16_t)f2bf(o0[r] * inv); op[32] = (bf16_t)f2bf(o1[r] * inv); }
}
__device__ __forceinline__ void phase_attn(const Args& a, LAS unsigned char* lds, int tid) {
    const int G = gridDim.x, bx = blockIdx.x; const int v0 = (G % 8 == 0) ? (bx % 8) * (G / 8) + bx / 8 : bx;
    for (int v = v0; v < 256; v += G) { const int bh = v >> 4, s = v & 15;
        attn_unit(a, bh >> 2, bh & 3, 31 - s, lds, tid);
        attn_unit(a, bh >> 2, bh & 3, s, lds, tid); }
}

#define XB_TMO      128
#define XB_XCNT(j)  (256  + 64 * (j))
#define XB_XSUB(j)  (1280 + 64 * (j))
#define XB_XGEN(j)  (2304 + 64 * (j))
#define XB_TOP      3328
#define XB_TOPGEN   3392
#define XCD_BAR_WORDS 3456
#define XB_SPIN_CAP (1u << 18)

__device__ __forceinline__ unsigned xb_ld(unsigned* p)              { return __hip_atomic_load(p, __ATOMIC_RELAXED, __HIP_MEMORY_SCOPE_AGENT); }
__device__ __forceinline__ unsigned xb_add(unsigned* p, unsigned v) { return __hip_atomic_fetch_add(p, v, __ATOMIC_RELAXED, __HIP_MEMORY_SCOPE_AGENT); }
__device__ __forceinline__ unsigned xb_xcc_id() { return (unsigned)__builtin_amdgcn_s_getreg((3 << 11) | 20) & 0xFu; }
#define XB_SPIN(cond, bar) do { unsigned _sp = 0; while (cond) { __builtin_amdgcn_s_sleep(1); \
    if ((++_sp & 255u) == 0u) { if (xb_ld(&(bar)[XB_TMO])) break; if (_sp > XB_SPIN_CAP) { atomicAdd(&(bar)[XB_TMO], 1u); break; } } } } while (0)

struct XcdBarrier {
    unsigned* bar; unsigned x;
    volatile LAS unsigned* st;
};

__device__ __forceinline__ XcdBarrier xcd_barrier_post(unsigned* bar, volatile LAS unsigned* st) {
    XcdBarrier b; b.bar = bar; b.x = xb_xcc_id(); b.st = st;
    if (threadIdx.x == 0) (void)xb_add(&bar[XB_XCNT(b.x)], 1u);
    return b;
}
__device__ __forceinline__ void xcd_barrier_complete(unsigned* bar, unsigned x, unsigned& nloc, unsigned& nx) {
    const unsigned G = gridDim.x * gridDim.y * gridDim.z;
    unsigned sum, cnt, mine, sp = 0u;
    for (;;) {
        sum = 0u; cnt = 0u; mine = 0u;
#pragma unroll
        for (unsigned j = 0; j < 16; ++j) { const unsigned c = xb_ld(&bar[XB_XCNT(j)]); sum += c; cnt += (c > 0u) ? 1u : 0u; mine = (j == x) ? c : mine; }
        if (sum == G) break;
        __builtin_amdgcn_s_sleep(1);
        if ((++sp & 255u) == 0u) { if (xb_ld(&bar[XB_TMO])) break; if (sp > XB_SPIN_CAP) { atomicAdd(&bar[XB_TMO], 1u); break; } }
    }
    nloc = mine > 0u ? mine : 1u; nx = cnt > 0u ? cnt : 1u;
}

__device__ __forceinline__ void xcd_barrier(const XcdBarrier& b) {
    asm volatile("s_waitcnt vmcnt(0)" ::: "memory");
    __syncthreads();
    if (threadIdx.x == 0) {
        unsigned* bar = b.bar;
        __builtin_amdgcn_s_waitcnt(0);
        unsigned nloc = b.st[0], nx = b.st[1];
        if (nloc == 0u) { xcd_barrier_complete(bar, b.x, nloc, nx); b.st[0] = nloc; b.st[1] = nx; }
        const unsigned old = xb_add(&bar[XB_XSUB(b.x)], 1u);
        const unsigned gen = old / nloc;
        if (old + 1u == (gen + 1u) * nloc) {
            __builtin_amdgcn_fence(__ATOMIC_RELEASE, "agent");
            asm volatile("s_waitcnt vmcnt(0)" ::: "memory");
            const unsigned og = xb_add(&bar[XB_TOP], 1u);
            const unsigned tg = og / nx;
            if (og + 1u == (tg + 1u) * nx) xb_add(&bar[XB_TOPGEN], 1u);
            else XB_SPIN(xb_ld(&bar[XB_TOPGEN]) == tg, bar);
            __builtin_amdgcn_fence(__ATOMIC_ACQUIRE, "agent");
            xb_add(&bar[XB_XGEN(b.x)], 1u);
            asm volatile("s_waitcnt vmcnt(0)" ::: "memory");
        } else {
            XB_SPIN(xb_ld(&bar[XB_XGEN(b.x)]) == gen, bar);
            __builtin_amdgcn_fence(__ATOMIC_ACQUIRE, "agent");
            asm volatile("s_waitcnt vmcnt(0)" ::: "memory");
        }
    }
    __syncthreads();
}

__global__ void __launch_bounds__(512, 2) mk_fwd(Args a) {
    extern __shared__ __attribute__((aligned(16))) unsigned char lds_raw[];
    LAS unsigned char* lds = (LAS unsigned char*)lds_raw;
    cg::grid_group grid = cg::this_grid();
    const int tid0 = threadIdx.x, G = gridDim.x, bx = blockIdx.x;
    { volatile LAS unsigned* st0 = (volatile LAS unsigned*)(lds + 131072 + 64); if (tid0 == 0) { st0[0] = 0u; st0[1] = 0u; } }
    __syncthreads();
    XcdBarrier xbar = xcd_barrier_post((unsigned*)a.ws, (volatile LAS unsigned*)(lds + 131072 + 64));
    for (int ph = a.lo; ph < a.hi; ++ph) {
        unsigned char* ws = a.ws; int tid = tid0;
        asm volatile("" : "+s"(ws), "+v"(tid));
        int l = 0, k = -1; if (ph > 0) { l = (ph - 1) / 11; k = (ph - 1) % 11; }
        const int ng = (k == 0 || k == 4 || k == 5 || k == 6 || k == 8 || k == 9) ? 1 : (k == 2 ? 3 : 0);
#ifndef PM
#define PM 0xFF
#endif
        if (PM & 1) for (int j = 0; j < ng; ++j) {
            size_t oA, oB, oO; int M_ = MTOK, N_ = DM, K_ = DM, lda = DM, ldb = DM, ldc = DM, mode = 0, nbr = 1, coff = 0, use_rs = 0, zs = 0, bmode = 0;
            if (k == 0) {
                oA = WS_XBF; oB = WS_WIN; oO = WS_BIG; N_ = 2048; ldc = 2048; use_rs = 1; mode = 1;
            } else if (k == 2) {
                if (j == 0) { oA = WS_CQN; oB = WS_WUQ; oO = WS_Q; N_ = 512; K_ = 256; lda = 256; ldb = 256; ldc = 512; }
                else if (j == 1) { oA = WS_CKVN; oB = WS_WK; oO = WS_KN; N_ = 256; K_ = 128; lda = 128; ldb = 128; ldc = 256; }
                else { oA = WS_WV; oB = WS_CKVN; oO = WS_VT; M_ = 256; N_ = MTOK; K_ = 128; lda = 128; ldb = 128; ldc = MTOK; coff = G / 2; }
            } else if (k == 4) {
                oA = WS_BR; oB = WS_WBR; oO = WS_BIG; K_ = 256; ldb = 256; ldc = 4096; nbr = 4; zs = 1024;
            } else if (k == 5) {
                oA = WS_XBF; oB = WS_WIN + (size_t)2048 * DM * 2; oO = WS_BR; N_ = 4096; use_rs = 1; mode = 5; bmode = 1;
            } else if (k == 6) {
                oA = WS_BR; oB = WS_WOUT; oO = WS_BIG;
            } else if (k == 8) {
                oA = WS_XBF; oB = WS_W1; oO = WS_BIG; N_ = DFF; ldc = DFF; use_rs = 1; mode = 3;
            } else {
                oA = WS_BIG; oB = WS_W2; oO = WS_BR; K_ = DFF; lda = DFF; ldb = DFF;
            }
            pg8::Gemm g{(const bf16_t*)(ws + oA), (const bf16_t*)(ws + oB), M_, N_, K_, lda, ldb, bmode};
            pg8::EpiRT E{(bf16_t*)(ws + oO), ldc, use_rs ? (const float*)(ws + WS_RS) : nullptr, a.in[I_GATEB] + l * 4096, (const bf16_t*)(ws + WS_BIG), mode, zs};
            pg8::MergeOrder S; S.init(M_, N_, G, (bx + coff) % G, nbr);
            pg8::gemm_phase<pg8::EpiRT, pg8::MergeOrder, true, true>(lds, g, S, E, tid);
        }
        if ((PM & 2) && k == 1) phase_e1(a, l, lds, tid);
        if ((PM & 4) && k == 3) phase_attn(a, lds, tid);
        if ((PM & 8) && (k == 7 || k == 10)) phase_nr(a, (k == 7 ? a.in[I_NPOST] : a.in[I_NFPOST]) + l * DM, k == 7 ? WS_BIG : WS_BR, (k == 10 && l == NLAYER - 1), tid);
        if ((PM & 16) && ph == 0) phase_s0(a, lds, tid);
        if ((PM & 32) && (ph == 0 || (k == 10 && l + 1 < NLAYER))) prep_weights(a, ph == 0 ? 0 : l + 1, lds, tid);
        if (ph + 1 < a.hi) { if (ph == a.lo) grid.sync(); else xcd_barrier(xbar); }
    }
}

constexpr int NPHASE = 1 + 11 * NLAYER;
#ifndef MK_ONE_LAUNCH
#define MK_ONE_LAUNCH 1
#endif
extern "C" void kernel_launch(void* const* d_in, const int* in_sizes, int n_in, void* d_out, int out_size, void* d_ws, size_t ws_size, hipStream_t stream) {
    static int grid = 0;
    if (grid == 0) {
        if (n_in != 26 || out_size != MTOK * DM || ws_size < WS_END) { fprintf(stderr, "kernel_launch: unexpected shapes (n_in %d out %d ws %zu)\n", n_in, out_size, ws_size); grid = -1; return; }
        int dev = 0, cus = 0, per_cu = 0;
        hipGetDevice(&dev); hipDeviceGetAttribute(&cus, hipDeviceAttributeMultiprocessorCount, dev);
        hipFuncSetAttribute((const void*)mk_fwd, hipFuncAttributeMaxDynamicSharedMemorySize, LDS_BYTES);
        hipOccupancyMaxActiveBlocksPerMultiprocessor(&per_cu, (const void*)mk_fwd, 512, LDS_BYTES);
        if (per_cu < 1) { fprintf(stderr, "kernel_launch: occupancy query says %d blocks per CU\n", per_cu); per_cu = 1; }
        (void)hipGetLastError();
        grid = cus;
    }
    if (grid < 0) return;
    Args a{};
    for (int i = 0; i < 26; ++i) a.in[i] = (const float*)d_in[i];
    a.out = (float*)d_out; a.ws = (unsigned char*)d_ws;
    if (hipMemsetAsync(d_ws, 0, 16384, stream) != hipSuccess) { fprintf(stderr, "memset failed\n"); return; }
#if MK_ONE_LAUNCH
    a.lo = 0; a.hi = NPHASE;
    { void* args[] = {&a}; hipError_t e = hipLaunchCooperativeKernel((const void*)mk_fwd, dim3(grid), dim3(512), args, LDS_BYTES, stream);
      if (e != hipSuccess) fprintf(stderr, "cooperative launch failed: %s (grid %d)\n", hipGetErrorString(e), grid); }
#else
    for (int ph = 0; ph < NPHASE; ++ph) { a.lo = ph; a.hi = ph + 1;
        void* args[] = {&a}; hipError_t e = hipLaunchCooperativeKernel((const void*)mk_fwd, dim3(grid), dim3(512), args, LDS_BYTES, stream);
        if (e != hipSuccess) { fprintf(stderr, "launch %d failed: %s (grid %d)\n", ph, hipGetErrorString(e), grid); break; } }
#endif
}
```

```cpp
#include <hip/hip_runtime.h>
#include <hip/hip_cooperative_groups.h>
#include <cstdio>
#include <cstdint>
namespace cg = cooperative_groups;

#define LAS __attribute__((address_space(3)))
typedef unsigned short bf16_t;
typedef short bf16x8 __attribute__((ext_vector_type(8)));
typedef short s16x4 __attribute__((ext_vector_type(4)));
typedef float f32x4 __attribute__((ext_vector_type(4)));
typedef float f32x2 __attribute__((ext_vector_type(2)));
typedef float f32x16 __attribute__((ext_vector_type(16)));
typedef unsigned u32x4 __attribute__((ext_vector_type(4)));
typedef unsigned u32x2 __attribute__((ext_vector_type(2)));

__device__ __forceinline__ unsigned f2bf(float f) { unsigned u = __builtin_bit_cast(unsigned, f); return (u + 0x7fffu + ((u >> 16) & 1u)) >> 16; }
__device__ __forceinline__ unsigned pk2(float lo, float hi) { return f2bf(lo) | (f2bf(hi) << 16); }
__device__ __forceinline__ float bflo(unsigned w) { return __builtin_bit_cast(float, w << 16); }
__device__ __forceinline__ float bfhi(unsigned w) { return __builtin_bit_cast(float, w & 0xffff0000u); }
__device__ __forceinline__ float bf2f(bf16_t h) { return __builtin_bit_cast(float, ((unsigned)h) << 16); }
__device__ __forceinline__ float wave_sum(float v) {
#pragma unroll
    for (int o = 1; o < 64; o <<= 1) v += __shfl_xor(v, o);
    return v;
}
__device__ __forceinline__ float fast_sigmoid(float v) { return __builtin_amdgcn_rcpf(1.0f + __builtin_amdgcn_exp2f(-1.4426950408889634f * v)); }
__device__ __forceinline__ float gelu_tanh(float x) { const float u = 0.7978845608028654f * (x + 0.044715f * x * x * x); return x * fast_sigmoid(2.0f * u); }

namespace pg8 {
#define PG8_LAS __attribute__((address_space(3)))
constexpr int BM = 256, BK = 64, HALF = 128, HTB = HALF * BK * 2  , STAGE_BYTES = 8 * HTB, NXCD = 8, WGM = 8;

__host__ __device__ __forceinline__ int lds_byte(int r, int c) { const int st = (r >> 4) * 2 + (c >> 5), rr = r & 15, cc = c & 31, ob = rr * 64 + cc * 2; return st * 1024 + (ob ^ (((ob >> 9) & 1) << 5)); }
__host__ __device__ __forceinline__ void stage_rc(int b, int& R, int& C) { const int st = b / 1024, sb = b % 1024, swz = sb ^ (((sb >> 9) & 1) << 5); R = (st >> 1) * 16 + swz / 64; C = (st & 1) * 32 + (swz % 64) / 2; }
__host__ __device__ __forceinline__ int perm32(int rho) { const int n = rho >> 4, i = rho & 15; return 8 * (i >> 2) + 4 * n + (i & 3); }

struct Unit { int pm, pn, bn, ak, z; };
struct Gemm { const bf16_t* A; const bf16_t* Bt; int M, N, K, lda, ldb, bmode; };

struct StaticOrder {
    int nM, nN, nwg, G, c;
    __host__ __device__ void init(int M, int N, int G_, int c_) { nM = M / BM; nN = N / BM; nwg = nM * nN; G = G_; c = c_; }
    __host__ __device__ bool map(long L, Unit& u) const {
        if (L >= nwg) return false;
        int wgid = (int)L; { const int q = nwg / NXCD, r = nwg % NXCD, xcd = wgid % NXCD, off = wgid / NXCD; wgid = (xcd < r ? xcd * (q + 1) : r * (q + 1) + (xcd - r) * q) + off; }
        const int nig = WGM * nN, gid = wgid / nig, fm = gid * WGM, gsz = (nM - fm) < WGM ? (nM - fm) : WGM;
        u.pm = fm + ((wgid % nig) % gsz); u.pn = (wgid % nig) / gsz; return true;
    }
    __host__ __device__ bool next(int i, Unit& u) const { u.ak = 0; u.z = 0; const bool ok = map((long)i * G + c, u); u.bn = u.pn; return ok; }
    __device__ __forceinline__ void a_ready(const Unit&) const {}
    __device__ __forceinline__ void done(const Unit&) const {}
};
struct MergeOrder {
    StaticOrder S; int nbr;
    __host__ __device__ void init(int M, int N, int G_, int c_, int nbr_) { S.init(M, N, G_, c_); nbr = nbr_; }
    __host__ __device__ bool next(int i, Unit& u) const { const int z = i % nbr; const bool ok = S.map((long)(i / nbr) * S.G + S.c, u); u.z = z; u.ak = z * 256; u.bn = z * S.nN + u.pn; return ok; }
    __device__ __forceinline__ void a_ready(const Unit&) const {}
    __device__ __forceinline__ void done(const Unit&) const {}
};

__device__ __forceinline__ unsigned cvt_pk_bf16(float lo, float hi) { unsigned r; asm volatile("v_cvt_pk_bf16_f32 %0, %1, %2" : "=v"(r) : "v"(lo), "v"(hi)); return r; }

struct EpiRT {
    static constexpr bool PERM = true, AFTER_DRAIN = false;
    bf16_t* O; int ldc; const float* rs; const float* bias; const bf16_t* gates; int mode, zs;
    __device__ __forceinline__ void operator()(const f32x4 (&acc)[2][2][4][2], const Unit& u, int wr, int wc, int fr, int fq) const {
        if (mode == 5) {
            const int row0 = u.pm * BM + wr * 64 + fr; const int col = u.pn * 64 + wc * 16 + 4 * fq;
#pragma unroll
            for (int q = 0; q < 4; ++q) { const int ai = q >> 1, mb = (q & 1) * 2;
                u32x2 yw[2][4]; float sc[2];
#pragma unroll
                for (int mm = 0; mm < 2; ++mm) { const int row = row0 + ai * HALF + (mb + mm) * 16; sc[mm] = rs[row]; const bf16_t* yp = gates + (size_t)row * 4096 + col;
#pragma unroll
                    for (int z = 0; z < 4; ++z) yw[mm][z] = *(const u32x2*)(yp + z * 1024); }
#pragma unroll
                for (int mm = 0; mm < 2; ++mm) { const int m = mb + mm; const int row = row0 + ai * HALF + m * 16;
                    f32x4 tot = (f32x4){0.f, 0.f, 0.f, 0.f};
#pragma unroll
                    for (int bj = 0; bj < 2; ++bj)
#pragma unroll
                        for (int n = 0; n < 2; ++n) { const int z = 2 * bj + n; const f32x4 v = acc[ai][bj][m][n] * sc[mm] + *(const f32x4*)(bias + z * 1024 + col); const u32x2 y2 = yw[mm][z];
                            tot[0] += fast_sigmoid(v[0]) * bflo(y2.x); tot[1] += fast_sigmoid(v[1]) * bfhi(y2.x); tot[2] += fast_sigmoid(v[2]) * bflo(y2.y); tot[3] += fast_sigmoid(v[3]) * bfhi(y2.y); }
                    u32x2 w; w.x = cvt_pk_bf16(tot[0], tot[1]); w.y = cvt_pk_bf16(tot[2], tot[3]);
                    *(u32x2*)(O + (size_t)row * ldc + col) = w; }
            }
            return;
        }
        const int row0 = u.pm * BM + wr * 64 + fr; const int col0 = u.pn * BM + wc * 32 + 8 * fq + u.z * zs;
        const int m_eff = (mode == 1) ? ((u.pn == 2 || u.pn == 3) ? 1 : 0) : mode;
#pragma unroll
        for (int ai = 0; ai < 2; ++ai)
#pragma unroll
            for (int m = 0; m < 4; ++m) { const int row = row0 + ai * HALF + m * 16; bf16_t* rowp = O + (size_t)row * ldc + col0;
                const float sc = rs ? rs[row] : 1.0f;
#pragma unroll
                for (int bj = 0; bj < 2; ++bj) { f32x4 v0 = acc[ai][bj][m][0] * sc, v1 = acc[ai][bj][m][1] * sc;
                    if (m_eff == 1) {
#pragma unroll
                        for (int e = 0; e < 4; ++e) { v0[e] = gelu_tanh(v0[e]); v1[e] = gelu_tanh(v1[e]); }
                    } else if (m_eff == 3) {
#pragma unroll
                        for (int e = 0; e < 4; ++e) { const float a = fmaxf(v0[e], 0.f), b = fmaxf(v1[e], 0.f); v0[e] = a * a; v1[e] = b * b; }
                    }
                    u32x4 w; w.x = cvt_pk_bf16(v0[0], v0[1]); w.y = cvt_pk_bf16(v0[2], v0[3]); w.z = cvt_pk_bf16(v1[0], v1[1]); w.w = cvt_pk_bf16(v1[2], v1[3]);
                    *(u32x4*)(rowp + bj * HALF) = w; } }
    }
};

template <class Epi, class Sched, bool ALIGN_EPI = false, bool SP2 = false>
__device__ __forceinline__ void gemm_phase(PG8_LAS unsigned char* lds, const Gemm g, const Sched& S, const Epi& E, const int tid) {
    const int wid = __builtin_amdgcn_readfirstlane(tid >> 6), lane = tid & 63, wr = wid >> 2, wc = wid & 3, fr = lane & 15, fq = lane >> 4;
    const int K = g.K, nt = K / BK;
    unsigned voffA[2], voffB[2];
#pragma unroll
    for (int i = 0; i < 2; ++i) { int R, C; stage_rc(tid * 16 + i * 8192, R, C); const int Rb = g.bmode ? (((R >> 4) & 1) * 1024 + (R >> 5) * 16 + (R & 15)) : ((R & ~31) + perm32(R & 31));
        voffA[i] = (unsigned)(R * g.lda + C) * 2u; voffB[i] = (unsigned)(Rb * g.ldb + C) * 2u; }
    const size_t kstep = (size_t)(BK * 2);
    const size_t hstepA = (size_t)HALF * g.lda * 2, hstepB = (size_t)(g.bmode ? 2048 : HALF) * g.ldb * 2;
    const size_t tstepA = 2 * hstepA, tstepB = (size_t)(g.bmode ? 64 : 256) * g.ldb * 2;
    const unsigned ldsw = (unsigned)wid * 1024u;
    const int aoff = lds_byte(wr * 64 + fr, fq * 8), boff = lds_byte(wc * 32 + fr, fq * 8);
#define PG8_SA(b, h) (((b) * 2 + (h)) * HTB)
#define PG8_SB(b, h) ((4 + (b) * 2 + (h)) * HTB)
#define PG8_STAGE(bufoff, gbase, voff) do { _Pragma("unroll") for (int _i = 0; _i < 2; ++_i) \
        __builtin_amdgcn_global_load_lds((const unsigned*)((const char*)(gbase) + (voff)[_i]), (PG8_LAS unsigned*)(lds + (bufoff) + ldsw + _i * 8192), 16, 0, 0); } while (0)
#define PG8_LDA(dst, b, h) do { _Pragma("unroll") for (int m = 0; m < 4; ++m) _Pragma("unroll") for (int k = 0; k < 2; ++k) dst[m][k] = *(const PG8_LAS bf16x8*)(lds + PG8_SA(b, h) + aoff + m * 2048 + k * 1024); } while (0)
#define PG8_LDB(dst, b, h) do { _Pragma("unroll") for (int n = 0; n < 2; ++n) _Pragma("unroll") for (int k = 0; k < 2; ++k) dst[n][k] = *(const PG8_LAS bf16x8*)(lds + PG8_SB(b, h) + boff + n * 2048 + k * 1024); } while (0)
#define PG8_MMA(ai, bj, At, Bt) do { __builtin_amdgcn_s_setprio(1); _Pragma("unroll") for (int m = 0; m < 4; ++m) _Pragma("unroll") for (int n = 0; n < 2; ++n) _Pragma("unroll") for (int k = 0; k < 2; ++k) \
        acc[ai][bj][m][n] = __builtin_amdgcn_mfma_f32_16x16x32_bf16(Bt[n][k], At[m][k], acc[ai][bj][m][n], 0, 0, 0); __builtin_amdgcn_s_setprio(0); } while (0)
#define PG8_WAIT_V(n) asm volatile("s_waitcnt vmcnt(" #n ")" ::: "memory")
#define PG8_WAIT_L(n) asm volatile("s_waitcnt lgkmcnt(" #n ")" ::: "memory")
#define PG8_BAR __builtin_amdgcn_s_barrier()
#define PG8_SCHED __builtin_amdgcn_sched_barrier(0)
    Unit cur, nxt; int ui = 0;
    if (!S.next(0, cur)) return;
    f32x4 acc[2][2][4][2];
#pragma unroll
    for (int a = 0; a < 2; ++a)
#pragma unroll
        for (int b = 0; b < 2; ++b)
#pragma unroll
            for (int m = 0; m < 4; ++m)
#pragma unroll
                for (int n = 0; n < 2; ++n) acc[a][b][m][n] = (f32x4){0.f, 0.f, 0.f, 0.f};
    bf16x8 At[4][2], B0[2][2], B1[2][2];
    const char* cA = (const char*)g.A + (size_t)cur.pm * tstepA + (size_t)cur.ak * 2; const char* cB = (const char*)g.Bt + (size_t)cur.bn * tstepB;
    S.a_ready(cur);
    if constexpr (SP2) {
        PG8_STAGE(PG8_SB(0, 0), cB, voffB); PG8_STAGE(PG8_SB(0, 1), cB + hstepB, voffB); PG8_STAGE(PG8_SA(0, 0), cA, voffA); PG8_STAGE(PG8_SA(0, 1), cA + hstepA, voffA);
        if (wr == 1) PG8_BAR;
        PG8_WAIT_V(2); PG8_BAR;
        PG8_STAGE(PG8_SB(1, 0), cB + kstep, voffB); PG8_STAGE(PG8_SA(1, 0), cA + kstep, voffA); PG8_STAGE(PG8_SB(1, 1), cB + hstepB + kstep, voffB);
        PG8_WAIT_V(6); PG8_BAR;
    } else {
        PG8_STAGE(PG8_SB(0, 0), cB, voffB); PG8_STAGE(PG8_SA(0, 0), cA, voffA); PG8_STAGE(PG8_SB(0, 1), cB + hstepB, voffB); PG8_STAGE(PG8_SA(0, 1), cA + hstepA, voffA);
        if (wr == 1) PG8_BAR;
        PG8_WAIT_V(4); PG8_BAR;
        PG8_STAGE(PG8_SB(1, 0), cB + kstep, voffB); PG8_STAGE(PG8_SA(1, 0), cA + kstep, voffA); PG8_STAGE(PG8_SB(1, 1), cB + hstepB + kstep, voffB);
        PG8_WAIT_V(6); PG8_BAR;
    }
    for (;;) {
        const bool has_next = S.next(ui + 1, nxt);
        const char* nA = has_next ? (const char*)g.A + (size_t)nxt.pm * tstepA + (size_t)nxt.ak * 2 : cA; const char* nB = has_next ? (const char*)g.Bt + (size_t)nxt.bn * tstepB : cB;
        for (int t = 0; t < nt; t += 2) {
            const bool last = (t == nt - 2);
            const char* a1 = cA + (size_t)(t + 1) * kstep;
            const char* a2 = last ? nA : cA + (size_t)(t + 2) * kstep; const char* b2 = last ? nB : cB + (size_t)(t + 2) * kstep;
            const char* a3 = a2 + kstep; const char* b3 = b2 + kstep;
            if (last && has_next) S.a_ready(nxt);
            if constexpr (SP2) {
            PG8_LDB(B0, 0, 0); PG8_LDB(B1, 0, 1); PG8_SCHED; PG8_LDA(At, 0, 0); PG8_STAGE(PG8_SA(1, 1), a1 + hstepA, voffA);
            PG8_WAIT_V(8); PG8_WAIT_L(0); PG8_BAR; PG8_MMA(0, 0, At, B0); PG8_MMA(0, 1, At, B1); PG8_BAR; PG8_SCHED;
            PG8_LDA(At, 0, 1); PG8_STAGE(PG8_SB(0, 0), b2, voffB); PG8_STAGE(PG8_SB(0, 1), b2 + hstepB, voffB); PG8_STAGE(PG8_SA(0, 0), a2, voffA);
            PG8_WAIT_V(8); PG8_WAIT_L(0); PG8_BAR; PG8_MMA(1, 0, At, B0); PG8_MMA(1, 1, At, B1); PG8_BAR; PG8_SCHED;
            PG8_LDB(B0, 1, 0); PG8_LDB(B1, 1, 1); PG8_SCHED; PG8_LDA(At, 1, 0); PG8_STAGE(PG8_SA(0, 1), a2 + hstepA, voffA);
            PG8_WAIT_V(8); PG8_WAIT_L(0); PG8_BAR; PG8_MMA(0, 0, At, B0); PG8_MMA(0, 1, At, B1); PG8_BAR; PG8_SCHED;
            PG8_LDA(At, 1, 1); PG8_STAGE(PG8_SB(1, 0), b3, voffB); PG8_STAGE(PG8_SB(1, 1), b3 + hstepB, voffB); PG8_STAGE(PG8_SA(1, 0), a3, voffA);
            PG8_WAIT_V(8); PG8_WAIT_L(0); PG8_BAR; PG8_MMA(1, 0, At, B0); PG8_MMA(1, 1, At, B1); PG8_BAR; PG8_SCHED;
            } else {
            PG8_LDB(B0, 0, 0); PG8_SCHED; PG8_LDA(At, 0, 0); PG8_STAGE(PG8_SA(1, 1), a1 + hstepA, voffA);
            PG8_WAIT_L(8); PG8_BAR; PG8_WAIT_L(0); PG8_MMA(0, 0, At, B0); PG8_BAR; PG8_SCHED;
            PG8_LDB(B1, 0, 1); PG8_STAGE(PG8_SB(0, 0), b2, voffB);
            PG8_BAR; PG8_WAIT_L(0); PG8_MMA(0, 1, At, B1); PG8_BAR;
            PG8_LDA(At, 0, 1); PG8_STAGE(PG8_SA(0, 0), a2, voffA);
            PG8_BAR; PG8_WAIT_L(0); PG8_MMA(1, 0, At, B0); PG8_BAR; PG8_SCHED;
            PG8_STAGE(PG8_SB(0, 1), b2 + hstepB, voffB);
            PG8_WAIT_V(6); PG8_BAR; PG8_MMA(1, 1, At, B1); PG8_BAR;
            PG8_LDB(B0, 1, 0); PG8_SCHED; PG8_LDA(At, 1, 0); PG8_STAGE(PG8_SA(0, 1), a2 + hstepA, voffA);
            PG8_WAIT_L(8); PG8_BAR; PG8_WAIT_L(0); PG8_MMA(0, 0, At, B0); PG8_BAR; PG8_SCHED;
            PG8_LDB(B1, 1, 1); PG8_STAGE(PG8_SB(1, 0), b3, voffB);
            PG8_BAR; PG8_WAIT_L(0); PG8_MMA(0, 1, At, B1); PG8_BAR;
            PG8_LDA(At, 1, 1); PG8_STAGE(PG8_SA(1, 0), a3, voffA);
            PG8_BAR; PG8_WAIT_L(0); PG8_MMA(1, 0, At, B0); PG8_BAR; PG8_SCHED;
            PG8_STAGE(PG8_SB(1, 1), b3 + hstepB, voffB);
            PG8_WAIT_V(6); PG8_BAR; PG8_MMA(1, 1, At, B1); PG8_BAR;
            }
        }
        if constexpr (ALIGN_EPI) { if (wr == 0) PG8_BAR; }
        if constexpr (!Epi::AFTER_DRAIN) { E(acc, cur, wr, wc, fr, fq); S.done(cur); }
        if (!has_next) break;
#pragma unroll
        for (int a = 0; a < 2; ++a)
#pragma unroll
            for (int b = 0; b < 2; ++b)
#pragma unroll
                for (int m = 0; m < 4; ++m)
#pragma unroll
                    for (int n = 0; n < 2; ++n) acc[a][b][m][n] = (f32x4){0.f, 0.f, 0.f, 0.f};
        cur = nxt; cA = nA; cB = nB; ++ui;
        if constexpr (ALIGN_EPI) { if (wr == 1) PG8_BAR; }
    }
    PG8_WAIT_V(0);
    if constexpr (!ALIGN_EPI) { if (wr == 0) PG8_BAR; }
    PG8_BAR;
    if constexpr (Epi::AFTER_DRAIN) { E.fused(acc, cur, wr, wc, fr, fq, lds, wid, lane); S.done(cur); }
#undef PG8_SA
#undef PG8_SB
#undef PG8_STAGE
#undef PG8_LDA
#undef PG8_LDB
#undef PG8_MMA
#undef PG8_WAIT_V
#undef PG8_WAIT_L
#undef PG8_BAR
#undef PG8_SCHED
}
}

constexpr int MTOK = 32768, DM = 1024, SEQ = 8192, NLAYER = 4, NIN = 6048, DFF = 4096;
constexpr float EPS = 1e-6f;
constexpr float QSCALE = 0.10206207261596575f * 1.4426950408889634f;
constexpr size_t MiB = 1u << 20;
constexpr size_t WS_RS = 1 * MiB, WS_ROPEC = 2 * MiB, WS_ROPES = 4 * MiB;
constexpr size_t WS_WIN = 6 * MiB, WS_WUQ = 18 * MiB, WS_WK = WS_WUQ + 256 * 1024, WS_WV = WS_WK + 64 * 1024, WS_SGW = WS_WUQ + 512 * 1024;
constexpr size_t WS_WBR = 19 * MiB, WS_WOUT = 21 * MiB, WS_W1 = 23 * MiB, WS_W2 = 31 * MiB;
constexpr size_t WS_XBF = 40 * MiB;
constexpr size_t WS_BR = 104 * MiB;
constexpr size_t WS_BIG = 168 * MiB;
constexpr size_t WS_PROJ = WS_BIG, WS_CQN = WS_BIG + 128 * MiB, WS_CKVN = WS_BIG + 144 * MiB, WS_KR = WS_BIG + 152 * MiB, WS_Q = WS_BIG + 154 * MiB, WS_KN = WS_BIG + 186 * MiB, WS_VT = WS_BIG + 202 * MiB;
constexpr size_t WS_END = 424 * MiB;
constexpr int LDS_BYTES = 147456;

struct Args { const float* in[26]; float* out; unsigned char* ws; int lo, hi; };
enum { I_X = 0, I_POS, I_NPRE, I_WIN, I_GATEB, I_QN, I_WUQ, I_KVN, I_WUKV, I_WBRMLA, I_LNG, I_LNB, I_SGW, I_SGB, I_WBRSG, I_CONVW, I_WBRCONV, I_POOLW, I_POOLS, I_WBRPOOL, I_WOUT, I_NPOST, I_NFPRE, I_WFF1, I_WFF2, I_NFPOST };

typedef __bf16 bf16x2_t __attribute__((ext_vector_type(2)));
__device__ __forceinline__ unsigned cvtpk_v(float lo, float hi) { f32x2 v = {lo, hi}; bf16x2_t b = __builtin_convertvector(v, bf16x2_t); return __builtin_bit_cast(unsigned, b); }
__device__ __forceinline__ int crow(int r, int hi) { return (r & 3) + 8 * (r >> 2) + 4 * hi; }
#define MFMA32(a, b, c) __builtin_amdgcn_mfma_f32_32x32x16_bf16((a), (b), (c), 0, 0, 0)

__device__ __forceinline__ void tr_item(const float* __restrict__ W, int ldw, int k0, int srcn0, const float* __restrict__ gk, float mul, bf16_t* WT, int ldt, int dstn0, LAS float* scr, int lane) {
#pragma unroll 8
    for (int i = 0; i < 32; ++i) { const int kk = 2 * i + (lane >> 5); float v = 0.f;
        if (srcn0 >= 0) { v = W[(size_t)(k0 + kk) * ldw + srcn0 + (lane & 31)] * mul; if (gk) v *= gk[k0 + kk]; }
        scr[kk * 33 + (lane & 31)] = v; }
    asm volatile("s_waitcnt lgkmcnt(0)" ::: "memory");
    const int c = lane & 7;
#pragma unroll
    for (int j = 0; j < 4; ++j) { const int n = (lane >> 3) + 8 * j; const LAS float* s = scr + (8 * c) * 33 + n;
        u32x4 o; o.x = pk2(s[0 * 33], s[1 * 33]); o.y = pk2(s[2 * 33], s[3 * 33]); o.z = pk2(s[4 * 33], s[5 * 33]); o.w = pk2(s[6 * 33], s[7 * 33]);
        *(u32x4*)(WT + (size_t)(dstn0 + n) * ldt + k0 + 8 * c) = o; }
    asm volatile("s_waitcnt lgkmcnt(0)" ::: "memory");
}

__device__ __forceinline__ void prep_weights(const Args& a, int l, LAS unsigned char* lds, int tid) {
    const int lane = tid & 63, wave = tid >> 6, G = gridDim.x;
    LAS float* scr = (LAS float*)(lds + wave * 8448);
    const int gw = blockIdx.x * 8 + wave, NGW = G * 8;
    unsigned char* ws = a.ws;
    constexpr int N0 = 16 * 192, N1 = 4 * 16, N2 = 2 * 8, N3 = 2 * 8, N4 = 3 * 4 * 32, N5 = 16 * 32, N6 = 16 * 128, N7 = 64 * 32;
    constexpr int NITEMS = N0 + N1 + N2 + N3 + N4 + N5 + N6 + N7;
    for (int it = gw; it < NITEMS; it += NGW) {
        int r = it;
        if (r < N0) { const int kb = r / 192, nb = r % 192, d0 = nb * 32; const int src = d0 < 416 ? d0 : (d0 < 512 ? -1 : d0 - 96);
            tr_item(a.in[I_WIN] + (size_t)l * DM * NIN, NIN, kb * 64, src, a.in[I_NPRE] + l * DM, 1.f, (bf16_t*)(ws + WS_WIN), DM, d0, scr, lane); continue; } r -= N0;
        if (r < N1) { const int kb = r / 16, nb = r % 16;
            tr_item(a.in[I_WUQ] + (size_t)l * 256 * 384, 384, kb * 64, nb < 12 ? nb * 32 : -1, a.in[I_QN] + l * 256, QSCALE, (bf16_t*)(ws + WS_WUQ), 256, nb * 32, scr, lane); continue; } r -= N1;
        if (r < N2) { const int kb = r / 8, nb = r % 8;
            tr_item(a.in[I_WUKV] + (size_t)l * 128 * 512, 512, kb * 64, (nb >> 1) * 128 + (nb & 1) * 32, a.in[I_KVN] + l * 128, 1.f, (bf16_t*)(ws + WS_WK), 128, nb * 32, scr, lane); continue; } r -= N2;
        if (r < N3) { const int kb = r / 8, nb = r % 8;
            tr_item(a.in[I_WUKV] + (size_t)l * 128 * 512, 512, kb * 64, (nb >> 1) * 128 + 64 + (nb & 1) * 32, a.in[I_KVN] + l * 128, 1.f, (bf16_t*)(ws + WS_WV), 128, nb * 32, scr, lane); continue; } r -= N3;
        if (r < N4) { const int z = r / 128, rr = r % 128, kb = rr / 32, nb = rr % 32; const float* W = (z == 0 ? a.in[I_WBRMLA] : z == 1 ? a.in[I_WBRSG] : a.in[I_WBRCONV]) + (size_t)l * 256 * DM;
            tr_item(W, DM, kb * 64, nb * 32, nullptr, 1.f, (bf16_t*)(ws + WS_WBR) + (size_t)z * DM * 256, 256, nb * 32, scr, lane); continue; } r -= N4;
        if (r < N5) { const int kb = r / 32, nb = r % 32;
            tr_item(a.in[I_WOUT] + (size_t)l * DM * DM, DM, kb * 64, nb * 32, nullptr, 1.f, (bf16_t*)(ws + WS_WOUT), DM, nb * 32, scr, lane); continue; } r -= N5;
        if (r < N6) { const int kb = r / 128, nb = r % 128;
            tr_item(a.in[I_WFF1] + (size_t)l * DM * DFF, DFF, kb * 64, nb * 32, a.in[I_NFPRE] + l * DM, 1.f, (bf16_t*)(ws + WS_W1), DM, nb * 32, scr, lane); continue; } r -= N6;
        { const int kb = r / 32, nb = r % 32;
            tr_item(a.in[I_WFF2] + (size_t)l * DFF * DM, DM, kb * 64, nb * 32, nullptr, 1.f, (bf16_t*)(ws + WS_W2), DFF, nb * 32, scr, lane); }
    }
    const int gt = blockIdx.x * 512 + tid, NGT = G * 512;
    { const float* sw = a.in[I_SGW] + (size_t)l * 65536; bf16_t* o = (bf16_t*)(ws + WS_SGW);
      for (int i = gt; i < 65536; i += NGT) { const int t = (i >> 7) & 127, s = i & 127; o[i] = (bf16_t)f2bf(s <= t ? sw[i] : 0.f); } }
    { const float* wp = a.in[I_POOLW] + (size_t)l * 4 * 64 * 64; const float* sc = a.in[I_POOLS] + l * 256; const float* wb = a.in[I_WBRPOOL] + (size_t)l * 256 * DM;
      bf16_t* o = (bf16_t*)(ws + WS_WBR) + (size_t)3 * DM * 256;
      for (int i = gt; i < 256 * DM; i += NGT) { const int n = i & 1023, cp = i >> 10, g = cp >> 6, c = cp & 63; float acc = 0.f;
          for (int d = 0; d < 64; ++d) acc += wp[(g * 64 + c) * 64 + d] * sc[g * 64 + d] * wb[(size_t)(g * 64 + d) * DM + n];
          o[(size_t)n * 256 + cp] = (bf16_t)f2bf(acc); } }
}

__device__ __forceinline__ void phase_s0(const Args& a, LAS unsigned char* lds, int tid) {
    const int G = gridDim.x, gt = blockIdx.x * 512 + tid, NGT = G * 512;
    const int* pos = (const int*)a.in[I_POS];
    float* rc = (float*)(a.ws + WS_ROPEC); float* rsn = (float*)(a.ws + WS_ROPES);
    for (int i = gt; i < MTOK * 16; i += NGT) { const int tok = i & (MTOK - 1); const int k = __builtin_amdgcn_readfirstlane(i >> 15);
        const unsigned chi = (k == 0 ? 0x3fc45f30u : (k == 1 ? 0x3fb6e96eu : (k == 2 ? 0x3fa9c4c0u : (k == 3 ? 0x3f9cfb40u : (k == 4 ? 0x3f904c26u : (k == 5 ? 0x3f825458u : (k == 6 ? 0x3f749d66u : (k == 7 ? 0x3f672f66u : (k == 8 ? 0x3f5a1371u : (k == 9 ? 0x3f4d53c1u : (k == 10 ? 0x3f407debu : (k == 11 ? 0x3f328c52u : (k == 12 ? 0x3f24dc5au : (k == 13 ? 0x3f177634u : (k == 14 ? 0x3f0a6312u : (k == 15 ? 0x3efdad50u : 0u))))))))))))))));
        const unsigned clo = (k == 0 ? 0x6dc9c883u : (k == 1 ? 0xcaebf83fu : (k == 2 ? 0x200b604fu : (k == 3 ? 0x35fd7496u : (k == 4 ? 0xbe3b06cfu : (k == 5 ? 0xa2566033u : (k == 6 ? 0x800919d9u : (k == 7 ? 0x91979078u : (k == 8 ? 0x305e714cu : (k == 9 ? 0x03bd66b8u : (k == 10 ? 0x99a0e17au : (k == 11 ? 0x0e12d9f9u : (k == 12 ? 0x8d185aa3u : (k == 13 ? 0x02fdebc6u : (k == 14 ? 0x8f67cf2au : (k == 15 ? 0x16848ff5u : 0u))))))))))))))));
        const double cf = __hiloint2double((int)chi, (int)clo);
        const double rev = (double)pos[tok] * cf;
        const float fr = (float)(rev - __builtin_rint(rev));
        rc[tok * 16 + k] = __builtin_amdgcn_cosf(fr); rsn[tok * 16 + k] = __builtin_amdgcn_sinf(fr); }
    const int lane = tid & 63, wave = tid >> 6, gw = blockIdx.x * 8 + wave, NGW = G * 8;
    const float* x = a.in[I_X]; float* xo = a.out; bf16_t* xb = (bf16_t*)(a.ws + WS_XBF); float* rs = (float*)(a.ws + WS_RS);
    for (int row = gw; row < MTOK; row += NGW) {
        const float* xr = x + (size_t)row * DM + 8 * lane; bf16_t* bw = xb + (size_t)row * DM + 8 * lane;
        float ss = 0.f;
#pragma unroll
        for (int j = 0; j < 2; ++j) { const f32x4 v0 = *(const f32x4*)(xr + 512 * j), v1 = *(const f32x4*)(xr + 512 * j + 4);
            ss += v0.x * v0.x + v0.y * v0.y + v0.z * v0.z + v0.w * v0.w + v1.x * v1.x + v1.y * v1.y + v1.z * v1.z + v1.w * v1.w;
            u32x4 o; o.x = pk2(v0.x, v0.y); o.y = pk2(v0.z, v0.w); o.z = pk2(v1.x, v1.y); o.w = pk2(v1.z, v1.w); *(u32x4*)(bw + 512 * j) = o; }
        ss = wave_sum(ss);
        if (lane == 0) rs[row] = 1.0f / sqrtf(ss * (1.0f / DM) + EPS);
    }
}

__device__ __forceinline__ void phase_nr(const Args& a, const float* gpost, size_t ysrc, bool final_out, int tid) {
    const int G = gridDim.x, lane = tid & 63, wave = tid >> 6, gw = blockIdx.x * 8 + wave, NGW = G * 8;
    float* xo = a.out; bf16_t* xb = (bf16_t*)(a.ws + WS_XBF); float* rs = (float*)(a.ws + WS_RS); const bf16_t* y = (const bf16_t*)(a.ws + ysrc);
    f32x4 gv[4];
#pragma unroll
    for (int j = 0; j < 2; ++j) { gv[2 * j] = *(const f32x4*)(gpost + 8 * lane + 512 * j); gv[2 * j + 1] = *(const f32x4*)(gpost + 8 * lane + 512 * j + 4); }
    constexpr int NR = 4;
    for (int grp = gw; grp < MTOK / NR; grp += NGW) {
        u32x4 yw[NR][2], xw[NR][2];
#pragma unroll
        for (int r = 0; r < NR; ++r) { const size_t off = (size_t)(grp * NR + r) * DM + 8 * lane;
#pragma unroll
            for (int j = 0; j < 2; ++j) { yw[r][j] = *(const u32x4*)(y + off + 512 * j); xw[r][j] = *(const u32x4*)(xb + off + 512 * j); } }
        float ss[NR];
#pragma unroll
        for (int r = 0; r < NR; ++r) { float s_ = 0.f;
#pragma unroll
            for (int j = 0; j < 2; ++j) { const u32x4 w = yw[r][j]; const float e0 = bflo(w.x), e1 = bfhi(w.x), e2 = bflo(w.y), e3 = bfhi(w.y), e4 = bflo(w.z), e5 = bfhi(w.z), e6 = bflo(w.w), e7 = bfhi(w.w);
                s_ += e0 * e0 + e1 * e1 + e2 * e2 + e3 * e3 + e4 * e4 + e5 * e5 + e6 * e6 + e7 * e7; }
            ss[r] = s_; }
#pragma unroll
        for (int o = 1; o < 64; o <<= 1) {
#pragma unroll
            for (int r = 0; r < NR; ++r) ss[r] += __shfl_xor(ss[r], o); }
        float xs[NR];
#pragma unroll
        for (int r = 0; r < NR; ++r) { const float ry = 1.0f / sqrtf(ss[r] * (1.0f / DM) + EPS); float s_ = 0.f; const size_t off = (size_t)(grp * NR + r) * DM + 8 * lane;
#pragma unroll
            for (int j = 0; j < 2; ++j) { const u32x4 w = yw[r][j]; const u32x4 xx = xw[r][j]; f32x4 a0, a1;
                a0[0] = bflo(xx.x) + bflo(w.x) * ry * gv[2 * j][0]; a0[1] = bfhi(xx.x) + bfhi(w.x) * ry * gv[2 * j][1]; a0[2] = bflo(xx.y) + bflo(w.y) * ry * gv[2 * j][2]; a0[3] = bfhi(xx.y) + bfhi(w.y) * ry * gv[2 * j][3];
                a1[0] = bflo(xx.z) + bflo(w.z) * ry * gv[2 * j + 1][0]; a1[1] = bfhi(xx.z) + bfhi(w.z) * ry * gv[2 * j + 1][1]; a1[2] = bflo(xx.w) + bflo(w.w) * ry * gv[2 * j + 1][2]; a1[3] = bfhi(xx.w) + bfhi(w.w) * ry * gv[2 * j + 1][3];
                if (final_out) { *(f32x4*)(xo + off + 512 * j) = a0; *(f32x4*)(xo + off + 512 * j + 4) = a1; }
                else { u32x4 o; o.x = pk2(a0[0], a0[1]); o.y = pk2(a0[2], a0[3]); o.z = pk2(a1[0], a1[1]); o.w = pk2(a1[2], a1[3]); *(u32x4*)(xb + off + 512 * j) = o;
                    const float b0 = bflo(o.x), b1 = bfhi(o.x), b2 = bflo(o.y), b3 = bfhi(o.y), b4 = bflo(o.z), b5 = bfhi(o.z), b6 = bflo(o.w), b7 = bfhi(o.w);
                    s_ += b0 * b0 + b1 * b1 + b2 * b2 + b3 * b3 + b4 * b4 + b5 * b5 + b6 * b6 + b7 * b7; } }
            xs[r] = s_; }
        if (!final_out) {
#pragma unroll
            for (int o = 1; o < 64; o <<= 1) {
#pragma unroll
                for (int r = 0; r < NR; ++r) xs[r] += __shfl_xor(xs[r], o); }
            if (lane == 0) {
#pragma unroll
                for (int r = 0; r < NR; ++r) rs[grp * NR + r] = 1.0f / sqrtf(xs[r] * (1.0f / DM) + EPS); } }
    }
}

__device__ __forceinline__ void unpack8(const u32x4 w, float (&f)[8]) { f[0] = bflo(w.x); f[1] = bfhi(w.x); f[2] = bflo(w.y); f[3] = bfhi(w.y); f[4] = bflo(w.z); f[5] = bfhi(w.z); f[6] = bflo(w.w); f[7] = bfhi(w.w); }
__device__ __forceinline__ u32x4 pack8(const float (&f)[8]) { u32x4 o; o.x = pk2(f[0], f[1]); o.y = pk2(f[2], f[3]); o.z = pk2(f[4], f[5]); o.w = pk2(f[6], f[7]); return o; }

__device__ __forceinline__ void phase_e1(const Args& a, int l, LAS unsigned char* lds, int tid) {
    const int lane = tid & 63, wid = __builtin_amdgcn_readfirstlane(tid >> 6), r32 = lane & 31, hi = lane >> 5;
    unsigned char* ws = a.ws;
    const bf16_t* P = (const bf16_t*)(ws + WS_PROJ); bf16_t* CQN = (bf16_t*)(ws + WS_CQN); bf16_t* CKVN = (bf16_t*)(ws + WS_CKVN); bf16_t* KR = (bf16_t*)(ws + WS_KR);
    bf16_t* BR = (bf16_t*)(ws + WS_BR); const float* rc = (const float*)(ws + WS_ROPEC); const float* rsn = (const float*)(ws + WS_ROPES);
    const bf16_t* SGWB = (const bf16_t*)(ws + WS_SGW);
    const float* convw = a.in[I_CONVW] + l * 3 * 256; const float* lng = a.in[I_LNG] + l * 256; const float* lnb = a.in[I_LNB] + l * 256; const float* sgb = a.in[I_SGB] + l * 512;
    for (int tile = blockIdx.x; tile < MTOK / 128; tile += gridDim.x) {
        const int R0 = tile * 128, s0 = R0 & (SEQ - 1);
        { const int rsub = lane >> 4, li = lane & 15;
#pragma unroll
          for (int it2 = 0; it2 < 2; ++it2) {
              u32x4 cqa[2], cqb[2], ckv[2]; float x1[2], x2[2], cc[2], ss[2];
#pragma unroll
              for (int u = 0; u < 2; ++u) { const int row = R0 + wid * 16 + (it2 * 2 + u) * 4 + rsub; const bf16_t* pr = P + (size_t)row * 2048;
                  cqa[u] = *(const u32x4*)(pr + 8 * li); cqb[u] = *(const u32x4*)(pr + 128 + 8 * li); ckv[u] = *(const u32x4*)(pr + 256 + 8 * li);
                  x1[u] = bf2f(pr[384 + li]); x2[u] = bf2f(pr[400 + li]); cc[u] = rc[(size_t)row * 16 + li]; ss[u] = rsn[(size_t)row * 16 + li]; }
#pragma unroll
              for (int u = 0; u < 2; ++u) { const int row = R0 + wid * 16 + (it2 * 2 + u) * 4 + rsub;
                  float qa[8], qb[8], kv[8]; unpack8(cqa[u], qa); unpack8(cqb[u], qb); unpack8(ckv[u], kv);
                  float sq = 0.f, sk = 0.f;
#pragma unroll
                  for (int e = 0; e < 8; ++e) { sq += qa[e] * qa[e] + qb[e] * qb[e]; sk += kv[e] * kv[e]; }
#pragma unroll
                  for (int o = 1; o < 16; o <<= 1) { sq += __shfl_xor(sq, o); sk += __shfl_xor(sk, o); }
                  const float rq = 1.0f / sqrtf(sq * (1.0f / 256.0f) + EPS), rk = 1.0f / sqrtf(sk * (1.0f / 128.0f) + EPS);
#pragma unroll
                  for (int e = 0; e < 8; ++e) { qa[e] *= rq; qb[e] *= rq; kv[e] *= rk; }
                  *(u32x4*)(CQN + (size_t)row * 256 + 8 * li) = pack8(qa); *(u32x4*)(CQN + (size_t)row * 256 + 128 + 8 * li) = pack8(qb);
                  *(u32x4*)(CKVN + (size_t)row * 128 + 8 * li) = pack8(kv);
                  KR[(size_t)row * 32 + li] = (bf16_t)f2bf(x1[u] * cc[u] - x2[u] * ss[u]); KR[(size_t)row * 32 + 16 + li] = (bf16_t)f2bf(x2[u] * cc[u] + x1[u] * ss[u]); } } }
        { const int ch = tid & 31, run = tid >> 5, t0 = run * 8; const bf16_t* pb = P + (size_t)(R0 + t0) * 2048 + 8 * ch; const int sb = s0 + t0;
          { float w0[8], w1[8], w2[8];
#pragma unroll
            for (int e = 0; e < 8; ++e) { w0[e] = convw[8 * ch + e]; w1[e] = convw[256 + 8 * ch + e]; w2[e] = convw[512 + 8 * ch + e]; }
            float zm2[8], zm1[8];
#pragma unroll
            for (int e = 0; e < 8; ++e) { zm2[e] = 0.f; zm1[e] = 0.f; }
            if (sb >= 2) { float xv[8], cv[8]; unpack8(*(const u32x4*)(pb - 2 * 2048 + 1024), xv); unpack8(*(const u32x4*)(pb - 2 * 2048 + 1536), cv);
#pragma unroll
                for (int e = 0; e < 8; ++e) zm2[e] = xv[e] * cv[e]; }
            if (sb >= 1) { float xv[8], cv[8]; unpack8(*(const u32x4*)(pb - 2048 + 1024), xv); unpack8(*(const u32x4*)(pb - 2048 + 1536), cv);
#pragma unroll
                for (int e = 0; e < 8; ++e) zm1[e] = xv[e] * cv[e]; }
#pragma unroll
            for (int half = 0; half < 2; ++half) { u32x4 lx[4], lc[4], lb[4];
#pragma unroll
                for (int j = 0; j < 4; ++j) { const bf16_t* pr = pb + (size_t)(half * 4 + j) * 2048; lx[j] = *(const u32x4*)(pr + 1024); lc[j] = *(const u32x4*)(pr + 1536); lb[j] = *(const u32x4*)(pr + 1280); }
#pragma unroll
                for (int j = 0; j < 4; ++j) { float xv[8], cv[8], bg[8], y[8]; unpack8(lx[j], xv); unpack8(lc[j], cv); unpack8(lb[j], bg);
#pragma unroll
                    for (int e = 0; e < 8; ++e) { const float z = xv[e] * cv[e]; y[e] = bg[e] * (w0[e] * zm2[e] + w1[e] * zm1[e] + w2[e] * z); zm2[e] = zm1[e]; zm1[e] = z; }
                    *(u32x4*)(BR + (size_t)(R0 + t0 + half * 4 + j) * DM + 512 + 8 * ch) = pack8(y); } } }
          { const int g = ch >> 3, win = 2 << g; float S[8];
#pragma unroll
            for (int e = 0; e < 8; ++e) S[e] = 0.f;
            for (int i = 1; i < win; ++i) { if (sb - i >= 0) { float pv[8]; unpack8(*(const u32x4*)(pb - (size_t)i * 2048 + 1792), pv);
#pragma unroll
                    for (int e = 0; e < 8; ++e) S[e] += pv[e]; } }
#pragma unroll
            for (int half = 0; half < 2; ++half) { u32x4 lp[4], lo[4];
#pragma unroll
                for (int j = 0; j < 4; ++j) { const int t = half * 4 + j; lp[j] = *(const u32x4*)(pb + (size_t)t * 2048 + 1792);
                    const int back = t - win + 1; lo[j] = (sb + back >= 0) ? *(const u32x4*)(pb + (ptrdiff_t)back * 2048 + 1792) : (u32x4){0u, 0u, 0u, 0u}; }
#pragma unroll
                for (int j = 0; j < 4; ++j) { const int t = half * 4 + j; float pt[8], po[8], o[8]; unpack8(lp[j], pt); unpack8(lo[j], po);
                    const int s = sb + t; const int cnt = (s + 1) < win ? (s + 1) : win; const float ic = 1.0f / (float)cnt;
#pragma unroll
                    for (int e = 0; e < 8; ++e) { S[e] += pt[e]; o[e] = S[e] * ic - pt[e]; S[e] -= po[e]; }
                    *(u32x4*)(BR + (size_t)(R0 + t0 + t) * DM + 768 + 8 * ch) = pack8(o); } } } }
        { const int srow = tid >> 2, qt = tid & 3; const bf16_t* vp = P + (size_t)(R0 + srow) * 2048 + 768 + qt * 64;
          float v[64]; float sum = 0.f;
#pragma unroll
          for (int j = 0; j < 8; ++j) { const u32x4 w = *(const u32x4*)(vp + 8 * j);
              v[8 * j + 0] = bflo(w.x); v[8 * j + 1] = bfhi(w.x); v[8 * j + 2] = bflo(w.y); v[8 * j + 3] = bfhi(w.y); v[8 * j + 4] = bflo(w.z); v[8 * j + 5] = bfhi(w.z); v[8 * j + 6] = bflo(w.w); v[8 * j + 7] = bfhi(w.w); }
#pragma unroll
          for (int j = 0; j < 64; ++j) sum += v[j];
          sum += __shfl_xor(sum, 1); sum += __shfl_xor(sum, 2);
          const float mean = sum * (1.0f / 256.0f); float var = 0.f;
#pragma unroll
          for (int j = 0; j < 64; ++j) { v[j] -= mean; var += v[j] * v[j]; }
          var += __shfl_xor(var, 1); var += __shfl_xor(var, 2);
          const float rstd = 1.0f / sqrtf(var * (1.0f / 256.0f) + EPS);
          LAS bf16_t* vT = (LAS bf16_t*)lds;
#pragma unroll
          for (int j = 0; j < 64; ++j) { const int c = qt * 64 + j; vT[c * 136 + srow] = (bf16_t)f2bf(v[j] * rstd * lng[c] + lnb[c]); } }
        __syncthreads();
        { const int g = wid >> 1, th = wid & 1;
#pragma unroll
          for (int tb = 0; tb < 2; ++tb) {
              const int nks = (64 * th + 32 * tb + 32) >> 4;
              const bf16_t* ap = SGWB + (size_t)(g * 128 + 64 * th + 32 * tb + r32) * 128 + 8 * hi;
              bf16x8 Af[8];
#pragma unroll
              for (int ks = 0; ks < 8; ++ks) Af[ks] = (ks < nks) ? *(const bf16x8*)(ap + 16 * ks) : (bf16x8){0, 0, 0, 0, 0, 0, 0, 0};
              float bsv[16];
#pragma unroll
              for (int r = 0; r < 16; ++r) bsv[r] = sgb[g * 128 + 64 * th + 32 * tb + crow(r, hi)];
#pragma unroll
              for (int cb = 0; cb < 2; ++cb) { f32x16 acc;
#pragma unroll
                  for (int r = 0; r < 16; ++r) acc[r] = 0.f;
                  const LAS unsigned char* bp = lds + (g * 64 + 32 * cb + r32) * 272 + 16 * hi;
                  const int c = g * 64 + 32 * cb + r32;
                  float uv[16];
#pragma unroll
                  for (int r = 0; r < 16; ++r) uv[r] = bf2f(P[(size_t)(R0 + 64 * th + 32 * tb + crow(r, hi)) * 2048 + 512 + c]);
#pragma unroll
                  for (int ks = 0; ks < 8; ++ks) { if (ks < nks) { const bf16x8 B = *(const LAS bf16x8*)(bp + 32 * ks); acc = MFMA32(Af[ks], B, acc); } }
#pragma unroll
                  for (int r = 0; r < 16; ++r) { const int t = 64 * th + 32 * tb + crow(r, hi);
                      BR[(size_t)(R0 + t) * DM + 256 + c] = (bf16_t)f2bf(uv[r] * (acc[r] + bsv[r])); } } } }
        __syncthreads();
    }
}

constexpr int KPITCH = 208, VPITCH = 264, KBUF = 128 * KPITCH, VBUF = 64 * VPITCH, ATT_V0 = 2 * KBUF, ATT_WS = ATT_V0 + 2 * VBUF;
#define ATT_QK(P0, P1, KB) do { \
    _Pragma("unroll") for (int r = 0; r < 16; ++r) { P0[r] = 0.f; P1[r] = 0.f; } \
    _Pragma("unroll") for (int kh = 0; kh < 2; ++kh) { bf16x8 ka_[3], kc_[3]; \
        _Pragma("unroll") for (int ks = 0; ks < 3; ++ks) { ka_[ks] = *(const LAS bf16x8*)((KB) + (3 * kh + ks) * 32); kc_[ks] = *(const LAS bf16x8*)((KB) + 32 * KPITCH + (3 * kh + ks) * 32); } \
        _Pragma("unroll") for (int ks = 0; ks < 3; ++ks) { P0 = MFMA32(ka_[ks], qf[3 * kh + ks], P0); P1 = MFMA32(kc_[ks], qf[3 * kh + ks], P1); } } } while (0)
#define ATT_MAX(P0, P1, TT) do { \
    if (64 * (TT) + 63 > qw0) { const int qg_ = qw0 + r32; \
        _Pragma("unroll") for (int r = 0; r < 16; ++r) { const int kv_ = 64 * (TT) + crow(r, hi); if (kv_ > qg_) P0[r] = -INFINITY; if (kv_ + 32 > qg_) P1[r] = -INFINITY; } } \
    float rm_ = fmaxf(P0[0], P1[0]); \
    _Pragma("unroll") for (int r = 1; r < 16; ++r) rm_ = fmaxf(rm_, fmaxf(P0[r], P1[r])); \
    rm_ = fmaxf(rm_, __shfl_xor(rm_, 32)); \
    if (__any(rm_ > mref + 8.0f)) { const float mnew_ = fmaxf(mref, rm_); const float alpha_ = __builtin_amdgcn_exp2f(mref - mnew_); \
        lsum *= alpha_; mref = mnew_; if (hi == 0) wsf[r32] = alpha_; \
        asm volatile("s_waitcnt lgkmcnt(0)" ::: "memory"); \
        _Pragma("unroll") for (int r = 0; r < 16; ++r) { const float f_ = wsf[crow(r, hi)]; o0[r] *= f_; o1[r] *= f_; } } } while (0)
#define ATT_EXP(P0, P1, PA) do { float ps_ = 0.f; \
    _Pragma("unroll") for (int r = 0; r < 16; ++r) { P0[r] = __builtin_amdgcn_exp2f(P0[r] - mref); P1[r] = __builtin_amdgcn_exp2f(P1[r] - mref); ps_ += P0[r] + P1[r]; } \
    lsum += ps_; u32x4 w_; \
    w_.x = cvtpk_v(P0[0], P0[1]); w_.y = cvtpk_v(P0[2], P0[3]); w_.z = cvtpk_v(P0[4], P0[5]); w_.w = cvtpk_v(P0[6], P0[7]); PA[0] = __builtin_bit_cast(bf16x8, w_); \
    w_.x = cvtpk_v(P0[8], P0[9]); w_.y = cvtpk_v(P0[10], P0[11]); w_.z = cvtpk_v(P0[12], P0[13]); w_.w = cvtpk_v(P0[14], P0[15]); PA[1] = __builtin_bit_cast(bf16x8, w_); \
    w_.x = cvtpk_v(P1[0], P1[1]); w_.y = cvtpk_v(P1[2], P1[3]); w_.z = cvtpk_v(P1[4], P1[5]); w_.w = cvtpk_v(P1[6], P1[7]); PA[2] = __builtin_bit_cast(bf16x8, w_); \
    w_.x = cvtpk_v(P1[8], P1[9]); w_.y = cvtpk_v(P1[10], P1[11]); w_.z = cvtpk_v(P1[12], P1[13]); w_.w = cvtpk_v(P1[14], P1[15]); PA[3] = __builtin_bit_cast(bf16x8, w_); } while (0)
#define ATT_PV(PA, VB) do { \
    _Pragma("unroll") for (int kk = 0; kk < 4; ++kk) { \
        const s16x4 l0_ = *(const LAS s16x4*)((VB) + kk * 32), h0_ = *(const LAS s16x4*)((VB) + kk * 32 + 16); \
        const s16x4 l1_ = *(const LAS s16x4*)((VB) + 32 * VPITCH + kk * 32), h1_ = *(const LAS s16x4*)((VB) + 32 * VPITCH + kk * 32 + 16); \
        const bf16x8 v0_ = __builtin_shufflevector(l0_, h0_, 0, 1, 2, 3, 4, 5, 6, 7), v1_ = __builtin_shufflevector(l1_, h1_, 0, 1, 2, 3, 4, 5, 6, 7); \
        o0 = MFMA32(PA[kk], v0_, o0); o1 = MFMA32(PA[kk], v1_, o1); } } while (0)

__device__ __forceinline__ void attn_unit(const Args& a, int b, int h, int qb, LAS unsigned char* lds, int tid_in) {
    int tid = tid_in; asm volatile("" : "+v"(tid));
    const int lane = tid & 63, wid = __builtin_amdgcn_readfirstlane(tid >> 6), r32 = lane & 31, hi = lane >> 5;
    unsigned char* ws = a.ws;
    const bf16_t* Q = (const bf16_t*)(ws + WS_Q); const bf16_t* Kn = (const bf16_t*)(ws + WS_KN); const bf16_t* Kr = (const bf16_t*)(ws + WS_KR); const bf16_t* Vt = (const bf16_t*)(ws + WS_VT);
    bf16_t* O = (bf16_t*)(ws + WS_BR); const float* rc = (const float*)(ws + WS_ROPEC); const float* rsn = (const float*)(ws + WS_ROPES);
    const size_t rowbase = (size_t)b * SEQ; const int qw0 = qb * 256 + wid * 32;
    LAS float* wsf = (LAS float*)(lds + ATT_WS) + wid * 64;
    bf16x8 qf[6];
    { const size_t qrow = rowbase + qw0 + r32; const bf16_t* qp = Q + qrow * 512 + h * 96 + 8 * hi;
#pragma unroll
      for (int ks = 0; ks < 4; ++ks) qf[ks] = *(const bf16x8*)(qp + 16 * ks);
      const bf16x8 x1 = *(const bf16x8*)(qp + 64), x2 = *(const bf16x8*)(qp + 80);
      const float* cp = rc + qrow * 16 + 8 * hi; const float* sp = rsn + qrow * 16 + 8 * hi;
      const f32x4 c0 = *(const f32x4*)cp, c1 = *(const f32x4*)(cp + 4), s0 = *(const f32x4*)sp, s1 = *(const f32x4*)(sp + 4);
      bf16x8 o1, o2;
#pragma unroll
      for (int j = 0; j < 8; ++j) { const float xa = bf2f((bf16_t)x1[j]), xb = bf2f((bf16_t)x2[j]); const float c = j < 4 ? c0[j & 3] : c1[j & 3], s = j < 4 ? s0[j & 3] : s1[j & 3];
          o1[j] = (short)f2bf(xa * c - xb * s); o2[j] = (short)f2bf(xb * c + xa * s); }
      qf[4] = o1; qf[5] = o2; }
    const bf16_t* knu = Kn + rowbase * 256 + h * 64;
    const bf16_t* kru = Kr + rowbase * 32;
    const bf16_t* vtu = Vt + (size_t)(h * 64) * MTOK + rowbase;
    u32x4 gk0, gk1, gr, gv0, gv1;
#define ATT_LOAD(T) do { int t_ = tid; asm volatile("" : "+v"(t_)); const unsigned knv = (unsigned)((t_ >> 3) * 256 + (t_ & 7) * 8), krv = (unsigned)((t_ >> 2) * 32 + (t_ & 3) * 8), vtv = (unsigned)((t_ >> 3) * MTOK + (t_ & 7) * 8); \
        const bf16_t* k_ = knu + (size_t)(T) * 128 * 256; const bf16_t* r_ = kru + (size_t)(T) * 128 * 32; const bf16_t* v_ = vtu + (size_t)(T) * 128; \
        gk0 = *(const u32x4*)(k_ + knv); gk1 = *(const u32x4*)(k_ + 64 * 256 + knv); gr = *(const u32x4*)(r_ + krv); \
        gv0 = *(const u32x4*)(v_ + vtv); gv1 = *(const u32x4*)(v_ + 64 + vtv); } while (0)
#define ATT_STORE(bf) do { int t_ = tid; asm volatile("" : "+v"(t_)); const int krow = t_ >> 3, kch = t_ & 7, rrow = t_ >> 2, rch = t_ & 3; \
        LAS unsigned char* kd_ = lds + (bf) * KBUF; LAS unsigned char* vd_ = lds + ATT_V0 + (bf) * VBUF + krow * VPITCH + kch * 16; \
        *(LAS u32x4*)(kd_ + krow * KPITCH + kch * 16) = gk0; *(LAS u32x4*)(kd_ + (krow + 64) * KPITCH + kch * 16) = gk1; *(LAS u32x4*)(kd_ + rrow * KPITCH + 128 + rch * 16) = gr; \
        *(LAS u32x2*)(vd_) = (u32x2){gv0.x, gv0.y}; *(LAS u32x2*)(vd_ + 8) = (u32x2){gv0.z, gv0.w}; *(LAS u32x2*)(vd_ + 128) = (u32x2){gv1.x, gv1.y}; *(LAS u32x2*)(vd_ + 136) = (u32x2){gv1.z, gv1.w}; } while (0)
    float mref = -INFINITY, lsum = 0.f; f32x16 o0, o1;
#pragma unroll
    for (int r = 0; r < 16; ++r) { o0[r] = 0.f; o1[r] = 0.f; }
    const int NT2 = 2 * qb + 2;
    ATT_LOAD(0); ATT_STORE(0); __syncthreads();
    for (int T = 0; T < NT2; ++T) {
        const int buf = T & 1;
        if (T + 1 < NT2) ATT_LOAD(T + 1);
        const int tA = 2 * T, tB = 2 * T + 1;
        const LAS unsigned char* kbA = lds + buf * KBUF + r32 * KPITCH + hi * 16; const LAS unsigned char* kbB = kbA + 64 * KPITCH;
        const LAS unsigned char* vbA = lds + ATT_V0 + buf * VBUF + r32 * VPITCH + hi * 8; const LAS unsigned char* vbB = vbA + 128;
        if (64 * tB <= qw0 + 31) {
            f32x16 pA0, pA1, pB0, pB1; bf16x8 pa[4];
            ATT_QK(pA0, pA1, kbA);
            ATT_MAX(pA0, pA1, tA);
            ATT_QK(pB0, pB1, kbB);
            ATT_EXP(pA0, pA1, pa);
            ATT_MAX(pB0, pB1, tB);
            ATT_PV(pa, vbA);
            ATT_EXP(pB0, pB1, pa);
            ATT_PV(pa, vbB);
        } else if (64 * tA <= qw0 + 31) {
            f32x16 pA0, pA1; bf16x8 pa[4];
            ATT_QK(pA0, pA1, kbA);
            ATT_MAX(pA0, pA1, tA);
            ATT_EXP(pA0, pA1, pa);
            ATT_PV(pa, vbA);
        }
        if (T + 1 < NT2) ATT_STORE((T + 1) & 1);
        __syncthreads();
    }
#undef ATT_LOAD
#undef ATT_STORE
    lsum += __shfl_xor(lsum, 32);
    if (hi == 0) wsf[32 + r32] = 1.0f / lsum;
    asm volatile("s_waitcnt lgkmcnt(0)" ::: "memory");
    { bf16_t* ou = O + (rowbase + qw0) * DM + h * 64;
#pragma unroll
      for (int r = 0; r < 16; ++r) { const int qr = crow(r, hi); const float inv = wsf[32 + qr]; const unsigned ov = (unsigned)(qr * DM + r32);
          ou[ov] = (bf16_t)f2bf(o0[r] * inv); ou[ov + 32] = (bf16_t)f2bf(o1[r] * inv); } }
}
__device__ __forceinline__ void phase_attn(const Args& a, LAS unsigned char* lds, int tid) {
    const int G = gridDim.x, bx = blockIdx.x; const int v0 = (G % 8 == 0) ? (bx % 8) * (G / 8) + bx / 8 : bx;
    for (int v = v0; v < 256; v += G) { const int bh = v >> 4, s = v & 15;
        attn_unit(a, bh >> 2, bh & 3, 31 - s, lds, tid);
        attn_unit(a, bh >> 2, bh & 3, s, lds, tid); }
}

#define XB_TMO      128
#define XB_XCNT(j)  (256  + 64 * (j))
#define XB_XSUB(j)  (1280 + 64 * (j))
#define XB_XGEN(j)  (2304 + 64 * (j))
#define XB_TOP      3328
#define XB_TOPGEN   3392
#define XCD_BAR_WORDS 3456
#define XB_SPIN_CAP (1u << 18)

__device__ __forceinline__ unsigned xb_ld(unsigned* p)              { return __hip_atomic_load(p, __ATOMIC_RELAXED, __HIP_MEMORY_SCOPE_AGENT); }
__device__ __forceinline__ unsigned xb_add(unsigned* p, unsigned v) { return __hip_atomic_fetch_add(p, v, __ATOMIC_RELAXED, __HIP_MEMORY_SCOPE_AGENT); }
__device__ __forceinline__ unsigned xb_xcc_id() { return (unsigned)__builtin_amdgcn_s_getreg((3 << 11) | 20) & 0xFu; }
#define XB_SPIN(cond, bar) do { unsigned _sp = 0; while (cond) { __builtin_amdgcn_s_sleep(1); \
    if ((++_sp & 255u) == 0u) { if (xb_ld(&(bar)[XB_TMO])) break; if (_sp > XB_SPIN_CAP) { atomicAdd(&(bar)[XB_TMO], 1u); break; } } } } while (0)

struct XcdBarrier {
    unsigned* bar; unsigned x;
    volatile LAS unsigned* st;
};

__device__ __forceinline__ XcdBarrier xcd_barrier_post(unsigned* bar, volatile LAS unsigned* st) {
    XcdBarrier b; b.bar = bar; b.x = xb_xcc_id(); b.st = st;
    if (threadIdx.x == 0) (void)xb_add(&bar[XB_XCNT(b.x)], 1u);
    return b;
}
__device__ __forceinline__ void xcd_barrier_complete(unsigned* bar, unsigned x, unsigned& nloc, unsigned& nx) {
    const unsigned G = gridDim.x * gridDim.y * gridDim.z;
    unsigned sum, cnt, mine, sp = 0u;
    for (;;) {
        sum = 0u; cnt = 0u; mine = 0u;
#pragma unroll
        for (unsigned j = 0; j < 16; ++j) { const unsigned c = xb_ld(&bar[XB_XCNT(j)]); sum += c; cnt += (c > 0u) ? 1u : 0u; mine = (j == x) ? c : mine; }
        if (sum == G) break;
        __builtin_amdgcn_s_sleep(1);
        if ((++sp & 255u) == 0u) { if (xb_ld(&bar[XB_TMO])) break; if (sp > XB_SPIN_CAP) { atomicAdd(&bar[XB_TMO], 1u); break; } }
    }
    nloc = mine > 0u ? mine : 1u; nx = cnt > 0u ? cnt : 1u;
}

__device__ __forceinline__ void xcd_barrier(const XcdBarrier& b) {
    asm volatile("s_waitcnt vmcnt(0)" ::: "memory");
    __syncthreads();
    if (threadIdx.x == 0) {
        unsigned* bar = b.bar;
        __builtin_amdgcn_s_waitcnt(0);
        unsigned nloc = b.st[0], nx = b.st[1];
        if (nloc == 0u) { xcd_barrier_complete(bar, b.x, nloc, nx); b.st[0] = nloc; b.st[1] = nx; }
        const unsigned old = xb_add(&bar[XB_XSUB(b.x)], 1u);
        const unsigned gen = old / nloc;
        if (old + 1u == (gen + 1u) * nloc) {
            __builtin_amdgcn_fence(__ATOMIC_RELEASE, "agent");
            asm volatile("s_waitcnt vmcnt(0)" ::: "memory");
            const unsigned og = xb_add(&bar[XB_TOP], 1u);
            const unsigned tg = og / nx;
            if (og + 1u == (tg + 1u) * nx) xb_add(&bar[XB_TOPGEN], 1u);
            else XB_SPIN(xb_ld(&bar[XB_TOPGEN]) == tg, bar);
            __builtin_amdgcn_fence(__ATOMIC_ACQUIRE, "agent");
            xb_add(&bar[XB_XGEN(b.x)], 1u);
            asm volatile("s_waitcnt vmcnt(0)" ::: "memory");
        } else {
            XB_SPIN(xb_ld(&bar[XB_XGEN(b.x)]) == gen, bar);
            __builtin_amdgcn_fence(__ATOMIC_ACQUIRE, "agent");
            asm volatile("s_waitcnt vmcnt(0)" ::: "memory");
        }
    }
    __syncthreads();
}

__global__ void __launch_bounds__(512, 2) mk_fwd(Args a) {
    extern __shared__ __attribute__((aligned(16))) unsigned char lds_raw[];
    LAS unsigned char* lds = (LAS unsigned char*)lds_raw;
    cg::grid_group grid = cg::this_grid();
    const int tid0 = threadIdx.x, G = gridDim.x, bx = blockIdx.x;
    { volatile LAS unsigned* st0 = (volatile LAS unsigned*)(lds + 131072 + 64); if (tid0 == 0) { st0[0] = 0u; st0[1] = 0u; } }
    __syncthreads();
    XcdBarrier xbar = xcd_barrier_post((unsigned*)a.ws, (volatile LAS unsigned*)(lds + 131072 + 64));
    for (int ph = a.lo; ph < a.hi; ++ph) {
        unsigned char* ws = a.ws; int tid = tid0;
        asm volatile("" : "+s"(ws), "+v"(tid));
        int l = 0, k = -1; if (ph > 0) { l = (ph - 1) / 11; k = (ph - 1) % 11; }
        const int ng = (k == 0 || k == 4 || k == 5 || k == 6 || k == 8 || k == 9) ? 1 : (k == 2 ? 3 : 0);
#ifndef PM
#define PM 0xFF
#endif
        if (PM & 1) for (int j = 0; j < ng; ++j) {
            size_t oA, oB, oO; int M_ = MTOK, N_ = DM, K_ = DM, lda = DM, ldb = DM, ldc = DM, mode = 0, nbr = 1, coff = 0, use_rs = 0, zs = 0, bmode = 0;
            if (k == 0) {
                oA = WS_XBF; oB = WS_WIN; oO = WS_BIG; N_ = 2048; ldc = 2048; use_rs = 1; mode = 1;
            } else if (k == 2) {
                if (j == 0) { oA = WS_CQN; oB = WS_WUQ; oO = WS_Q; N_ = 512; K_ = 256; lda = 256; ldb = 256; ldc = 512; }
                else if (j == 1) { oA = WS_CKVN; oB = WS_WK; oO = WS_KN; N_ = 256; K_ = 128; lda = 128; ldb = 128; ldc = 256; }
                else { oA = WS_WV; oB = WS_CKVN; oO = WS_VT; M_ = 256; N_ = MTOK; K_ = 128; lda = 128; ldb = 128; ldc = MTOK; coff = G / 2; }
            } else if (k == 4) {
                oA = WS_BR; oB = WS_WBR; oO = WS_BIG; K_ = 256; ldb = 256; ldc = 4096; nbr = 4; zs = 1024;
            } else if (k == 5) {
                oA = WS_XBF; oB = WS_WIN + (size_t)2048 * DM * 2; oO = WS_BR; N_ = 4096; use_rs = 1; mode = 5; bmode = 1;
            } else if (k == 6) {
                oA = WS_BR; oB = WS_WOUT; oO = WS_BIG;
            } else if (k == 8) {
                oA = WS_XBF; oB = WS_W1; oO = WS_BIG; N_ = DFF; ldc = DFF; use_rs = 1; mode = 3;
            } else {
                oA = WS_BIG; oB = WS_W2; oO = WS_BR; K_ = DFF; lda = DFF; ldb = DFF;
            }
            pg8::Gemm g{(const bf16_t*)(ws + oA), (const bf16_t*)(ws + oB), M_, N_, K_, lda, ldb, bmode};
            pg8::EpiRT E{(bf16_t*)(ws + oO), ldc, use_rs ? (const float*)(ws + WS_RS) : nullptr, a.in[I_GATEB] + l * 4096, (const bf16_t*)(ws + WS_BIG), mode, zs};
            pg8::MergeOrder S; S.init(M_, N_, G, (bx + coff) % G, nbr);
            pg8::gemm_phase<pg8::EpiRT, pg8::MergeOrder, true, true>(lds, g, S, E, tid);
        }
        if ((PM & 2) && k == 1) phase_e1(a, l, lds, tid);
        if ((PM & 4) && k == 3) phase_attn(a, lds, tid);
        if ((PM & 8) && (k == 7 || k == 10)) phase_nr(a, (k == 7 ? a.in[I_NPOST] : a.in[I_NFPOST]) + l * DM, k == 7 ? WS_BIG : WS_BR, (k == 10 && l == NLAYER - 1), tid);
        if ((PM & 16) && ph == 0) phase_s0(a, lds, tid);
        if ((PM & 32) && (ph == 0 || (k == 10 && l + 1 < NLAYER))) prep_weights(a, ph == 0 ? 0 : l + 1, lds, tid);
        if (ph + 1 < a.hi) { if (ph == a.lo) grid.sync(); else xcd_barrier(xbar); }
    }
}

constexpr int NPHASE = 1 + 11 * NLAYER;
#ifndef MK_ONE_LAUNCH
#define MK_ONE_LAUNCH 1
#endif
extern "C" void kernel_launch(void* const* d_in, const int* in_sizes, int n_in, void* d_out, int out_size, void* d_ws, size_t ws_size, hipStream_t stream) {
    static int grid = 0;
    if (grid == 0) {
        if (n_in != 26 || out_size != MTOK * DM || ws_size < WS_END) { fprintf(stderr, "kernel_launch: unexpected shapes (n_in %d out %d ws %zu)\n", n_in, out_size, ws_size); grid = -1; return; }
        int dev = 0, cus = 0, per_cu = 0;
        hipGetDevice(&dev); hipDeviceGetAttribute(&cus, hipDeviceAttributeMultiprocessorCount, dev);
        hipFuncSetAttribute((const void*)mk_fwd, hipFuncAttributeMaxDynamicSharedMemorySize, LDS_BYTES);
        hipOccupancyMaxActiveBlocksPerMultiprocessor(&per_cu, (const void*)mk_fwd, 512, LDS_BYTES);
        if (per_cu < 1) { fprintf(stderr, "kernel_launch: occupancy query says %d blocks per CU\n", per_cu); per_cu = 1; }
        (void)hipGetLastError();
        grid = cus;
    }
    if (grid < 0) return;
    Args a{};
    for (int i = 0; i < 26; ++i) a.in[i] = (const float*)d_in[i];
    a.out = (float*)d_out; a.ws = (unsigned char*)d_ws;
    if (hipMemsetAsync(d_ws, 0, 16384, stream) != hipSuccess) { fprintf(stderr, "memset failed\n"); return; }
#if MK_ONE_LAUNCH
    a.lo = 0; a.hi = NPHASE;
    { void* args[] = {&a}; hipError_t e = hipLaunchCooperativeKernel((const void*)mk_fwd, dim3(grid), dim3(512), args, LDS_BYTES, stream);
      if (e != hipSuccess) fprintf(stderr, "cooperative launch failed: %s (grid %d)\n", hipGetErrorString(e), grid); }
#else
    for (int ph = 0; ph < NPHASE; ++ph) { a.lo = ph; a.hi = ph + 1;
        void* args[] = {&a}; hipError_t e = hipLaunchCooperativeKernel((const void*)mk_fwd, dim3(grid), dim3(512), args, LDS_BYTES, stream);
        if (e != hipSuccess) { fprintf(stderr, "launch %d failed: %s (grid %d)\n", ph, hipGetErrorString(e), grid); break; } }
#endif
}
```

```cpp
#include <hip/hip_runtime.h>
#include <hip/hip_cooperative_groups.h>
#include <cstdio>
#include <cstdint>
namespace cg = cooperative_groups;

#define LAS __attribute__((address_space(3)))
typedef unsigned short bf16_t;
typedef short bf16x8 __attribute__((ext_vector_type(8)));
typedef short s16x4 __attribute__((ext_vector_type(4)));
typedef float f32x4 __attribute__((ext_vector_type(4)));
typedef float f32x2 __attribute__((ext_vector_type(2)));
typedef float f32x16 __attribute__((ext_vector_type(16)));
typedef unsigned u32x4 __attribute__((ext_vector_type(4)));
typedef unsigned u32x2 __attribute__((ext_vector_type(2)));

__device__ __forceinline__ unsigned f2bf(float f) { unsigned u = __builtin_bit_cast(unsigned, f); return (u + 0x7fffu + ((u >> 16) & 1u)) >> 16; }
__device__ __forceinline__ unsigned pk2(float lo, float hi) { return f2bf(lo) | (f2bf(hi) << 16); }
__device__ __forceinline__ float bflo(unsigned w) { return __builtin_bit_cast(float, w << 16); }
__device__ __forceinline__ float bfhi(unsigned w) { return __builtin_bit_cast(float, w & 0xffff0000u); }
__device__ __forceinline__ float bf2f(bf16_t h) { return __builtin_bit_cast(float, ((unsigned)h) << 16); }
__device__ __forceinline__ float wave_sum(float v) {
#pragma unroll
    for (int o = 1; o < 64; o <<= 1) v += __shfl_xor(v, o);
    return v;
}
__device__ __forceinline__ float fast_sigmoid(float v) { return __builtin_amdgcn_rcpf(1.0f + __builtin_amdgcn_exp2f(-1.4426950408889634f * v)); }
__device__ __forceinline__ float gelu_tanh(float x) { const float u = 0.7978845608028654f * (x + 0.044715f * x * x * x); return x * fast_sigmoid(2.0f * u); }

namespace pg8 {
#define PG8_LAS __attribute__((address_space(3)))
constexpr int BM = 256, BK = 64, HALF = 128, HTB = HALF * BK * 2  , STAGE_BYTES = 8 * HTB, NXCD = 8, WGM = 8;

__host__ __device__ __forceinline__ int lds_byte(int r, int c) { const int st = (r >> 4) * 2 + (c >> 5), rr = r & 15, cc = c & 31, ob = rr * 64 + cc * 2; return st * 1024 + (ob ^ (((ob >> 9) & 1) << 5)); }
__host__ __device__ __forceinline__ void stage_rc(int b, int& R, int& C) { const int st = b / 1024, sb = b % 1024, swz = sb ^ (((sb >> 9) & 1) << 5); R = (st >> 1) * 16 + swz / 64; C = (st & 1) * 32 + (swz % 64) / 2; }
__host__ __device__ __forceinline__ int perm32(int rho) { const int n = rho >> 4, i = rho & 15; return 8 * (i >> 2) + 4 * n + (i & 3); }

struct Unit { int pm, pn, bn, ak, z; };
struct Gemm { const bf16_t* A; const bf16_t* Bt; int M, N, K, lda, ldb, bmode; };

struct StaticOrder {
    int nM, nN, nwg, G, c;
    __host__ __device__ void init(int M, int N, int G_, int c_) { nM = M / BM; nN = N / BM; nwg = nM * nN; G = G_; c = c_; }
    __host__ __device__ bool map(long L, Unit& u) const {
        if (L >= nwg) return false;
        int wgid = (int)L; { const int q = nwg / NXCD, r = nwg % NXCD, xcd = wgid % NXCD, off = wgid / NXCD; wgid = (xcd < r ? xcd * (q + 1) : r * (q + 1) + (xcd - r) * q) + off; }
        const int nig = WGM * nN, gid = wgid / nig, fm = gid * WGM, gsz = (nM - fm) < WGM ? (nM - fm) : WGM;
        u.pm = fm + ((wgid % nig) % gsz); u.pn = (wgid % nig) / gsz; return true;
    }
    __host__ __device__ bool next(int i, Unit& u) const { u.ak = 0; u.z = 0; const bool ok = map((long)i * G + c, u); u.bn = u.pn; return ok; }
    __device__ __forceinline__ void a_ready(const Unit&) const {}
    __device__ __forceinline__ void done(const Unit&) const {}
};
struct MergeOrder {
    StaticOrder S; int nbr;
    __host__ __device__ void init(int M, int N, int G_, int c_, int nbr_) { S.init(M, N, G_, c_); nbr = nbr_; }
    __host__ __device__ bool next(int i, Unit& u) const { const int z = i % nbr; const bool ok = S.map((long)(i / nbr) * S.G + S.c, u); u.z = z; u.ak = z * 256; u.bn = z * S.nN + u.pn; return ok; }
    __device__ __forceinline__ void a_ready(const Unit&) const {}
    __device__ __forceinline__ void done(const Unit&) const {}
};

__device__ __forceinline__ unsigned cvt_pk_bf16(float lo, float hi) { unsigned r; asm volatile("v_cvt_pk_bf16_f32 %0, %1, %2" : "=v"(r) : "v"(lo), "v"(hi)); return r; }

struct EpiRT {
    static constexpr bool PERM = true, AFTER_DRAIN = false;
    bf16_t* O; int ldc; const float* rs; const float* bias; const bf16_t* gates; int mode, zs;
    __device__ __forceinline__ void operator()(const f32x4 (&acc)[2][2][4][2], const Unit& u, int wr, int wc, int fr, int fq) const {
        if (mode == 5) {
            const int row0 = u.pm * BM + wr * 64 + fr; const int col = u.pn * 64 + wc * 16 + 4 * fq;
#pragma unroll
            for (int q = 0; q < 4; ++q) { const int ai = q >> 1, mb = (q & 1) * 2;
                u32x2 yw[2][4]; float sc[2];
#pragma unroll
                for (int mm = 0; mm < 2; ++mm) { const int row = row0 + ai * HALF + (mb + mm) * 16; sc[mm] = rs[row]; const bf16_t* yp = gates + (size_t)row * 4096 + col;
#pragma unroll
                    for (int z = 0; z < 4; ++z) yw[mm][z] = *(const u32x2*)(yp + z * 1024); }
#pragma unroll
                for (int mm = 0; mm < 2; ++mm) { const int m = mb + mm; const int row = row0 + ai * HALF + m * 16;
                    f32x4 tot = (f32x4){0.f, 0.f, 0.f, 0.f};
#pragma unroll
                    for (int bj = 0; bj < 2; ++bj)
#pragma unroll
                        for (int n = 0; n < 2; ++n) { const int z = 2 * bj + n; const f32x4 v = acc[ai][bj][m][n] * sc[mm] + *(const f32x4*)(bias + z * 1024 + col); const u32x2 y2 = yw[mm][z];
                            tot[0] += fast_sigmoid(v[0]) * bflo(y2.x); tot[1] += fast_sigmoid(v[1]) * bfhi(y2.x); tot[2] += fast_sigmoid(v[2]) * bflo(y2.y); tot[3] += fast_sigmoid(v[3]) * bfhi(y2.y); }
                    u32x2 w; w.x = cvt_pk_bf16(tot[0], tot[1]); w.y = cvt_pk_bf16(tot[2], tot[3]);
                    *(u32x2*)(O + (size_t)row * ldc + col) = w; }
            }
            return;
        }
        const int row0 = u.pm * BM + wr * 64 + fr; const int col0 = u.pn * BM + wc * 32 + 8 * fq + u.z * zs;
        const int m_eff = (mode == 1) ? ((u.pn == 2 || u.pn == 3) ? 1 : 0) : mode;
#pragma unroll
        for (int ai = 0; ai < 2; ++ai)
#pragma unroll
            for (int m = 0; m < 4; ++m) { const int row = row0 + ai * HALF + m * 16; bf16_t* rowp = O + (size_t)row * ldc + col0;
                const float sc = rs ? rs[row] : 1.0f;
#pragma unroll
                for (int bj = 0; bj < 2; ++bj) { f32x4 v0 = acc[ai][bj][m][0] * sc, v1 = acc[ai][bj][m][1] * sc;
                    if (m_eff == 1) {
#pragma unroll
                        for (int e = 0; e < 4; ++e) { v0[e] = gelu_tanh(v0[e]); v1[e] = gelu_tanh(v1[e]); }
                    } else if (m_eff == 3) {
#pragma unroll
                        for (int e = 0; e < 4; ++e) { const float a = fmaxf(v0[e], 0.f), b = fmaxf(v1[e], 0.f); v0[e] = a * a; v1[e] = b * b; }
                    }
                    u32x4 w; w.x = cvt_pk_bf16(v0[0], v0[1]); w.y = cvt_pk_bf16(v0[2], v0[3]); w.z = cvt_pk_bf16(v1[0], v1[1]); w.w = cvt_pk_bf16(v1[2], v1[3]);
                    *(u32x4*)(rowp + bj * HALF) = w; } }
    }
};

template <class Epi, class Sched, bool ALIGN_EPI = false, bool SP2 = false>
__device__ __forceinline__ void gemm_phase(PG8_LAS unsigned char* lds, const Gemm g, const Sched& S, const Epi& E, const int tid) {
    const int wid = __builtin_amdgcn_readfirstlane(tid >> 6), lane = tid & 63, wr = wid >> 2, wc = wid & 3, fr = lane & 15, fq = lane >> 4;
    const int K = g.K, nt = K / BK;
    unsigned voffA[2], voffB[2];
#pragma unroll
    for (int i = 0; i < 2; ++i) { int R, C; stage_rc(tid * 16 + i * 8192, R, C); const int Rb = g.bmode ? (((R >> 4) & 1) * 1024 + (R >> 5) * 16 + (R & 15)) : ((R & ~31) + perm32(R & 31));
        voffA[i] = (unsigned)(R * g.lda + C) * 2u; voffB[i] = (unsigned)(Rb * g.ldb + C) * 2u; }
    const size_t kstep = (size_t)(BK * 2);
    const size_t hstepA = (size_t)HALF * g.lda * 2, hstepB = (size_t)(g.bmode ? 2048 : HALF) * g.ldb * 2;
    const size_t tstepA = 2 * hstepA, tstepB = (size_t)(g.bmode ? 64 : 256) * g.ldb * 2;
    const unsigned ldsw = (unsigned)wid * 1024u;
    const int aoff = lds_byte(wr * 64 + fr, fq * 8), boff = lds_byte(wc * 32 + fr, fq * 8);
#define PG8_SA(b, h) (((b) * 2 + (h)) * HTB)
#define PG8_SB(b, h) ((4 + (b) * 2 + (h)) * HTB)
#define PG8_STAGE(bufoff, gbase, voff) do { _Pragma("unroll") for (int _i = 0; _i < 2; ++_i) \
        __builtin_amdgcn_global_load_lds((const unsigned*)((const char*)(gbase) + (voff)[_i]), (PG8_LAS unsigned*)(lds + (bufoff) + ldsw + _i * 8192), 16, 0, 0); } while (0)
#define PG8_LDA(dst, b, h) do { _Pragma("unroll") for (int m = 0; m < 4; ++m) _Pragma("unroll") for (int k = 0; k < 2; ++k) dst[m][k] = *(const PG8_LAS bf16x8*)(lds + PG8_SA(b, h) + aoff + m * 2048 + k * 1024); } while (0)
#define PG8_LDB(dst, b, h) do { _Pragma("unroll") for (int n = 0; n < 2; ++n) _Pragma("unroll") for (int k = 0; k < 2; ++k) dst[n][k] = *(const PG8_LAS bf16x8*)(lds + PG8_SB(b, h) + boff + n * 2048 + k * 1024); } while (0)
#define PG8_MMA(ai, bj, At, Bt) do { __builtin_amdgcn_s_setprio(1); _Pragma("unroll") for (int m = 0; m < 4; ++m) _Pragma("unroll") for (int n = 0; n < 2; ++n) _Pragma("unroll") for (int k = 0; k < 2; ++k) \
        acc[ai][bj][m][n] = __builtin_amdgcn_mfma_f32_16x16x32_bf16(Bt[n][k], At[m][k], acc[ai][bj][m][n], 0, 0, 0); __builtin_amdgcn_s_setprio(0); } while (0)
#define PG8_WAIT_V(n) asm volatile("s_waitcnt vmcnt(" #n ")" ::: "memory")
#define PG8_WAIT_L(n) asm volatile("s_waitcnt lgkmcnt(" #n ")" ::: "memory")
#define PG8_BAR __builtin_amdgcn_s_barrier()
#define PG8_SCHED __builtin_amdgcn_sched_barrier(0)
    Unit cur, nxt; int ui = 0;
    if (!S.next(0, cur)) return;
    f32x4 acc[2][2][4][2];
#pragma unroll
    for (int a = 0; a < 2; ++a)
#pragma unroll
        for (int b = 0; b < 2; ++b)
#pragma unroll
            for (int m = 0; m < 4; ++m)
#pragma unroll
                for (int n = 0; n < 2; ++n) acc[a][b][m][n] = (f32x4){0.f, 0.f, 0.f, 0.f};
    bf16x8 At[4][2], B0[2][2], B1[2][2];
    const char* cA = (const char*)g.A + (size_t)cur.pm * tstepA + (size_t)cur.ak * 2; const char* cB = (const char*)g.Bt + (size_t)cur.bn * tstepB;
    S.a_ready(cur);
    if constexpr (SP2) {
        PG8_STAGE(PG8_SB(0, 0), cB, voffB); PG8_STAGE(PG8_SB(0, 1), cB + hstepB, voffB); PG8_STAGE(PG8_SA(0, 0), cA, voffA); PG8_STAGE(PG8_SA(0, 1), cA + hstepA, voffA);
        if (wr == 1) PG8_BAR;
        PG8_WAIT_V(2); PG8_BAR;
        PG8_STAGE(PG8_SB(1, 0), cB + kstep, voffB); PG8_STAGE(PG8_SA(1, 0), cA + kstep, voffA); PG8_STAGE(PG8_SB(1, 1), cB + hstepB + kstep, voffB);
        PG8_WAIT_V(6); PG8_BAR;
    } else {
        PG8_STAGE(PG8_SB(0, 0), cB, voffB); PG8_STAGE(PG8_SA(0, 0), cA, voffA); PG8_STAGE(PG8_SB(0, 1), cB + hstepB, voffB); PG8_STAGE(PG8_SA(0, 1), cA + hstepA, voffA);
        if (wr == 1) PG8_BAR;
        PG8_WAIT_V(4); PG8_BAR;
        PG8_STAGE(PG8_SB(1, 0), cB + kstep, voffB); PG8_STAGE(PG8_SA(1, 0), cA + kstep, voffA); PG8_STAGE(PG8_SB(1, 1), cB + hstepB + kstep, voffB);
        PG8_WAIT_V(6); PG8_BAR;
    }
    for (;;) {
        const bool has_next = S.next(ui + 1, nxt);
        const char* nA = has_next ? (const char*)g.A + (size_t)nxt.pm * tstepA + (size_t)nxt.ak * 2 : cA; const char* nB = has_next ? (const char*)g.Bt + (size_t)nxt.bn * tstepB : cB;
        for (int t = 0; t < nt; t += 2) {
            const bool last = (t == nt - 2);
            const char* a1 = cA + (size_t)(t + 1) * kstep;
            const char* a2 = last ? nA : cA + (size_t)(t + 2) * kstep; const char* b2 = last ? nB : cB + (size_t)(t + 2) * kstep;
            const char* a3 = a2 + kstep; const char* b3 = b2 + kstep;
            if (last && has_next) S.a_ready(nxt);
            if constexpr (SP2) {
            PG8_LDB(B0, 0, 0); PG8_LDB(B1, 0, 1); PG8_SCHED; PG8_LDA(At, 0, 0); PG8_STAGE(PG8_SA(1, 1), a1 + hstepA, voffA);
            PG8_WAIT_V(8); PG8_WAIT_L(0); PG8_BAR; PG8_MMA(0, 0, At, B0); PG8_MMA(0, 1, At, B1); PG8_BAR; PG8_SCHED;
            PG8_LDA(At, 0, 1); PG8_STAGE(PG8_SB(0, 0), b2, voffB); PG8_STAGE(PG8_SB(0, 1), b2 + hstepB, voffB); PG8_STAGE(PG8_SA(0, 0), a2, voffA);
            PG8_WAIT_V(8); PG8_WAIT_L(0); PG8_BAR; PG8_MMA(1, 0, At, B0); PG8_MMA(1, 1, At, B1); PG8_BAR; PG8_SCHED;
            PG8_LDB(B0, 1, 0); PG8_LDB(B1, 1, 1); PG8_SCHED; PG8_LDA(At, 1, 0); PG8_STAGE(PG8_SA(0, 1), a2 + hstepA, voffA);
            PG8_WAIT_V(8); PG8_WAIT_L(0); PG8_BAR; PG8_MMA(0, 0, At, B0); PG8_MMA(0, 1, At, B1); PG8_BAR; PG8_SCHED;
            PG8_LDA(At, 1, 1); PG8_STAGE(PG8_SB(1, 0), b3, voffB); PG8_STAGE(PG8_SB(1, 1), b3 + hstepB, voffB); PG8_STAGE(PG8_SA(1, 0), a3, voffA);
            PG8_WAIT_V(8); PG8_WAIT_L(0); PG8_BAR; PG8_MMA(1, 0, At, B0); PG8_MMA(1, 1, At, B1); PG8_BAR; PG8_SCHED;
            } else {
            PG8_LDB(B0, 0, 0); PG8_SCHED; PG8_LDA(At, 0, 0); PG8_STAGE(PG8_SA(1, 1), a1 + hstepA, voffA);
            PG8_WAIT_L(8); PG8_BAR; PG8_WAIT_L(0); PG8_MMA(0, 0, At, B0); PG8_BAR; PG8_SCHED;
            PG8_LDB(B1, 0, 1); PG8_STAGE(PG8_SB(0, 0), b2, voffB);
            PG8_BAR; PG8_WAIT_L(0); PG8_MMA(0, 1, At, B1); PG8_BAR;
            PG8_LDA(At, 0, 1); PG8_STAGE(PG8_SA(0, 0), a2, voffA);
            PG8_BAR; PG8_WAIT_L(0); PG8_MMA(1, 0, At, B0); PG8_BAR; PG8_SCHED;
            PG8_STAGE(PG8_SB(0, 1), b2 + hstepB, voffB);
            PG8_WAIT_V(6); PG8_BAR; PG8_MMA(1, 1, At, B1); PG8_BAR;
            PG8_LDB(B0, 1, 0); PG8_SCHED; PG8_LDA(At, 1, 0); PG8_STAGE(PG8_SA(0, 1), a2 + hstepA, voffA);
            PG8_WAIT_L(8); PG8_BAR; PG8_WAIT_L(0); PG8_MMA(0, 0, At, B0); PG8_BAR; PG8_SCHED;
            PG8_LDB(B1, 1, 1); PG8_STAGE(PG8_SB(1, 0), b3, voffB);
            PG8_BAR; PG8_WAIT_L(0); PG8_MMA(0, 1, At, B1); PG8_BAR;
            PG8_LDA(At, 1, 1); PG8_STAGE(PG8_SA(1, 0), a3, voffA);
            PG8_BAR; PG8_WAIT_L(0); PG8_MMA(1, 0, At, B0); PG8_BAR; PG8_SCHED;
            PG8_STAGE(PG8_SB(1, 1), b3 + hstepB, voffB);
            PG8_WAIT_V(6); PG8_BAR; PG8_MMA(1, 1, At, B1); PG8_BAR;
            }
        }
        if constexpr (ALIGN_EPI) { if (wr == 0) PG8_BAR; }
        if constexpr (!Epi::AFTER_DRAIN) { E(acc, cur, wr, wc, fr, fq); S.done(cur); }
        if (!has_next) break;
#pragma unroll
        for (int a = 0; a < 2; ++a)
#pragma unroll
            for (int b = 0; b < 2; ++b)
#pragma unroll
                for (int m = 0; m < 4; ++m)
#pragma unroll
                    for (int n = 0; n < 2; ++n) acc[a][b][m][n] = (f32x4){0.f, 0.f, 0.f, 0.f};
        cur = nxt; cA = nA; cB = nB; ++ui;
        if constexpr (ALIGN_EPI) { if (wr == 1) PG8_BAR; }
    }
    PG8_WAIT_V(0);
    if constexpr (!ALIGN_EPI) { if (wr == 0) PG8_BAR; }
    PG8_BAR;
    if constexpr (Epi::AFTER_DRAIN) { E.fused(acc, cur, wr, wc, fr, fq, lds, wid, lane); S.done(cur); }
#undef PG8_SA
#undef PG8_SB
#undef PG8_STAGE
#undef PG8_LDA
#undef PG8_LDB
#undef PG8_MMA
#undef PG8_WAIT_V
#undef PG8_WAIT_L
#undef PG8_BAR
#undef PG8_SCHED
}
}

constexpr int MTOK = 32768, DM = 1024, SEQ = 8192, NLAYER = 4, NIN = 6048, DFF = 4096;
constexpr float EPS = 1e-6f;
constexpr float QSCALE = 0.10206207261596575f * 1.4426950408889634f;
constexpr size_t MiB = 1u << 20;
constexpr size_t WS_RS = 1 * MiB, WS_ROPEC = 2 * MiB, WS_ROPES = 4 * MiB;
constexpr size_t WS_WIN = 6 * MiB, WS_WUQ = 18 * MiB, WS_WK = WS_WUQ + 256 * 1024, WS_WV = WS_WK + 64 * 1024, WS_SGW = WS_WUQ + 512 * 1024;
constexpr size_t WS_WBR = 19 * MiB, WS_WOUT = 21 * MiB, WS_W1 = 23 * MiB, WS_W2 = 31 * MiB;
constexpr size_t WS_XBF = 40 * MiB;
constexpr size_t WS_BR = 104 * MiB;
constexpr size_t WS_BIG = 168 * MiB;
constexpr size_t WS_PROJ = WS_BIG, WS_CQN = WS_BIG + 128 * MiB, WS_CKVN = WS_BIG + 144 * MiB, WS_KR = WS_BIG + 152 * MiB, WS_Q = WS_BIG + 154 * MiB, WS_KN = WS_BIG + 186 * MiB, WS_VT = WS_BIG + 202 * MiB;
constexpr size_t WS_END = 424 * MiB;
constexpr int LDS_BYTES = 147456;

struct Args { const float* in[26]; float* out; unsigned char* ws; int lo, hi; };
enum { I_X = 0, I_POS, I_NPRE, I_WIN, I_GATEB, I_QN, I_WUQ, I_KVN, I_WUKV, I_WBRMLA, I_LNG, I_LNB, I_SGW, I_SGB, I_WBRSG, I_CONVW, I_WBRCONV, I_POOLW, I_POOLS, I_WBRPOOL, I_WOUT, I_NPOST, I_NFPRE, I_WFF1, I_WFF2, I_NFPOST };

typedef __bf16 bf16x2_t __attribute__((ext_vector_type(2)));
__device__ __forceinline__ unsigned cvtpk_v(float lo, float hi) { f32x2 v = {lo, hi}; bf16x2_t b = __builtin_convertvector(v, bf16x2_t); return __builtin_bit_cast(unsigned, b); }
__device__ __forceinline__ int crow(int r, int hi) { return (r & 3) + 8 * (r >> 2) + 4 * hi; }
#define MFMA32(a, b, c) __builtin_amdgcn_mfma_f32_32x32x16_bf16((a), (b), (c), 0, 0, 0)

__device__ __forceinline__ void tr_item(const float* __restrict__ W, int ldw, int k0, int srcn0, const float* __restrict__ gk, float mul, bf16_t* WT, int ldt, int dstn0, LAS float* scr, int lane) {
    float tv[32];
#pragma unroll
    for (int i = 0; i < 32; ++i) { const int kk = 2 * i + (lane >> 5); tv[i] = (srcn0 >= 0) ? W[(size_t)(k0 + kk) * ldw + srcn0 + (lane & 31)] : 0.f; }
    float gkv = mul; (void)gkv;
#pragma unroll
    for (int i = 0; i < 32; ++i) { const int kk = 2 * i + (lane >> 5); float v = tv[i] * mul; if (gk) v *= gk[k0 + kk]; scr[kk * 33 + (lane & 31)] = v; }
    asm volatile("s_waitcnt lgkmcnt(0)" ::: "memory");
    const int c = lane & 7;
#pragma unroll
    for (int j = 0; j < 4; ++j) { const int n = (lane >> 3) + 8 * j; const LAS float* s = scr + (8 * c) * 33 + n;
        u32x4 o; o.x = pk2(s[0 * 33], s[1 * 33]); o.y = pk2(s[2 * 33], s[3 * 33]); o.z = pk2(s[4 * 33], s[5 * 33]); o.w = pk2(s[6 * 33], s[7 * 33]);
        *(u32x4*)(WT + (size_t)(dstn0 + n) * ldt + k0 + 8 * c) = o; }
    asm volatile("s_waitcnt lgkmcnt(0)" ::: "memory");
}

__device__ __forceinline__ void prep_weights(const Args& a, int l, LAS unsigned char* lds, int tid) {
    const int lane = tid & 63, wave = tid >> 6, G = gridDim.x;
    LAS float* scr = (LAS float*)(lds + wave * 8448);
    const int gw = blockIdx.x * 8 + wave, NGW = G * 8;
    unsigned char* ws = a.ws;
    constexpr int N0 = 16 * 192, N1 = 4 * 16, N2 = 2 * 8, N3 = 2 * 8, N4 = 3 * 4 * 32, N5 = 16 * 32, N6 = 16 * 128, N7 = 64 * 32;
    constexpr int NITEMS = N0 + N1 + N2 + N3 + N4 + N5 + N6 + N7;
    for (int it = gw; it < NITEMS; it += NGW) {
        int r = it;
        if (r < N0) { const int kb = r / 192, nb = r % 192, d0 = nb * 32; const int src = d0 < 416 ? d0 : (d0 < 512 ? -1 : d0 - 96);
            tr_item(a.in[I_WIN] + (size_t)l * DM * NIN, NIN, kb * 64, src, a.in[I_NPRE] + l * DM, 1.f, (bf16_t*)(ws + WS_WIN), DM, d0, scr, lane); continue; } r -= N0;
        if (r < N1) { const int kb = r / 16, nb = r % 16;
            tr_item(a.in[I_WUQ] + (size_t)l * 256 * 384, 384, kb * 64, nb < 12 ? nb * 32 : -1, a.in[I_QN] + l * 256, QSCALE, (bf16_t*)(ws + WS_WUQ), 256, nb * 32, scr, lane); continue; } r -= N1;
        if (r < N2) { const int kb = r / 8, nb = r % 8;
            tr_item(a.in[I_WUKV] + (size_t)l * 128 * 512, 512, kb * 64, (nb >> 1) * 128 + (nb & 1) * 32, a.in[I_KVN] + l * 128, 1.f, (bf16_t*)(ws + WS_WK), 128, nb * 32, scr, lane); continue; } r -= N2;
        if (r < N3) { const int kb = r / 8, nb = r % 8;
            tr_item(a.in[I_WUKV] + (size_t)l * 128 * 512, 512, kb * 64, (nb >> 1) * 128 + 64 + (nb & 1) * 32, a.in[I_KVN] + l * 128, 1.f, (bf16_t*)(ws + WS_WV), 128, nb * 32, scr, lane); continue; } r -= N3;
        if (r < N4) { const int z = r / 128, rr = r % 128, kb = rr / 32, nb = rr % 32; const float* W = (z == 0 ? a.in[I_WBRMLA] : z == 1 ? a.in[I_WBRSG] : a.in[I_WBRCONV]) + (size_t)l * 256 * DM;
            tr_item(W, DM, kb * 64, nb * 32, nullptr, 1.f, (bf16_t*)(ws + WS_WBR) + (size_t)z * DM * 256, 256, nb * 32, scr, lane); continue; } r -= N4;
        if (r < N5) { const int kb = r / 32, nb = r % 32;
            tr_item(a.in[I_WOUT] + (size_t)l * DM * DM, DM, kb * 64, nb * 32, nullptr, 1.f, (bf16_t*)(ws + WS_WOUT), DM, nb * 32, scr, lane); continue; } r -= N5;
        if (r < N6) { const int kb = r / 128, nb = r % 128;
            tr_item(a.in[I_WFF1] + (size_t)l * DM * DFF, DFF, kb * 64, nb * 32, a.in[I_NFPRE] + l * DM, 1.f, (bf16_t*)(ws + WS_W1), DM, nb * 32, scr, lane); continue; } r -= N6;
        { const int kb = r / 32, nb = r % 32;
            tr_item(a.in[I_WFF2] + (size_t)l * DFF * DM, DM, kb * 64, nb * 32, nullptr, 1.f, (bf16_t*)(ws + WS_W2), DFF, nb * 32, scr, lane); }
    }
    const int gt = blockIdx.x * 512 + tid, NGT = G * 512;
    { const float* sw = a.in[I_SGW] + (size_t)l * 65536; bf16_t* o = (bf16_t*)(ws + WS_SGW);
      for (int i = gt; i < 65536; i += NGT) { const int t = (i >> 7) & 127, s = i & 127; o[i] = (bf16_t)f2bf(s <= t ? sw[i] : 0.f); } }
    { const float* wp = a.in[I_POOLW] + (size_t)l * 4 * 64 * 64; const float* sc = a.in[I_POOLS] + l * 256; const float* wb = a.in[I_WBRPOOL] + (size_t)l * 256 * DM;
      bf16_t* o = (bf16_t*)(ws + WS_WBR) + (size_t)3 * DM * 256;
      for (int i = gt; i < 256 * DM; i += NGT) { const int n = i & 1023, cp = i >> 10, g = cp >> 6, c = cp & 63; float acc = 0.f;
          for (int d = 0; d < 64; ++d) acc += wp[(g * 64 + c) * 64 + d] * sc[g * 64 + d] * wb[(size_t)(g * 64 + d) * DM + n];
          o[(size_t)n * 256 + cp] = (bf16_t)f2bf(acc); } }
}

__device__ __forceinline__ void phase_s0(const Args& a, LAS unsigned char* lds, int tid) {
    const int G = gridDim.x, gt = blockIdx.x * 512 + tid, NGT = G * 512;
    const int* pos = (const int*)a.in[I_POS];
    float* rc = (float*)(a.ws + WS_ROPEC); float* rsn = (float*)(a.ws + WS_ROPES);
    for (int i = gt; i < MTOK * 16; i += NGT) { const int tok = i & (MTOK - 1); const int k = __builtin_amdgcn_readfirstlane(i >> 15);
        const unsigned chi = (k == 0 ? 0x3fc45f30u : (k == 1 ? 0x3fb6e96eu : (k == 2 ? 0x3fa9c4c0u : (k == 3 ? 0x3f9cfb40u : (k == 4 ? 0x3f904c26u : (k == 5 ? 0x3f825458u : (k == 6 ? 0x3f749d66u : (k == 7 ? 0x3f672f66u : (k == 8 ? 0x3f5a1371u : (k == 9 ? 0x3f4d53c1u : (k == 10 ? 0x3f407debu : (k == 11 ? 0x3f328c52u : (k == 12 ? 0x3f24dc5au : (k == 13 ? 0x3f177634u : (k == 14 ? 0x3f0a6312u : (k == 15 ? 0x3efdad50u : 0u))))))))))))))));
        const unsigned clo = (k == 0 ? 0x6dc9c883u : (k == 1 ? 0xcaebf83fu : (k == 2 ? 0x200b604fu : (k == 3 ? 0x35fd7496u : (k == 4 ? 0xbe3b06cfu : (k == 5 ? 0xa2566033u : (k == 6 ? 0x800919d9u : (k == 7 ? 0x91979078u : (k == 8 ? 0x305e714cu : (k == 9 ? 0x03bd66b8u : (k == 10 ? 0x99a0e17au : (k == 11 ? 0x0e12d9f9u : (k == 12 ? 0x8d185aa3u : (k == 13 ? 0x02fdebc6u : (k == 14 ? 0x8f67cf2au : (k == 15 ? 0x16848ff5u : 0u))))))))))))))));
        const double cf = __hiloint2double((int)chi, (int)clo);
        const double rev = (double)pos[tok] * cf;
        const float fr = (float)(rev - __builtin_rint(rev));
        rc[tok * 16 + k] = __builtin_amdgcn_cosf(fr); rsn[tok * 16 + k] = __builtin_amdgcn_sinf(fr); }
    const int lane = tid & 63, wave = tid >> 6, gw = blockIdx.x * 8 + wave, NGW = G * 8;
    const float* x = a.in[I_X]; float* xo = a.out; bf16_t* xb = (bf16_t*)(a.ws + WS_XBF); float* rs = (float*)(a.ws + WS_RS);
    for (int row = gw; row < MTOK; row += NGW) {
        const float* xr = x + (size_t)row * DM + 8 * lane; bf16_t* bw = xb + (size_t)row * DM + 8 * lane;
        float ss = 0.f;
#pragma unroll
        for (int j = 0; j < 2; ++j) { const f32x4 v0 = *(const f32x4*)(xr + 512 * j), v1 = *(const f32x4*)(xr + 512 * j + 4);
            ss += v0.x * v0.x + v0.y * v0.y + v0.z * v0.z + v0.w * v0.w + v1.x * v1.x + v1.y * v1.y + v1.z * v1.z + v1.w * v1.w;
            u32x4 o; o.x = pk2(v0.x, v0.y); o.y = pk2(v0.z, v0.w); o.z = pk2(v1.x, v1.y); o.w = pk2(v1.z, v1.w); *(u32x4*)(bw + 512 * j) = o; }
        ss = wave_sum(ss);
        if (lane == 0) rs[row] = 1.0f / sqrtf(ss * (1.0f / DM) + EPS);
    }
}

__device__ __forceinline__ void phase_nr(const Args& a, const float* gpost, size_t ysrc, bool final_out, int tid) {
    const int G = gridDim.x, lane = tid & 63, wave = tid >> 6, gw = blockIdx.x * 8 + wave, NGW = G * 8;
    float* xo = a.out; bf16_t* xb = (bf16_t*)(a.ws + WS_XBF); float* rs = (float*)(a.ws + WS_RS); const bf16_t* y = (const bf16_t*)(a.ws + ysrc);
    f32x4 gv[4];
#pragma unroll
    for (int j = 0; j < 2; ++j) { gv[2 * j] = *(const f32x4*)(gpost + 8 * lane + 512 * j); gv[2 * j + 1] = *(const f32x4*)(gpost + 8 * lane + 512 * j + 4); }
    constexpr int NR = 4;
    for (int grp = gw; grp < MTOK / NR; grp += NGW) {
        u32x4 yw[NR][2], xw[NR][2];
#pragma unroll
        for (int r = 0; r < NR; ++r) { const size_t off = (size_t)(grp * NR + r) * DM + 8 * lane;
#pragma unroll
            for (int j = 0; j < 2; ++j) { yw[r][j] = *(const u32x4*)(y + off + 512 * j); xw[r][j] = *(const u32x4*)(xb + off + 512 * j); } }
        float ss[NR];
#pragma unroll
        for (int r = 0; r < NR; ++r) { float s_ = 0.f;
#pragma unroll
            for (int j = 0; j < 2; ++j) { const u32x4 w = yw[r][j]; const float e0 = bflo(w.x), e1 = bfhi(w.x), e2 = bflo(w.y), e3 = bfhi(w.y), e4 = bflo(w.z), e5 = bfhi(w.z), e6 = bflo(w.w), e7 = bfhi(w.w);
                s_ += e0 * e0 + e1 * e1 + e2 * e2 + e3 * e3 + e4 * e4 + e5 * e5 + e6 * e6 + e7 * e7; }
            ss[r] = s_; }
#pragma unroll
        for (int o = 1; o < 64; o <<= 1) {
#pragma unroll
            for (int r = 0; r < NR; ++r) ss[r] += __shfl_xor(ss[r], o); }
        float xs[NR];
#pragma unroll
        for (int r = 0; r < NR; ++r) { const float ry = 1.0f / sqrtf(ss[r] * (1.0f / DM) + EPS); float s_ = 0.f; const size_t off = (size_t)(grp * NR + r) * DM + 8 * lane;
#pragma unroll
            for (int j = 0; j < 2; ++j) { const u32x4 w = yw[r][j]; const u32x4 xx = xw[r][j]; f32x4 a0, a1;
                a0[0] = bflo(xx.x) + bflo(w.x) * ry * gv[2 * j][0]; a0[1] = bfhi(xx.x) + bfhi(w.x) * ry * gv[2 * j][1]; a0[2] = bflo(xx.y) + bflo(w.y) * ry * gv[2 * j][2]; a0[3] = bfhi(xx.y) + bfhi(w.y) * ry * gv[2 * j][3];
                a1[0] = bflo(xx.z) + bflo(w.z) * ry * gv[2 * j + 1][0]; a1[1] = bfhi(xx.z) + bfhi(w.z) * ry * gv[2 * j + 1][1]; a1[2] = bflo(xx.w) + bflo(w.w) * ry * gv[2 * j + 1][2]; a1[3] = bfhi(xx.w) + bfhi(w.w) * ry * gv[2 * j + 1][3];
                if (final_out) { *(f32x4*)(xo + off + 512 * j) = a0; *(f32x4*)(xo + off + 512 * j + 4) = a1; }
                else { u32x4 o; o.x = pk2(a0[0], a0[1]); o.y = pk2(a0[2], a0[3]); o.z = pk2(a1[0], a1[1]); o.w = pk2(a1[2], a1[3]); *(u32x4*)(xb + off + 512 * j) = o;
                    const float b0 = bflo(o.x), b1 = bfhi(o.x), b2 = bflo(o.y), b3 = bfhi(o.y), b4 = bflo(o.z), b5 = bfhi(o.z), b6 = bflo(o.w), b7 = bfhi(o.w);
                    s_ += b0 * b0 + b1 * b1 + b2 * b2 + b3 * b3 + b4 * b4 + b5 * b5 + b6 * b6 + b7 * b7; } }
            xs[r] = s_; }
        if (!final_out) {
#pragma unroll
            for (int o = 1; o < 64; o <<= 1) {
#pragma unroll
                for (int r = 0; r < NR; ++r) xs[r] += __shfl_xor(xs[r], o); }
            if (lane == 0) {
#pragma unroll
                for (int r = 0; r < NR; ++r) rs[grp * NR + r] = 1.0f / sqrtf(xs[r] * (1.0f / DM) + EPS); } }
    }
}

__device__ __forceinline__ void unpack8(const u32x4 w, float (&f)[8]) { f[0] = bflo(w.x); f[1] = bfhi(w.x); f[2] = bflo(w.y); f[3] = bfhi(w.y); f[4] = bflo(w.z); f[5] = bfhi(w.z); f[6] = bflo(w.w); f[7] = bfhi(w.w); }
__device__ __forceinline__ u32x4 pack8(const float (&f)[8]) { u32x4 o; o.x = pk2(f[0], f[1]); o.y = pk2(f[2], f[3]); o.z = pk2(f[4], f[5]); o.w = pk2(f[6], f[7]); return o; }

__device__ __forceinline__ void phase_e1(const Args& a, int l, LAS unsigned char* lds, int tid) {
    const int lane = tid & 63, wid = __builtin_amdgcn_readfirstlane(tid >> 6), r32 = lane & 31, hi = lane >> 5;
    unsigned char* ws = a.ws;
    const bf16_t* P = (const bf16_t*)(ws + WS_PROJ); bf16_t* CQN = (bf16_t*)(ws + WS_CQN); bf16_t* CKVN = (bf16_t*)(ws + WS_CKVN); bf16_t* KR = (bf16_t*)(ws + WS_KR);
    bf16_t* BR = (bf16_t*)(ws + WS_BR); const float* rc = (const float*)(ws + WS_ROPEC); const float* rsn = (const float*)(ws + WS_ROPES);
    const bf16_t* SGWB = (const bf16_t*)(ws + WS_SGW);
    const float* convw = a.in[I_CONVW] + l * 3 * 256; const float* lng = a.in[I_LNG] + l * 256; const float* lnb = a.in[I_LNB] + l * 256; const float* sgb = a.in[I_SGB] + l * 512;
    for (int tile = blockIdx.x; tile < MTOK / 128; tile += gridDim.x) {
        const int R0 = tile * 128, s0 = R0 & (SEQ - 1);
        { const int rsub = lane >> 4, li = lane & 15;
#pragma unroll
          for (int it2 = 0; it2 < 2; ++it2) {
              u32x4 cqa[2], cqb[2], ckv[2]; float x1[2], x2[2], cc[2], ss[2];
#pragma unroll
              for (int u = 0; u < 2; ++u) { const int row = R0 + wid * 16 + (it2 * 2 + u) * 4 + rsub; const bf16_t* pr = P + (size_t)row * 2048;
                  cqa[u] = *(const u32x4*)(pr + 8 * li); cqb[u] = *(const u32x4*)(pr + 128 + 8 * li); ckv[u] = *(const u32x4*)(pr + 256 + 8 * li);
                  x1[u] = bf2f(pr[384 + li]); x2[u] = bf2f(pr[400 + li]); cc[u] = rc[(size_t)row * 16 + li]; ss[u] = rsn[(size_t)row * 16 + li]; }
#pragma unroll
              for (int u = 0; u < 2; ++u) { const int row = R0 + wid * 16 + (it2 * 2 + u) * 4 + rsub;
                  float qa[8], qb[8], kv[8]; unpack8(cqa[u], qa); unpack8(cqb[u], qb); unpack8(ckv[u], kv);
                  float sq = 0.f, sk = 0.f;
#pragma unroll
                  for (int e = 0; e < 8; ++e) { sq += qa[e] * qa[e] + qb[e] * qb[e]; sk += kv[e] * kv[e]; }
#pragma unroll
                  for (int o = 1; o < 16; o <<= 1) { sq += __shfl_xor(sq, o); sk += __shfl_xor(sk, o); }
                  const float rq = 1.0f / sqrtf(sq * (1.0f / 256.0f) + EPS), rk = 1.0f / sqrtf(sk * (1.0f / 128.0f) + EPS);
#pragma unroll
                  for (int e = 0; e < 8; ++e) { qa[e] *= rq; qb[e] *= rq; kv[e] *= rk; }
                  *(u32x4*)(CQN + (size_t)row * 256 + 8 * li) = pack8(qa); *(u32x4*)(CQN + (size_t)row * 256 + 128 + 8 * li) = pack8(qb);
                  *(u32x4*)(CKVN + (size_t)row * 128 + 8 * li) = pack8(kv);
                  KR[(size_t)row * 32 + li] = (bf16_t)f2bf(x1[u] * cc[u] - x2[u] * ss[u]); KR[(size_t)row * 32 + 16 + li] = (bf16_t)f2bf(x2[u] * cc[u] + x1[u] * ss[u]); } } }
        { const int ch = tid & 31, run = tid >> 5, t0 = run * 8; const bf16_t* pb = P + (size_t)(R0 + t0) * 2048 + 8 * ch; const int sb = s0 + t0;
          { float w0[8], w1[8], w2[8];
#pragma unroll
            for (int e = 0; e < 8; ++e) { w0[e] = convw[8 * ch + e]; w1[e] = convw[256 + 8 * ch + e]; w2[e] = convw[512 + 8 * ch + e]; }
            float zm2[8], zm1[8];
#pragma unroll
            for (int e = 0; e < 8; ++e) { zm2[e] = 0.f; zm1[e] = 0.f; }
            if (sb >= 2) { float xv[8], cv[8]; unpack8(*(const u32x4*)(pb - 2 * 2048 + 1024), xv); unpack8(*(const u32x4*)(pb - 2 * 2048 + 1536), cv);
#pragma unroll
                for (int e = 0; e < 8; ++e) zm2[e] = xv[e] * cv[e]; }
            if (sb >= 1) { float xv[8], cv[8]; unpack8(*(const u32x4*)(pb - 2048 + 1024), xv); unpack8(*(const u32x4*)(pb - 2048 + 1536), cv);
#pragma unroll
                for (int e = 0; e < 8; ++e) zm1[e] = xv[e] * cv[e]; }
#pragma unroll
            for (int half = 0; half < 2; ++half) { u32x4 lx[4], lc[4], lb[4];
#pragma unroll
                for (int j = 0; j < 4; ++j) { const bf16_t* pr = pb + (size_t)(half * 4 + j) * 2048; lx[j] = *(const u32x4*)(pr + 1024); lc[j] = *(const u32x4*)(pr + 1536); lb[j] = *(const u32x4*)(pr + 1280); }
#pragma unroll
                for (int j = 0; j < 4; ++j) { float xv[8], cv[8], bg[8], y[8]; unpack8(lx[j], xv); unpack8(lc[j], cv); unpack8(lb[j], bg);
#pragma unroll
                    for (int e = 0; e < 8; ++e) { const float z = xv[e] * cv[e]; y[e] = bg[e] * (w0[e] * zm2[e] + w1[e] * zm1[e] + w2[e] * z); zm2[e] = zm1[e]; zm1[e] = z; }
                    *(u32x4*)(BR + (size_t)(R0 + t0 + half * 4 + j) * DM + 512 + 8 * ch) = pack8(y); } } }
          { const int g = ch >> 3, win = 2 << g; float S[8];
#pragma unroll
            for (int e = 0; e < 8; ++e) S[e] = 0.f;
            for (int i = 1; i < win; ++i) { if (sb - i >= 0) { float pv[8]; unpack8(*(const u32x4*)(pb - (size_t)i * 2048 + 1792), pv);
#pragma unroll
                    for (int e = 0; e < 8; ++e) S[e] += pv[e]; } }
#pragma unroll
            for (int half = 0; half < 2; ++half) { u32x4 lp[4], lo[4];
#pragma unroll
                for (int j = 0; j < 4; ++j) { const int t = half * 4 + j; lp[j] = *(const u32x4*)(pb + (size_t)t * 2048 + 1792);
                    const int back = t - win + 1; lo[j] = (sb + back >= 0) ? *(const u32x4*)(pb + (ptrdiff_t)back * 2048 + 1792) : (u32x4){0u, 0u, 0u, 0u}; }
#pragma unroll
                for (int j = 0; j < 4; ++j) { const int t = half * 4 + j; float pt[8], po[8], o[8]; unpack8(lp[j], pt); unpack8(lo[j], po);
                    const int s = sb + t; const int cnt = (s + 1) < win ? (s + 1) : win; const float ic = 1.0f / (float)cnt;
#pragma unroll
                    for (int e = 0; e < 8; ++e) { S[e] += pt[e]; o[e] = S[e] * ic - pt[e]; S[e] -= po[e]; }
                    *(u32x4*)(BR + (size_t)(R0 + t0 + t) * DM + 768 + 8 * ch) = pack8(o); } } } }
        { const int srow = tid >> 2, qt = tid & 3; const bf16_t* vp = P + (size_t)(R0 + srow) * 2048 + 768 + qt * 64;
          float v[64]; float sum = 0.f;
#pragma unroll
          for (int j = 0; j < 8; ++j) { const u32x4 w = *(const u32x4*)(vp + 8 * j);
              v[8 * j + 0] = bflo(w.x); v[8 * j + 1] = bfhi(w.x); v[8 * j + 2] = bflo(w.y); v[8 * j + 3] = bfhi(w.y); v[8 * j + 4] = bflo(w.z); v[8 * j + 5] = bfhi(w.z); v[8 * j + 6] = bflo(w.w); v[8 * j + 7] = bfhi(w.w); }
#pragma unroll
          for (int j = 0; j < 64; ++j) sum += v[j];
          sum += __shfl_xor(sum, 1); sum += __shfl_xor(sum, 2);
          const float mean = sum * (1.0f / 256.0f); float var = 0.f;
#pragma unroll
          for (int j = 0; j < 64; ++j) { v[j] -= mean; var += v[j] * v[j]; }
          var += __shfl_xor(var, 1); var += __shfl_xor(var, 2);
          const float rstd = 1.0f / sqrtf(var * (1.0f / 256.0f) + EPS);
          LAS bf16_t* vT = (LAS bf16_t*)lds;
#pragma unroll
          for (int j = 0; j < 64; ++j) { const int c = qt * 64 + j; vT[c * 136 + srow] = (bf16_t)f2bf(v[j] * rstd * lng[c] + lnb[c]); } }
        __syncthreads();
        { const int g = wid >> 1, th = wid & 1;
#pragma unroll
          for (int tb = 0; tb < 2; ++tb) {
              const int nks = (64 * th + 32 * tb + 32) >> 4;
              const bf16_t* ap = SGWB + (size_t)(g * 128 + 64 * th + 32 * tb + r32) * 128 + 8 * hi;
              bf16x8 Af[8];
#pragma unroll
              for (int ks = 0; ks < 8; ++ks) Af[ks] = (ks < nks) ? *(const bf16x8*)(ap + 16 * ks) : (bf16x8){0, 0, 0, 0, 0, 0, 0, 0};
              float bsv[16];
#pragma unroll
              for (int r = 0; r < 16; ++r) bsv[r] = sgb[g * 128 + 64 * th + 32 * tb + crow(r, hi)];
#pragma unroll
              for (int cb = 0; cb < 2; ++cb) { f32x16 acc;
#pragma unroll
                  for (int r = 0; r < 16; ++r) acc[r] = 0.f;
                  const LAS unsigned char* bp = lds + (g * 64 + 32 * cb + r32) * 272 + 16 * hi;
                  const int c = g * 64 + 32 * cb + r32;
                  float uv[16];
#pragma unroll
                  for (int r = 0; r < 16; ++r) uv[r] = bf2f(P[(size_t)(R0 + 64 * th + 32 * tb + crow(r, hi)) * 2048 + 512 + c]);
#pragma unroll
                  for (int ks = 0; ks < 8; ++ks) { if (ks < nks) { const bf16x8 B = *(const LAS bf16x8*)(bp + 32 * ks); acc = MFMA32(Af[ks], B, acc); } }
#pragma unroll
                  for (int r = 0; r < 16; ++r) { const int t = 64 * th + 32 * tb + crow(r, hi);
                      BR[(size_t)(R0 + t) * DM + 256 + c] = (bf16_t)f2bf(uv[r] * (acc[r] + bsv[r])); } } } }
        __syncthreads();
    }
}

constexpr int KPITCH = 208, VPITCH = 264, KBUF = 128 * KPITCH, VBUF = 64 * VPITCH, ATT_V0 = 2 * KBUF, ATT_WS = ATT_V0 + 2 * VBUF;
#define MX3(a, b, c) __builtin_fmaxf(__builtin_fmaxf((a), (b)), (c))
#define ATT_QK(P0, P1, KB) do { \
    _Pragma("unroll") for (int kh = 0; kh < 2; ++kh) { bf16x8 ka_[3], kc_[3]; \
        _Pragma("unroll") for (int ks = 0; ks < 3; ++ks) { ka_[ks] = *(const LAS bf16x8*)((KB) + (3 * kh + ks) * 32); kc_[ks] = *(const LAS bf16x8*)((KB) + 32 * KPITCH + (3 * kh + ks) * 32); } \
        _Pragma("unroll") for (int ks = 0; ks < 3; ++ks) { if (kh == 0 && ks == 0) { P0 = MFMA32(ka_[0], qf[0], negm); P1 = MFMA32(kc_[0], qf[0], negm); } \
            else { P0 = MFMA32(ka_[ks], qf[3 * kh + ks], P0); P1 = MFMA32(kc_[ks], qf[3 * kh + ks], P1); } } } } while (0)
#define ATT_MAX(P0, P1, TT) do { \
    if (64 * (TT) + 63 > qw0) { const int qg_ = qw0 + r32; \
        _Pragma("unroll") for (int r = 0; r < 16; ++r) { const int kv_ = 64 * (TT) + crow(r, hi); if (kv_ > qg_) P0[r] = -INFINITY; if (kv_ + 32 > qg_) P1[r] = -INFINITY; } } \
    float ra_ = MX3(P0[0], P0[1], P1[0]), rb_ = MX3(P0[2], P0[3], P1[1]); ra_ = MX3(ra_, P1[2], P1[3]); \
    _Pragma("unroll") for (int r = 4; r < 16; r += 4) { ra_ = MX3(ra_, P0[r], P0[r + 1]); rb_ = MX3(rb_, P0[r + 2], P0[r + 3]); ra_ = MX3(ra_, P1[r], P1[r + 1]); rb_ = MX3(rb_, P1[r + 2], P1[r + 3]); } \
    float rm_ = __builtin_fmaxf(ra_, rb_); rm_ = __builtin_fmaxf(rm_, __shfl_xor(rm_, 32));        \
    const bool first_ = ((TT) == 0); \
    if (first_ || __any(rm_ > 8.0f)) { const float dl_ = first_ ? rm_ : __builtin_fmaxf(rm_, 0.f); mref += dl_; \
        _Pragma("unroll") for (int r = 0; r < 16; ++r) { P0[r] -= dl_; P1[r] -= dl_; } \
        _Pragma("unroll") for (int r = 0; r < 16; ++r) negm[r] = -mref; \
        const float alpha_ = __builtin_amdgcn_exp2f(-dl_); lsum *= alpha_; if (hi == 0) wsf[r32] = alpha_; \
        asm volatile("s_waitcnt lgkmcnt(0)" ::: "memory"); \
        _Pragma("unroll") for (int r = 0; r < 16; ++r) { const float f_ = wsf[crow(r, hi)]; o0[r] *= f_; o1[r] *= f_; } } } while (0)
#define ATT_EXP(P0, P1, PA) do { float ps_ = 0.f; \
    _Pragma("unroll") for (int r = 0; r < 16; ++r) { P0[r] = __builtin_amdgcn_exp2f(P0[r]); P1[r] = __builtin_amdgcn_exp2f(P1[r]); ps_ += P0[r] + P1[r]; } \
    lsum += ps_; u32x4 w_; \
    w_.x = cvtpk_v(P0[0], P0[1]); w_.y = cvtpk_v(P0[2], P0[3]); w_.z = cvtpk_v(P0[4], P0[5]); w_.w = cvtpk_v(P0[6], P0[7]); PA[0] = __builtin_bit_cast(bf16x8, w_); \
    w_.x = cvtpk_v(P0[8], P0[9]); w_.y = cvtpk_v(P0[10], P0[11]); w_.z = cvtpk_v(P0[12], P0[13]); w_.w = cvtpk_v(P0[14], P0[15]); PA[1] = __builtin_bit_cast(bf16x8, w_); \
    w_.x = cvtpk_v(P1[0], P1[1]); w_.y = cvtpk_v(P1[2], P1[3]); w_.z = cvtpk_v(P1[4], P1[5]); w_.w = cvtpk_v(P1[6], P1[7]); PA[2] = __builtin_bit_cast(bf16x8, w_); \
    w_.x = cvtpk_v(P1[8], P1[9]); w_.y = cvtpk_v(P1[10], P1[11]); w_.z = cvtpk_v(P1[12], P1[13]); w_.w = cvtpk_v(P1[14], P1[15]); PA[3] = __builtin_bit_cast(bf16x8, w_); } while (0)
#define ATT_PV(PA, VB) do { \
    _Pragma("unroll") for (int kk = 0; kk < 4; ++kk) { \
        const s16x4 l0_ = *(const LAS s16x4*)((VB) + kk * 32), h0_ = *(const LAS s16x4*)((VB) + kk * 32 + 16); \
        const s16x4 l1_ = *(const LAS s16x4*)((VB) + 32 * VPITCH + kk * 32), h1_ = *(const LAS s16x4*)((VB) + 32 * VPITCH + kk * 32 + 16); \
        const bf16x8 v0_ = __builtin_shufflevector(l0_, h0_, 0, 1, 2, 3, 4, 5, 6, 7), v1_ = __builtin_shufflevector(l1_, h1_, 0, 1, 2, 3, 4, 5, 6, 7); \
        o0 = MFMA32(PA[kk], v0_, o0); o1 = MFMA32(PA[kk], v1_, o1); } } while (0)

__device__ __forceinline__ void attn_unit(const Args& a, int b, int h, int qb, LAS unsigned char* lds, int tid_in) {
    int tid = tid_in; asm volatile("" : "+v"(tid));
    const int lane = tid & 63, wid = __builtin_amdgcn_readfirstlane(tid >> 6), r32 = lane & 31, hi = lane >> 5;
    unsigned char* ws = a.ws;
    const bf16_t* Q = (const bf16_t*)(ws + WS_Q); const bf16_t* Kn = (const bf16_t*)(ws + WS_KN); const bf16_t* Kr = (const bf16_t*)(ws + WS_KR); const bf16_t* Vt = (const bf16_t*)(ws + WS_VT);
    bf16_t* O = (bf16_t*)(ws + WS_BR); const float* rc = (const float*)(ws + WS_ROPEC); const float* rsn = (const float*)(ws + WS_ROPES);
    const size_t rowbase = (size_t)b * SEQ; const int qw0 = qb * 256 + wid * 32;
    LAS float* wsf = (LAS float*)(lds + ATT_WS) + wid * 64;
    bf16x8 qf[6];
    { const size_t qrow = rowbase + qw0 + r32; const bf16_t* qp = Q + qrow * 512 + h * 96 + 8 * hi;
#pragma unroll
      for (int ks = 0; ks < 4; ++ks) qf[ks] = *(const bf16x8*)(qp + 16 * ks);
      const bf16x8 x1 = *(const bf16x8*)(qp + 64), x2 = *(const bf16x8*)(qp + 80);
      const float* cp = rc + qrow * 16 + 8 * hi; const float* sp = rsn + qrow * 16 + 8 * hi;
      const f32x4 c0 = *(const f32x4*)cp, c1 = *(const f32x4*)(cp + 4), s0 = *(const f32x4*)sp, s1 = *(const f32x4*)(sp + 4);
      bf16x8 o1, o2;
#pragma unroll
      for (int j = 0; j < 8; ++j) { const float xa = bf2f((bf16_t)x1[j]), xb = bf2f((bf16_t)x2[j]); const float c = j < 4 ? c0[j & 3] : c1[j & 3], s = j < 4 ? s0[j & 3] : s1[j & 3];
          o1[j] = (short)f2bf(xa * c - xb * s); o2[j] = (short)f2bf(xb * c + xa * s); }
      qf[4] = o1; qf[5] = o2; }
    const bf16_t* knu = Kn + rowbase * 256 + h * 64;
    const bf16_t* kru = Kr + rowbase * 32;
    const bf16_t* vtu = Vt + (size_t)(h * 64) * MTOK + rowbase;
    u32x4 gk0, gk1, gr, gv0, gv1;
#define ATT_LOAD(T) do { int t_ = tid; asm volatile("" : "+v"(t_)); const unsigned knv = (unsigned)((t_ >> 3) * 256 + (t_ & 7) * 8), krv = (unsigned)((t_ >> 2) * 32 + (t_ & 3) * 8), vtv = (unsigned)((t_ >> 3) * MTOK + (t_ & 7) * 8); \
        const bf16_t* k_ = knu + (size_t)(T) * 128 * 256; const bf16_t* r_ = kru + (size_t)(T) * 128 * 32; const bf16_t* v_ = vtu + (size_t)(T) * 128; \
        gk0 = *(const u32x4*)(k_ + knv); gk1 = *(const u32x4*)(k_ + 64 * 256 + knv); gr = *(const u32x4*)(r_ + krv); \
        gv0 = *(const u32x4*)(v_ + vtv); gv1 = *(const u32x4*)(v_ + 64 + vtv); } while (0)
#define ATT_STORE(bf) do { int t_ = tid; asm volatile("" : "+v"(t_)); const int krow = t_ >> 3, kch = t_ & 7, rrow = t_ >> 2, rch = t_ & 3; \
        LAS unsigned char* kd_ = lds + (bf) * KBUF; LAS unsigned char* vd_ = lds + ATT_V0 + (bf) * VBUF + krow * VPITCH + kch * 16; \
        *(LAS u32x4*)(kd_ + krow * KPITCH + kch * 16) = gk0; *(LAS u32x4*)(kd_ + (krow + 64) * KPITCH + kch * 16) = gk1; *(LAS u32x4*)(kd_ + rrow * KPITCH + 128 + rch * 16) = gr; \
        *(LAS u32x2*)(vd_) = (u32x2){gv0.x, gv0.y}; *(LAS u32x2*)(vd_ + 8) = (u32x2){gv0.z, gv0.w}; *(LAS u32x2*)(vd_ + 128) = (u32x2){gv1.x, gv1.y}; *(LAS u32x2*)(vd_ + 136) = (u32x2){gv1.z, gv1.w}; } while (0)
    float mref = 0.f, lsum = 0.f; f32x16 o0, o1, negm;
#pragma unroll
    for (int r = 0; r < 16; ++r) { o0[r] = 0.f; o1[r] = 0.f; negm[r] = 0.f; }
    const int NT2 = 2 * qb + 2;
    ATT_LOAD(0); ATT_STORE(0); __syncthreads();
    for (int T = 0; T < NT2; ++T) {
        const int buf = T & 1;
        if (T + 1 < NT2) ATT_LOAD(T + 1);
        const int tA = 2 * T, tB = 2 * T + 1;
        const LAS unsigned char* kbA = lds + buf * KBUF + r32 * KPITCH + hi * 16; const LAS unsigned char* kbB = kbA + 64 * KPITCH;
        const LAS unsigned char* vbA = lds + ATT_V0 + buf * VBUF + r32 * VPITCH + hi * 8; const LAS unsigned char* vbB = vbA + 128;
        if (64 * tB <= qw0 + 31) {
            f32x16 pA0, pA1, pB0, pB1; bf16x8 pa[4];
            ATT_QK(pA0, pA1, kbA);
            ATT_MAX(pA0, pA1, tA);
            ATT_QK(pB0, pB1, kbB);
            ATT_EXP(pA0, pA1, pa);
            ATT_MAX(pB0, pB1, tB);
            ATT_PV(pa, vbA);
            ATT_EXP(pB0, pB1, pa);
            ATT_PV(pa, vbB);
        } else if (64 * tA <= qw0 + 31) {
            f32x16 pA0, pA1; bf16x8 pa[4];
            ATT_QK(pA0, pA1, kbA);
            ATT_MAX(pA0, pA1, tA);
            ATT_EXP(pA0, pA1, pa);
            ATT_PV(pa, vbA);
        }
        if (T + 1 < NT2) ATT_STORE((T + 1) & 1);
        __syncthreads();
    }
#undef ATT_LOAD
#undef ATT_STORE
    lsum += __shfl_xor(lsum, 32);
    if (hi == 0) wsf[32 + r32] = 1.0f / lsum;
    asm volatile("s_waitcnt lgkmcnt(0)" ::: "memory");
    { bf16_t* ou = O + (rowbase + qw0) * DM + h * 64;
#pragma unroll
      for (int r = 0; r < 16; ++r) { const int qr = crow(r, hi); const float inv = wsf[32 + qr]; const unsigned ov = (unsigned)(qr * DM + r32);
          ou[ov] = (bf16_t)f2bf(o0[r] * inv); ou[ov + 32] = (bf16_t)f2bf(o1[r] * inv); } }
}
__device__ __forceinline__ void phase_attn(const Args& a, LAS unsigned char* lds, int tid) {
    const int G = gridDim.x, bx = blockIdx.x; const int v0 = (G % 8 == 0) ? (bx % 8) * (G / 8) + bx / 8 : bx;
    for (int v = v0; v < 256; v += G) { const int bh = v >> 4, s = v & 15;
        attn_unit(a, bh >> 2, bh & 3, 31 - s, lds, tid);
        attn_unit(a, bh >> 2, bh & 3, s, lds, tid); }
}

#define XB_TMO      128
#define XB_XCNT(j)  (256  + 64 * (j))
#define XB_XSUB(j)  (1280 + 64 * (j))
#define XB_XGEN(j)  (2304 + 64 * (j))
#define XB_TOP      3328
#define XB_TOPGEN   3392
#define XCD_BAR_WORDS 3456
#define XB_SPIN_CAP (1u << 18)

__device__ __forceinline__ unsigned xb_ld(unsigned* p)              { return __hip_atomic_load(p, __ATOMIC_RELAXED, __HIP_MEMORY_SCOPE_AGENT); }
__device__ __forceinline__ unsigned xb_add(unsigned* p, unsigned v) { return __hip_atomic_fetch_add(p, v, __ATOMIC_RELAXED, __HIP_MEMORY_SCOPE_AGENT); }
__device__ __forceinline__ unsigned xb_xcc_id() { return (unsigned)__builtin_amdgcn_s_getreg((3 << 11) | 20) & 0xFu; }
#define XB_SPIN(cond, bar) do { unsigned _sp = 0; while (cond) { __builtin_amdgcn_s_sleep(1); \
    if ((++_sp & 255u) == 0u) { if (xb_ld(&(bar)[XB_TMO])) break; if (_sp > XB_SPIN_CAP) { atomicAdd(&(bar)[XB_TMO], 1u); break; } } } } while (0)

struct XcdBarrier {
    unsigned* bar; unsigned x;
    volatile LAS unsigned* st;
};

__device__ __forceinline__ XcdBarrier xcd_barrier_post(unsigned* bar, volatile LAS unsigned* st) {
    XcdBarrier b; b.bar = bar; b.x = xb_xcc_id(); b.st = st;
    if (threadIdx.x == 0) (void)xb_add(&bar[XB_XCNT(b.x)], 1u);
    return b;
}
__device__ __forceinline__ void xcd_barrier_complete(unsigned* bar, unsigned x, unsigned& nloc, unsigned& nx) {
    const unsigned G = gridDim.x * gridDim.y * gridDim.z;
    unsigned sum, cnt, mine, sp = 0u;
    for (;;) {
        sum = 0u; cnt = 0u; mine = 0u;
#pragma unroll
        for (unsigned j = 0; j < 16; ++j) { const unsigned c = xb_ld(&bar[XB_XCNT(j)]); sum += c; cnt += (c > 0u) ? 1u : 0u; mine = (j == x) ? c : mine; }
        if (sum == G) break;
        __builtin_amdgcn_s_sleep(1);
        if ((++sp & 255u) == 0u) { if (xb_ld(&bar[XB_TMO])) break; if (sp > XB_SPIN_CAP) { atomicAdd(&bar[XB_TMO], 1u); break; } }
    }
    nloc = mine > 0u ? mine : 1u; nx = cnt > 0u ? cnt : 1u;
}

__device__ __forceinline__ void xcd_barrier(const XcdBarrier& b) {
    asm volatile("s_waitcnt vmcnt(0)" ::: "memory");
    __syncthreads();
    if (threadIdx.x == 0) {
        unsigned* bar = b.bar;
        __builtin_amdgcn_s_waitcnt(0);
        unsigned nloc = b.st[0], nx = b.st[1];
        if (nloc == 0u) { xcd_barrier_complete(bar, b.x, nloc, nx); b.st[0] = nloc; b.st[1] = nx; }
        const unsigned old = xb_add(&bar[XB_XSUB(b.x)], 1u);
        const unsigned gen = old / nloc;
        if (old + 1u == (gen + 1u) * nloc) {
            __builtin_amdgcn_fence(__ATOMIC_RELEASE, "agent");
            asm volatile("s_waitcnt vmcnt(0)" ::: "memory");
            const unsigned og = xb_add(&bar[XB_TOP], 1u);
            const unsigned tg = og / nx;
            if (og + 1u == (tg + 1u) * nx) xb_add(&bar[XB_TOPGEN], 1u);
            else XB_SPIN(xb_ld(&bar[XB_TOPGEN]) == tg, bar);
            __builtin_amdgcn_fence(__ATOMIC_ACQUIRE, "agent");
            xb_add(&bar[XB_XGEN(b.x)], 1u);
            asm volatile("s_waitcnt vmcnt(0)" ::: "memory");
        } else {
            XB_SPIN(xb_ld(&bar[XB_XGEN(b.x)]) == gen, bar);
            __builtin_amdgcn_fence(__ATOMIC_ACQUIRE, "agent");
            asm volatile("s_waitcnt vmcnt(0)" ::: "memory");
        }
    }
    __syncthreads();
}

__global__ void __launch_bounds__(512, 2) mk_fwd(Args a) {
    extern __shared__ __attribute__((aligned(16))) unsigned char lds_raw[];
    LAS unsigned char* lds = (LAS unsigned char*)lds_raw;
    cg::grid_group grid = cg::this_grid();
    const int tid0 = threadIdx.x, G = gridDim.x, bx = blockIdx.x;
    { volatile LAS unsigned* st0 = (volatile LAS unsigned*)(lds + 131072 + 64); if (tid0 == 0) { st0[0] = 0u; st0[1] = 0u; } }
    __syncthreads();
    XcdBarrier xbar = xcd_barrier_post((unsigned*)a.ws, (volatile LAS unsigned*)(lds + 131072 + 64));
    for (int ph = a.lo; ph < a.hi; ++ph) {
        unsigned char* ws = a.ws; int tid = tid0;
        asm volatile("" : "+s"(ws), "+v"(tid));
        int l = 0, k = -1; if (ph > 0) { l = (ph - 1) / 11; k = (ph - 1) % 11; }
        const int ng = (k == 0 || k == 4 || k == 5 || k == 6 || k == 8 || k == 9) ? 1 : (k == 2 ? 3 : 0);
#ifndef PM
#define PM 0xFF
#endif
        if (PM & 1) for (int j = 0; j < ng; ++j) {
            size_t oA, oB, oO; int M_ = MTOK, N_ = DM, K_ = DM, lda = DM, ldb = DM, ldc = DM, mode = 0, nbr = 1, coff = 0, use_rs = 0, zs = 0, bmode = 0;
            if (k == 0) {
                oA = WS_XBF; oB = WS_WIN; oO = WS_BIG; N_ = 2048; ldc = 2048; use_rs = 1; mode = 1;
            } else if (k == 2) {
                if (j == 0) { oA = WS_CQN; oB = WS_WUQ; oO = WS_Q; N_ = 512; K_ = 256; lda = 256; ldb = 256; ldc = 512; }
                else if (j == 1) { oA = WS_CKVN; oB = WS_WK; oO = WS_KN; N_ = 256; K_ = 128; lda = 128; ldb = 128; ldc = 256; }
                else { oA = WS_WV; oB = WS_CKVN; oO = WS_VT; M_ = 256; N_ = MTOK; K_ = 128; lda = 128; ldb = 128; ldc = MTOK; coff = G / 2; }
            } else if (k == 4) {
                oA = WS_BR; oB = WS_WBR; oO = WS_BIG; K_ = 256; ldb = 256; ldc = 4096; nbr = 4; zs = 1024;
            } else if (k == 5) {
                oA = WS_XBF; oB = WS_WIN + (size_t)2048 * DM * 2; oO = WS_BR; N_ = 4096; use_rs = 1; mode = 5; bmode = 1;
            } else if (k == 6) {
                oA = WS_BR; oB = WS_WOUT; oO = WS_BIG;
            } else if (k == 8) {
                oA = WS_XBF; oB = WS_W1; oO = WS_BIG; N_ = DFF; ldc = DFF; use_rs = 1; mode = 3;
            } else {
                oA = WS_BIG; oB = WS_W2; oO = WS_BR; K_ = DFF; lda = DFF; ldb = DFF;
            }
            pg8::Gemm g{(const bf16_t*)(ws + oA), (const bf16_t*)(ws + oB), M_, N_, K_, lda, ldb, bmode};
            pg8::EpiRT E{(bf16_t*)(ws + oO), ldc, use_rs ? (const float*)(ws + WS_RS) : nullptr, a.in[I_GATEB] + l * 4096, (const bf16_t*)(ws + WS_BIG), mode, zs};
            pg8::MergeOrder S; S.init(M_, N_, G, (bx + coff) % G, nbr);
            pg8::gemm_phase<pg8::EpiRT, pg8::MergeOrder, true, true>(lds, g, S, E, tid);
        }
        if ((PM & 2) && k == 1) phase_e1(a, l, lds, tid);
        if ((PM & 4) && k == 3) phase_attn(a, lds, tid);
        if ((PM & 8) && (k == 7 || k == 10)) phase_nr(a, (k == 7 ? a.in[I_NPOST] : a.in[I_NFPOST]) + l * DM, k == 7 ? WS_BIG : WS_BR, (k == 10 && l == NLAYER - 1), tid);
        if ((PM & 16) && ph == 0) phase_s0(a, lds, tid);
        if ((PM & 32) && (ph == 0 || (k == 10 && l + 1 < NLAYER))) prep_weights(a, ph == 0 ? 0 : l + 1, lds, tid);
        if (ph + 1 < a.hi) { if (ph == a.lo) grid.sync(); else xcd_barrier(xbar); }
    }
}

constexpr int NPHASE = 1 + 11 * NLAYER;
#ifndef MK_ONE_LAUNCH
#define MK_ONE_LAUNCH 1
#endif
extern "C" void kernel_launch(void* const* d_in, const int* in_sizes, int n_in, void* d_out, int out_size, void* d_ws, size_t ws_size, hipStream_t stream) {
    static int grid = 0;
    if (grid == 0) {
        if (n_in != 26 || out_size != MTOK * DM || ws_size < WS_END) { fprintf(stderr, "kernel_launch: unexpected shapes (n_in %d out %d ws %zu)\n", n_in, out_size, ws_size); grid = -1; return; }
        int dev = 0, cus = 0, per_cu = 0;
        hipGetDevice(&dev); hipDeviceGetAttribute(&cus, hipDeviceAttributeMultiprocessorCount, dev);
        hipFuncSetAttribute((const void*)mk_fwd, hipFuncAttributeMaxDynamicSharedMemorySize, LDS_BYTES);
        hipOccupancyMaxActiveBlocksPerMultiprocessor(&per_cu, (const void*)mk_fwd, 512, LDS_BYTES);
        if (per_cu < 1) { fprintf(stderr, "kernel_launch: occupancy query says %d blocks per CU\n", per_cu); per_cu = 1; }
        (void)hipGetLastError();
        grid = cus;
    }
    if (grid < 0) return;
    Args a{};
    for (int i = 0; i < 26; ++i) a.in[i] = (const float*)d_in[i];
    a.out = (float*)d_out; a.ws = (unsigned char*)d_ws;
    if (hipMemsetAsync(d_ws, 0, 16384, stream) != hipSuccess) { fprintf(stderr, "memset failed\n"); return; }
#if MK_ONE_LAUNCH
    a.lo = 0; a.hi = NPHASE;
    { void* args[] = {&a}; hipError_t e = hipLaunchCooperativeKernel((const void*)mk_fwd, dim3(grid), dim3(512), args, LDS_BYTES, stream);
      if (e != hipSuccess) fprintf(stderr, "cooperative launch failed: %s (grid %d)\n", hipGetErrorString(e), grid); }
#else
    for (int ph = 0; ph < NPHASE; ++ph) { a.lo = ph; a.hi = ph + 1;
        void* args[] = {&a}; hipError_t e = hipLaunchCooperativeKernel((const void*)mk_fwd, dim3(grid), dim3(512), args, LDS_BYTES, stream);
        if (e != hipSuccess) { fprintf(stderr, "launch %d failed: %s (grid %d)\n", ph, hipGetErrorString(e), grid); break; } }
#endif
}
```

```cpp
#include <hip/hip_runtime.h>
#include <hip/hip_cooperative_groups.h>
#include <cstdio>
#include <cstdint>
namespace cg = cooperative_groups;

#define LAS __attribute__((address_space(3)))
typedef unsigned short bf16_t;
typedef short bf16x8 __attribute__((ext_vector_type(8)));
typedef short s16x4 __attribute__((ext_vector_type(4)));
typedef float f32x4 __attribute__((ext_vector_type(4)));
typedef float f32x2 __attribute__((ext_vector_type(2)));
typedef float f32x16 __attribute__((ext_vector_type(16)));
typedef unsigned u32x4 __attribute__((ext_vector_type(4)));
typedef unsigned u32x2 __attribute__((ext_vector_type(2)));

__device__ __forceinline__ unsigned f2bf(float f) { unsigned u = __builtin_bit_cast(unsigned, f); return (u + 0x7fffu + ((u >> 16) & 1u)) >> 16; }
__device__ __forceinline__ unsigned pk2(float lo, float hi) { return f2bf(lo) | (f2bf(hi) << 16); }
__device__ __forceinline__ float bflo(unsigned w) { return __builtin_bit_cast(float, w << 16); }
__device__ __forceinline__ float bfhi(unsigned w) { return __builtin_bit_cast(float, w & 0xffff0000u); }
__device__ __forceinline__ float bf2f(bf16_t h) { return __builtin_bit_cast(float, ((unsigned)h) << 16); }
__device__ __forceinline__ float wave_sum(float v) {
#pragma unroll
    for (int o = 1; o < 64; o <<= 1) v += __shfl_xor(v, o);
    return v;
}
__device__ __forceinline__ float fast_sigmoid(float v) { return __builtin_amdgcn_rcpf(1.0f + __builtin_amdgcn_exp2f(-1.4426950408889634f * v)); }
__device__ __forceinline__ float gelu_tanh(float x) { const float u = 0.7978845608028654f * (x + 0.044715f * x * x * x); return x * fast_sigmoid(2.0f * u); }

namespace pg8 {
#define PG8_LAS __attribute__((address_space(3)))
constexpr int BM = 256, BK = 64, HALF = 128, HTB = HALF * BK * 2  , STAGE_BYTES = 8 * HTB, NXCD = 8, WGM = 8;

__host__ __device__ __forceinline__ int lds_byte(int r, int c) { const int st = (r >> 4) * 2 + (c >> 5), rr = r & 15, cc = c & 31, ob = rr * 64 + cc * 2; return st * 1024 + (ob ^ (((ob >> 9) & 1) << 5)); }
__host__ __device__ __forceinline__ void stage_rc(int b, int& R, int& C) { const int st = b / 1024, sb = b % 1024, swz = sb ^ (((sb >> 9) & 1) << 5); R = (st >> 1) * 16 + swz / 64; C = (st & 1) * 32 + (swz % 64) / 2; }
__host__ __device__ __forceinline__ int perm32(int rho) { const int n = rho >> 4, i = rho & 15; return 8 * (i >> 2) + 4 * n + (i & 3); }

struct Unit { int pm, pn, bn, ak, z; };
struct Gemm { const bf16_t* A; const bf16_t* Bt; int M, N, K, lda, ldb, bmode; };

struct StaticOrder {
    int nM, nN, nwg, G, c;
    __host__ __device__ void init(int M, int N, int G_, int c_) { nM = M / BM; nN = N / BM; nwg = nM * nN; G = G_; c = c_; }
    __host__ __device__ bool map(long L, Unit& u) const {
        if (L >= nwg) return false;
        int wgid = (int)L; { const int q = nwg / NXCD, r = nwg % NXCD, xcd = wgid % NXCD, off = wgid / NXCD; wgid = (xcd < r ? xcd * (q + 1) : r * (q + 1) + (xcd - r) * q) + off; }
        const int nig = WGM * nN, gid = wgid / nig, fm = gid * WGM, gsz = (nM - fm) < WGM ? (nM - fm) : WGM;
        u.pm = fm + ((wgid % nig) % gsz); u.pn = (wgid % nig) / gsz; return true;
    }
    __host__ __device__ bool next(int i, Unit& u) const { u.ak = 0; u.z = 0; const bool ok = map((long)i * G + c, u); u.bn = u.pn; return ok; }
    __device__ __forceinline__ void a_ready(const Unit&) const {}
    __device__ __forceinline__ void done(const Unit&) const {}
};
struct MergeOrder {
    StaticOrder S; int nbr;
    __host__ __device__ void init(int M, int N, int G_, int c_, int nbr_) { S.init(M, N, G_, c_); nbr = nbr_; }
    __host__ __device__ bool next(int i, Unit& u) const { const int z = i % nbr; const bool ok = S.map((long)(i / nbr) * S.G + S.c, u); u.z = z; u.ak = z * 256; u.bn = z * S.nN + u.pn; return ok; }
    __device__ __forceinline__ void a_ready(const Unit&) const {}
    __device__ __forceinline__ void done(const Unit&) const {}
};

__device__ __forceinline__ unsigned cvt_pk_bf16(float lo, float hi) { unsigned r; asm volatile("v_cvt_pk_bf16_f32 %0, %1, %2" : "=v"(r) : "v"(lo), "v"(hi)); return r; }

constexpr size_t Y_OFF = (size_t)168 << 20;
struct EpiRT {
    static constexpr bool PERM = true, AFTER_DRAIN = false;
    bf16_t* O; int ldc; const float* rs; const float* bias; const bf16_t* gates; int mode, zs;
    __device__ __forceinline__ void operator()(const f32x4 (&acc)[2][2][4][2], const Unit& u, int wr, int wc, int fr, int fq) const {
        if (mode == 6) {
            const int tidx = (wr * 4 + wc) * 64 + fq * 16 + fr; u32x4* Yp = (u32x4*)O;
#pragma unroll
            for (int bj = 0; bj < 2; ++bj)
#pragma unroll
                for (int n = 0; n < 2; ++n) { const size_t base = ((size_t)((u.pm * 16 + 4 * u.pn + 2 * bj + n) * 4 + u.z) * 4) * 512 + tidx;
#pragma unroll
                    for (int ai = 0; ai < 2; ++ai)
#pragma unroll
                        for (int mp = 0; mp < 2; ++mp) { const f32x4 a0 = acc[ai][bj][2 * mp][n], a1 = acc[ai][bj][2 * mp + 1][n];
                            u32x4 w; w.x = cvt_pk_bf16(a0[0], a0[1]); w.y = cvt_pk_bf16(a0[2], a0[3]); w.z = cvt_pk_bf16(a1[0], a1[1]); w.w = cvt_pk_bf16(a1[2], a1[3]);
                            Yp[base + (size_t)(ai * 2 + mp) * 512] = w; } }
            return;
        }
        if (mode == 5) {
            const int row0 = u.pm * BM + wr * 64 + fr; const int col = u.pn * 64 + wc * 16 + 4 * fq;
            const int tidx = (wr * 4 + wc) * 64 + fq * 16 + fr; size_t yo_ = Y_OFF + ((size_t)(u.pm * 16 + u.pn) * 16) * 512 * 16; asm volatile("" : "+s"(yo_));
            const u32x4* Yp = (const u32x4*)((const unsigned char*)gates + yo_) + tidx;
#pragma unroll
            for (int ai = 0; ai < 2; ++ai)
#pragma unroll
                for (int mp = 0; mp < 2; ++mp) {
                    f32x4 tot[2]; tot[0] = (f32x4){0.f, 0.f, 0.f, 0.f}; tot[1] = tot[0];
                    const float sc0 = rs[row0 + ai * HALF + (2 * mp) * 16], sc1 = rs[row0 + ai * HALF + (2 * mp + 1) * 16];
#pragma unroll
                    for (int bj = 0; bj < 2; ++bj) { u32x4 yw[2];
#pragma unroll
                        for (int n = 0; n < 2; ++n) yw[n] = Yp[(size_t)((2 * bj + n) * 4 + ai * 2 + mp) * 512];
#pragma unroll
                        for (int n = 0; n < 2; ++n) { const int z = 2 * bj + n; const f32x4 bz = *(const f32x4*)(bias + z * 1024 + col);
#pragma unroll
                            for (int mm = 0; mm < 2; ++mm) { const int m = 2 * mp + mm; const f32x4 v = acc[ai][bj][m][n] * (mm ? sc1 : sc0) + bz;
                                const unsigned y01 = mm ? yw[n].z : yw[n].x, y23 = mm ? yw[n].w : yw[n].y;
                                tot[mm][0] += fast_sigmoid(v[0]) * bflo(y01); tot[mm][1] += fast_sigmoid(v[1]) * bfhi(y01); tot[mm][2] += fast_sigmoid(v[2]) * bflo(y23); tot[mm][3] += fast_sigmoid(v[3]) * bfhi(y23); } } }
#pragma unroll
                    for (int mm = 0; mm < 2; ++mm) { const int row = row0 + ai * HALF + (2 * mp + mm) * 16;
                        u32x2 w; w.x = cvt_pk_bf16(tot[mm][0], tot[mm][1]); w.y = cvt_pk_bf16(tot[mm][2], tot[mm][3]);
                        *(u32x2*)(O + (size_t)row * ldc + col) = w; } }
            return;
        }
        const int row0 = u.pm * BM + wr * 64 + fr; const int col0 = u.pn * BM + wc * 32 + 8 * fq + u.z * zs;
        const int m_eff = (mode == 1) ? ((u.pn == 2 || u.pn == 3) ? 1 : 0) : mode;
#pragma unroll
        for (int ai = 0; ai < 2; ++ai)
#pragma unroll
            for (int m = 0; m < 4; ++m) { const int row = row0 + ai * HALF + m * 16; bf16_t* rowp = O + (size_t)row * ldc + col0;
                const float sc = rs ? rs[row] : 1.0f;
#pragma unroll
                for (int bj = 0; bj < 2; ++bj) { f32x4 v0 = acc[ai][bj][m][0] * sc, v1 = acc[ai][bj][m][1] * sc;
                    if (m_eff == 1) {
#pragma unroll
                        for (int e = 0; e < 4; ++e) { v0[e] = gelu_tanh(v0[e]); v1[e] = gelu_tanh(v1[e]); }
                    } else if (m_eff == 3) {
#pragma unroll
                        for (int e = 0; e < 4; ++e) { const float a = fmaxf(v0[e], 0.f), b = fmaxf(v1[e], 0.f); v0[e] = a * a; v1[e] = b * b; }
                    }
                    u32x4 w; w.x = cvt_pk_bf16(v0[0], v0[1]); w.y = cvt_pk_bf16(v0[2], v0[3]); w.z = cvt_pk_bf16(v1[0], v1[1]); w.w = cvt_pk_bf16(v1[2], v1[3]);
                    *(u32x4*)(rowp + bj * HALF) = w; } }
    }
};

template <class Epi, class Sched, bool ALIGN_EPI = false, bool SP2 = false>
__device__ __forceinline__ void gemm_phase(PG8_LAS unsigned char* lds, const Gemm g, const Sched& S, const Epi& E, const int tid) {
    const int wid = __builtin_amdgcn_readfirstlane(tid >> 6), lane = tid & 63, wr = wid >> 2, wc = wid & 3, fr = lane & 15, fq = lane >> 4;
    const int K = g.K, nt = K / BK;
    unsigned voffA[2], voffB[2];
#pragma unroll
    for (int i = 0; i < 2; ++i) { int R, C; stage_rc(tid * 16 + i * 8192, R, C); const int Rb = g.bmode == 1 ? (((R >> 4) & 1) * 1024 + (R >> 5) * 16 + (R & 15)) : g.bmode == 2 ? (((R >> 4) & 1) * 64 + (R >> 5) * 16 + (R & 15)) : ((R & ~31) + perm32(R & 31));
        voffA[i] = (unsigned)(R * g.lda + C) * 2u; voffB[i] = (unsigned)(Rb * g.ldb + C) * 2u; }
    const size_t kstep = (size_t)(BK * 2);
    const size_t hstepA = (size_t)HALF * g.lda * 2, hstepB = (size_t)(g.bmode == 1 ? 2048 : HALF) * g.ldb * 2;
    const size_t tstepA = 2 * hstepA, tstepB = (size_t)(g.bmode == 1 ? 64 : 256) * g.ldb * 2;
    const unsigned ldsw = (unsigned)wid * 1024u;
    const int aoff = lds_byte(wr * 64 + fr, fq * 8), boff = lds_byte(wc * 32 + fr, fq * 8);
#define PG8_SA(b, h) (((b) * 2 + (h)) * HTB)
#define PG8_SB(b, h) ((4 + (b) * 2 + (h)) * HTB)
#define PG8_STAGE(bufoff, gbase, voff) do { _Pragma("unroll") for (int _i = 0; _i < 2; ++_i) \
        __builtin_amdgcn_global_load_lds((const unsigned*)((const char*)(gbase) + (voff)[_i]), (PG8_LAS unsigned*)(lds + (bufoff) + ldsw + _i * 8192), 16, 0, 0); } while (0)
#define PG8_LDA(dst, b, h) do { _Pragma("unroll") for (int m = 0; m < 4; ++m) _Pragma("unroll") for (int k = 0; k < 2; ++k) dst[m][k] = *(const PG8_LAS bf16x8*)(lds + PG8_SA(b, h) + aoff + m * 2048 + k * 1024); } while (0)
#define PG8_LDB(dst, b, h) do { _Pragma("unroll") for (int n = 0; n < 2; ++n) _Pragma("unroll") for (int k = 0; k < 2; ++k) dst[n][k] = *(const PG8_LAS bf16x8*)(lds + PG8_SB(b, h) + boff + n * 2048 + k * 1024); } while (0)
#define PG8_MMA(ai, bj, At, Bt) do { __builtin_amdgcn_s_setprio(1); _Pragma("unroll") for (int m = 0; m < 4; ++m) _Pragma("unroll") for (int n = 0; n < 2; ++n) _Pragma("unroll") for (int k = 0; k < 2; ++k) \
        acc[ai][bj][m][n] = __builtin_amdgcn_mfma_f32_16x16x32_bf16(Bt[n][k], At[m][k], acc[ai][bj][m][n], 0, 0, 0); __builtin_amdgcn_s_setprio(0); } while (0)
#define PG8_WAIT_V(n) asm volatile("s_waitcnt vmcnt(" #n ")" ::: "memory")
#define PG8_WAIT_L(n) asm volatile("s_waitcnt lgkmcnt(" #n ")" ::: "memory")
#define PG8_BAR __builtin_amdgcn_s_barrier()
#define PG8_SCHED __builtin_amdgcn_sched_barrier(0)
    Unit cur, nxt; int ui = 0;
    if (!S.next(0, cur)) return;
    f32x4 acc[2][2][4][2];
#pragma unroll
    for (int a = 0; a < 2; ++a)
#pragma unroll
        for (int b = 0; b < 2; ++b)
#pragma unroll
            for (int m = 0; m < 4; ++m)
#pragma unroll
                for (int n = 0; n < 2; ++n) acc[a][b][m][n] = (f32x4){0.f, 0.f, 0.f, 0.f};
    bf16x8 At[4][2], B0[2][2], B1[2][2];
    const char* cA = (const char*)g.A + (size_t)cur.pm * tstepA + (size_t)cur.ak * 2; const char* cB = (const char*)g.Bt + (size_t)cur.bn * tstepB;
    S.a_ready(cur);
    if constexpr (SP2) {
        PG8_STAGE(PG8_SB(0, 0), cB, voffB); PG8_STAGE(PG8_SB(0, 1), cB + hstepB, voffB); PG8_STAGE(PG8_SA(0, 0), cA, voffA); PG8_STAGE(PG8_SA(0, 1), cA + hstepA, voffA);
        if (wr == 1) PG8_BAR;
        PG8_WAIT_V(2); PG8_BAR;
        PG8_STAGE(PG8_SB(1, 0), cB + kstep, voffB); PG8_STAGE(PG8_SA(1, 0), cA + kstep, voffA); PG8_STAGE(PG8_SB(1, 1), cB + hstepB + kstep, voffB);
        PG8_WAIT_V(6); PG8_BAR;
    } else {
        PG8_STAGE(PG8_SB(0, 0), cB, voffB); PG8_STAGE(PG8_SA(0, 0), cA, voffA); PG8_STAGE(PG8_SB(0, 1), cB + hstepB, voffB); PG8_STAGE(PG8_SA(0, 1), cA + hstepA, voffA);
        if (wr == 1) PG8_BAR;
        PG8_WAIT_V(4); PG8_BAR;
        PG8_STAGE(PG8_SB(1, 0), cB + kstep, voffB); PG8_STAGE(PG8_SA(1, 0), cA + kstep, voffA); PG8_STAGE(PG8_SB(1, 1), cB + hstepB + kstep, voffB);
        PG8_WAIT_V(6); PG8_BAR;
    }
    for (;;) {
        const bool has_next = S.next(ui + 1, nxt);
        const char* nA = has_next ? (const char*)g.A + (size_t)nxt.pm * tstepA + (size_t)nxt.ak * 2 : cA; const char* nB = has_next ? (const char*)g.Bt + (size_t)nxt.bn * tstepB : cB;
        for (int t = 0; t < nt; t += 2) {
            const bool last = (t == nt - 2);
            const char* a1 = cA + (size_t)(t + 1) * kstep;
            const char* a2 = last ? nA : cA + (size_t)(t + 2) * kstep; const char* b2 = last ? nB : cB + (size_t)(t + 2) * kstep;
            const char* a3 = a2 + kstep; const char* b3 = b2 + kstep;
            if (last && has_next) S.a_ready(nxt);
            if constexpr (SP2) {
            PG8_LDB(B0, 0, 0); PG8_LDB(B1, 0, 1); PG8_SCHED; PG8_LDA(At, 0, 0); PG8_STAGE(PG8_SA(1, 1), a1 + hstepA, voffA);
            PG8_WAIT_V(8); PG8_WAIT_L(0); PG8_BAR; PG8_MMA(0, 0, At, B0); PG8_MMA(0, 1, At, B1); PG8_BAR; PG8_SCHED;
            PG8_LDA(At, 0, 1); PG8_STAGE(PG8_SB(0, 0), b2, voffB); PG8_STAGE(PG8_SB(0, 1), b2 + hstepB, voffB); PG8_STAGE(PG8_SA(0, 0), a2, voffA);
            PG8_WAIT_V(8); PG8_WAIT_L(0); PG8_BAR; PG8_MMA(1, 0, At, B0); PG8_MMA(1, 1, At, B1); PG8_BAR; PG8_SCHED;
            PG8_LDB(B0, 1, 0); PG8_LDB(B1, 1, 1); PG8_SCHED; PG8_LDA(At, 1, 0); PG8_STAGE(PG8_SA(0, 1), a2 + hstepA, voffA);
            PG8_WAIT_V(8); PG8_WAIT_L(0); PG8_BAR; PG8_MMA(0, 0, At, B0); PG8_MMA(0, 1, At, B1); PG8_BAR; PG8_SCHED;
            PG8_LDA(At, 1, 1); PG8_STAGE(PG8_SB(1, 0), b3, voffB); PG8_STAGE(PG8_SB(1, 1), b3 + hstepB, voffB); PG8_STAGE(PG8_SA(1, 0), a3, voffA);
            PG8_WAIT_V(8); PG8_WAIT_L(0); PG8_BAR; PG8_MMA(1, 0, At, B0); PG8_MMA(1, 1, At, B1); PG8_BAR; PG8_SCHED;
            } else {
            PG8_LDB(B0, 0, 0); PG8_SCHED; PG8_LDA(At, 0, 0); PG8_STAGE(PG8_SA(1, 1), a1 + hstepA, voffA);
            PG8_WAIT_L(8); PG8_BAR; PG8_WAIT_L(0); PG8_MMA(0, 0, At, B0); PG8_BAR; PG8_SCHED;
            PG8_LDB(B1, 0, 1); PG8_STAGE(PG8_SB(0, 0), b2, voffB);
            PG8_BAR; PG8_WAIT_L(0); PG8_MMA(0, 1, At, B1); PG8_BAR;
            PG8_LDA(At, 0, 1); PG8_STAGE(PG8_SA(0, 0), a2, voffA);
            PG8_BAR; PG8_WAIT_L(0); PG8_MMA(1, 0, At, B0); PG8_BAR; PG8_SCHED;
            PG8_STAGE(PG8_SB(0, 1), b2 + hstepB, voffB);
            PG8_WAIT_V(6); PG8_BAR; PG8_MMA(1, 1, At, B1); PG8_BAR;
            PG8_LDB(B0, 1, 0); PG8_SCHED; PG8_LDA(At, 1, 0); PG8_STAGE(PG8_SA(0, 1), a2 + hstepA, voffA);
            PG8_WAIT_L(8); PG8_BAR; PG8_WAIT_L(0); PG8_MMA(0, 0, At, B0); PG8_BAR; PG8_SCHED;
            PG8_LDB(B1, 1, 1); PG8_STAGE(PG8_SB(1, 0), b3, voffB);
            PG8_BAR; PG8_WAIT_L(0); PG8_MMA(0, 1, At, B1); PG8_BAR;
            PG8_LDA(At, 1, 1); PG8_STAGE(PG8_SA(1, 0), a3, voffA);
            PG8_BAR; PG8_WAIT_L(0); PG8_MMA(1, 0, At, B0); PG8_BAR; PG8_SCHED;
            PG8_STAGE(PG8_SB(1, 1), b3 + hstepB, voffB);
            PG8_WAIT_V(6); PG8_BAR; PG8_MMA(1, 1, At, B1); PG8_BAR;
            }
        }
        if constexpr (ALIGN_EPI) { if (wr == 0) PG8_BAR; }
        if constexpr (!Epi::AFTER_DRAIN) { E(acc, cur, wr, wc, fr, fq); S.done(cur); }
        if (!has_next) break;
#pragma unroll
        for (int a = 0; a < 2; ++a)
#pragma unroll
            for (int b = 0; b < 2; ++b)
#pragma unroll
                for (int m = 0; m < 4; ++m)
#pragma unroll
                    for (int n = 0; n < 2; ++n) acc[a][b][m][n] = (f32x4){0.f, 0.f, 0.f, 0.f};
        cur = nxt; cA = nA; cB = nB; ++ui;
        if constexpr (ALIGN_EPI) { if (wr == 1) PG8_BAR; }
    }
    PG8_WAIT_V(0);
    if constexpr (!ALIGN_EPI) { if (wr == 0) PG8_BAR; }
    PG8_BAR;
    if constexpr (Epi::AFTER_DRAIN) { E.fused(acc, cur, wr, wc, fr, fq, lds, wid, lane); S.done(cur); }
#undef PG8_SA
#undef PG8_SB
#undef PG8_STAGE
#undef PG8_LDA
#undef PG8_LDB
#undef PG8_MMA
#undef PG8_WAIT_V
#undef PG8_WAIT_L
#undef PG8_BAR
#undef PG8_SCHED
}
}

constexpr int MTOK = 32768, DM = 1024, SEQ = 8192, NLAYER = 4, NIN = 6048, DFF = 4096;
constexpr float EPS = 1e-6f;
constexpr float QSCALE = 0.10206207261596575f * 1.4426950408889634f;
constexpr size_t MiB = 1u << 20;
constexpr size_t WS_RS = 1 * MiB, WS_ROPEC = 2 * MiB, WS_ROPES = 4 * MiB;
constexpr size_t WS_WIN = 6 * MiB, WS_WUQ = 18 * MiB, WS_WK = WS_WUQ + 256 * 1024, WS_WV = WS_WK + 64 * 1024, WS_SGW = WS_WUQ + 512 * 1024;
constexpr size_t WS_WBR = 19 * MiB, WS_WOUT = 21 * MiB, WS_W1 = 23 * MiB, WS_W2 = 31 * MiB;
constexpr size_t WS_XBF = 40 * MiB;
constexpr size_t WS_BR = 104 * MiB;
constexpr size_t WS_BIG = 168 * MiB;
constexpr size_t WS_PROJ = WS_BIG, WS_CQN = WS_BIG + 128 * MiB, WS_CKVN = WS_BIG + 144 * MiB, WS_KR = WS_BIG + 152 * MiB, WS_Q = WS_BIG + 154 * MiB, WS_KN = WS_BIG + 186 * MiB, WS_VT = WS_BIG + 202 * MiB;
constexpr size_t WS_END = 424 * MiB;
static_assert(WS_BIG == pg8::Y_OFF, "Y exchange offset");
constexpr int LDS_BYTES = 147456;

struct Args { const float* in[26]; float* out; unsigned char* ws; int lo, hi; };
enum { I_X = 0, I_POS, I_NPRE, I_WIN, I_GATEB, I_QN, I_WUQ, I_KVN, I_WUKV, I_WBRMLA, I_LNG, I_LNB, I_SGW, I_SGB, I_WBRSG, I_CONVW, I_WBRCONV, I_POOLW, I_POOLS, I_WBRPOOL, I_WOUT, I_NPOST, I_NFPRE, I_WFF1, I_WFF2, I_NFPOST };

typedef __bf16 bf16x2_t __attribute__((ext_vector_type(2)));
__device__ __forceinline__ unsigned cvtpk_v(float lo, float hi) { f32x2 v = {lo, hi}; bf16x2_t b = __builtin_convertvector(v, bf16x2_t); return __builtin_bit_cast(unsigned, b); }
__device__ __forceinline__ int crow(int r, int hi) { return (r & 3) + 8 * (r >> 2) + 4 * hi; }
#define MFMA32(a, b, c) __builtin_amdgcn_mfma_f32_32x32x16_bf16((a), (b), (c), 0, 0, 0)

__device__ __forceinline__ void tr_item(const float* __restrict__ W, int ldw, int k0, int srcn0, const float* __restrict__ gk, float mul, bf16_t* WT, int ldt, int dstn0, LAS float* scr, int lane) {
    float tv[32];
#pragma unroll
    for (int i = 0; i < 32; ++i) { const int kk = 2 * i + (lane >> 5); tv[i] = (srcn0 >= 0) ? W[(size_t)(k0 + kk) * ldw + srcn0 + (lane & 31)] : 0.f; }
    float gkv = mul; (void)gkv;
#pragma unroll
    for (int i = 0; i < 32; ++i) { const int kk = 2 * i + (lane >> 5); float v = tv[i] * mul; if (gk) v *= gk[k0 + kk]; scr[kk * 33 + (lane & 31)] = v; }
    asm volatile("s_waitcnt lgkmcnt(0)" ::: "memory");
    const int c = lane & 7;
#pragma unroll
    for (int j = 0; j < 4; ++j) { const int n = (lane >> 3) + 8 * j; const LAS float* s = scr + (8 * c) * 33 + n;
        u32x4 o; o.x = pk2(s[0 * 33], s[1 * 33]); o.y = pk2(s[2 * 33], s[3 * 33]); o.z = pk2(s[4 * 33], s[5 * 33]); o.w = pk2(s[6 * 33], s[7 * 33]);
        *(u32x4*)(WT + (size_t)(dstn0 + n) * ldt + k0 + 8 * c) = o; }
    asm volatile("s_waitcnt lgkmcnt(0)" ::: "memory");
}

__device__ __forceinline__ void prep_weights(const Args& a, unsigned char* wsl, int l, LAS unsigned char* lds, int tid) {
    const int lane = tid & 63, wave = tid >> 6, G = gridDim.x;
    LAS float* scr = (LAS float*)(lds + wave * 8448);
    const int gw = blockIdx.x * 8 + wave, NGW = G * 8;
    unsigned char* ws = wsl;
    constexpr int N0 = 16 * 192, N1 = 4 * 16, N2 = 2 * 8, N3 = 2 * 8, N4 = 3 * 4 * 32, N5 = 16 * 32, N6 = 16 * 128, N7 = 64 * 32;
    constexpr int NITEMS = N0 + N1 + N2 + N3 + N4 + N5 + N6 + N7;
    for (int it = gw; it < NITEMS; it += NGW) {
        int r = it;
        if (r < N0) { const int kb = r / 192, nb = r % 192, d0 = nb * 32; const int src = d0 < 416 ? d0 : (d0 < 512 ? -1 : d0 - 96);
            tr_item(a.in[I_WIN] + (size_t)l * DM * NIN, NIN, kb * 64, src, a.in[I_NPRE] + l * DM, 1.f, (bf16_t*)(ws + WS_WIN), DM, d0, scr, lane); continue; } r -= N0;
        if (r < N1) { const int kb = r / 16, nb = r % 16;
            tr_item(a.in[I_WUQ] + (size_t)l * 256 * 384, 384, kb * 64, nb < 12 ? nb * 32 : -1, a.in[I_QN] + l * 256, QSCALE, (bf16_t*)(ws + WS_WUQ), 256, nb * 32, scr, lane); continue; } r -= N1;
        if (r < N2) { const int kb = r / 8, nb = r % 8;
            tr_item(a.in[I_WUKV] + (size_t)l * 128 * 512, 512, kb * 64, (nb >> 1) * 128 + (nb & 1) * 32, a.in[I_KVN] + l * 128, 1.f, (bf16_t*)(ws + WS_WK), 128, nb * 32, scr, lane); continue; } r -= N2;
        if (r < N3) { const int kb = r / 8, nb = r % 8;
            tr_item(a.in[I_WUKV] + (size_t)l * 128 * 512, 512, kb * 64, (nb >> 1) * 128 + 64 + (nb & 1) * 32, a.in[I_KVN] + l * 128, 1.f, (bf16_t*)(ws + WS_WV), 128, nb * 32, scr, lane); continue; } r -= N3;
        if (r < N4) { const int z = r / 128, rr = r % 128, kb = rr / 32, nb = rr % 32; const float* W = (z == 0 ? a.in[I_WBRMLA] : z == 1 ? a.in[I_WBRSG] : a.in[I_WBRCONV]) + (size_t)l * 256 * DM;
            tr_item(W, DM, kb * 64, nb * 32, nullptr, 1.f, (bf16_t*)(ws + WS_WBR) + (size_t)z * DM * 256, 256, nb * 32, scr, lane); continue; } r -= N4;
        if (r < N5) { const int kb = r / 32, nb = r % 32;
            tr_item(a.in[I_WOUT] + (size_t)l * DM * DM, DM, kb * 64, nb * 32, nullptr, 1.f, (bf16_t*)(ws + WS_WOUT), DM, nb * 32, scr, lane); continue; } r -= N5;
        if (r < N6) { const int kb = r / 128, nb = r % 128;
            tr_item(a.in[I_WFF1] + (size_t)l * DM * DFF, DFF, kb * 64, nb * 32, a.in[I_NFPRE] + l * DM, 1.f, (bf16_t*)(ws + WS_W1), DM, nb * 32, scr, lane); continue; } r -= N6;
        { const int kb = r / 32, nb = r % 32;
            tr_item(a.in[I_WFF2] + (size_t)l * DFF * DM, DM, kb * 64, nb * 32, nullptr, 1.f, (bf16_t*)(ws + WS_W2), DFF, nb * 32, scr, lane); }
    }
    const int gt = blockIdx.x * 512 + tid, NGT = G * 512;
    { const float* sw = a.in[I_SGW] + (size_t)l * 65536; bf16_t* o = (bf16_t*)(ws + WS_SGW);
      for (int i = gt; i < 65536; i += NGT) { const int t = (i >> 7) & 127, s = i & 127; o[i] = (bf16_t)f2bf(s <= t ? sw[i] : 0.f); } }
    { const float* wp = a.in[I_POOLW] + (size_t)l * 4 * 64 * 64; const float* sc = a.in[I_POOLS] + l * 256; const float* wb = a.in[I_WBRPOOL] + (size_t)l * 256 * DM;
      bf16_t* o = (bf16_t*)(ws + WS_WBR) + (size_t)3 * DM * 256;
      for (int i = gt; i < 256 * DM; i += NGT) { const int n = i & 1023, cp = i >> 10, g = cp >> 6, c = cp & 63; float acc = 0.f;
          for (int d = 0; d < 64; ++d) acc += wp[(g * 64 + c) * 64 + d] * sc[g * 64 + d] * wb[(size_t)(g * 64 + d) * DM + n];
          o[(size_t)n * 256 + cp] = (bf16_t)f2bf(acc); } }
}

__device__ __forceinline__ void phase_s0(const Args& a, unsigned char* wsl, LAS unsigned char* lds, int tid) {
    const int G = gridDim.x, gt = blockIdx.x * 512 + tid, NGT = G * 512;
    const int* pos = (const int*)a.in[I_POS];
    float* rc = (float*)(wsl + WS_ROPEC); float* rsn = (float*)(wsl + WS_ROPES);
    for (int i = gt; i < MTOK * 16; i += NGT) { const int tok = i & (MTOK - 1); const int k = __builtin_amdgcn_readfirstlane(i >> 15);
        const unsigned chi = (k == 0 ? 0x3fc45f30u : (k == 1 ? 0x3fb6e96eu : (k == 2 ? 0x3fa9c4c0u : (k == 3 ? 0x3f9cfb40u : (k == 4 ? 0x3f904c26u : (k == 5 ? 0x3f825458u : (k == 6 ? 0x3f749d66u : (k == 7 ? 0x3f672f66u : (k == 8 ? 0x3f5a1371u : (k == 9 ? 0x3f4d53c1u : (k == 10 ? 0x3f407debu : (k == 11 ? 0x3f328c52u : (k == 12 ? 0x3f24dc5au : (k == 13 ? 0x3f177634u : (k == 14 ? 0x3f0a6312u : (k == 15 ? 0x3efdad50u : 0u))))))))))))))));
        const unsigned clo = (k == 0 ? 0x6dc9c883u : (k == 1 ? 0xcaebf83fu : (k == 2 ? 0x200b604fu : (k == 3 ? 0x35fd7496u : (k == 4 ? 0xbe3b06cfu : (k == 5 ? 0xa2566033u : (k == 6 ? 0x800919d9u : (k == 7 ? 0x91979078u : (k == 8 ? 0x305e714cu : (k == 9 ? 0x03bd66b8u : (k == 10 ? 0x99a0e17au : (k == 11 ? 0x0e12d9f9u : (k == 12 ? 0x8d185aa3u : (k == 13 ? 0x02fdebc6u : (k == 14 ? 0x8f67cf2au : (k == 15 ? 0x16848ff5u : 0u))))))))))))))));
        const double cf = __hiloint2double((int)chi, (int)clo);
        const double rev = (double)pos[tok] * cf;
        const float fr = (float)(rev - __builtin_rint(rev));
        rc[tok * 16 + k] = __builtin_amdgcn_cosf(fr); rsn[tok * 16 + k] = __builtin_amdgcn_sinf(fr); }
    const int lane = tid & 63, wave = tid >> 6, gw = blockIdx.x * 8 + wave, NGW = G * 8;
    const float* x = a.in[I_X]; float* xo = a.out; bf16_t* xb = (bf16_t*)(wsl + WS_XBF); float* rs = (float*)(wsl + WS_RS);
    for (int row = gw; row < MTOK; row += NGW) {
        const float* xr = x + (size_t)row * DM + 8 * lane; bf16_t* bw = xb + (size_t)row * DM + 8 * lane;
        float ss = 0.f;
#pragma unroll
        for (int j = 0; j < 2; ++j) { const f32x4 v0 = *(const f32x4*)(xr + 512 * j), v1 = *(const f32x4*)(xr + 512 * j + 4);
            ss += v0.x * v0.x + v0.y * v0.y + v0.z * v0.z + v0.w * v0.w + v1.x * v1.x + v1.y * v1.y + v1.z * v1.z + v1.w * v1.w;
            u32x4 o; o.x = pk2(v0.x, v0.y); o.y = pk2(v0.z, v0.w); o.z = pk2(v1.x, v1.y); o.w = pk2(v1.z, v1.w); *(u32x4*)(bw + 512 * j) = o; }
        ss = wave_sum(ss);
        if (lane == 0) rs[row] = 1.0f / sqrtf(ss * (1.0f / DM) + EPS);
    }
}

__device__ __forceinline__ void phase_nr(const Args& a, unsigned char* wsl, const float* gpost, size_t ysrc, bool final_out, int tid) {
    const int G = gridDim.x, lane = tid & 63, wave = tid >> 6, gw = blockIdx.x * 8 + wave, NGW = G * 8;
    float* xo = a.out; bf16_t* xb = (bf16_t*)(wsl + WS_XBF); float* rs = (float*)(wsl + WS_RS); const bf16_t* y = (const bf16_t*)(wsl + ysrc);
    f32x4 gv[4];
#pragma unroll
    for (int j = 0; j < 2; ++j) { gv[2 * j] = *(const f32x4*)(gpost + 8 * lane + 512 * j); gv[2 * j + 1] = *(const f32x4*)(gpost + 8 * lane + 512 * j + 4); }
    constexpr int NR = 4;
    for (int grp = gw; grp < MTOK / NR; grp += NGW) {
        u32x4 yw[NR][2], xw[NR][2];
#pragma unroll
        for (int r = 0; r < NR; ++r) { const size_t off = (size_t)(grp * NR + r) * DM + 8 * lane;
#pragma unroll
            for (int j = 0; j < 2; ++j) { yw[r][j] = *(const u32x4*)(y + off + 512 * j); xw[r][j] = *(const u32x4*)(xb + off + 512 * j); } }
        float ss[NR];
#pragma unroll
        for (int r = 0; r < NR; ++r) { float s_ = 0.f;
#pragma unroll
            for (int j = 0; j < 2; ++j) { const u32x4 w = yw[r][j]; const float e0 = bflo(w.x), e1 = bfhi(w.x), e2 = bflo(w.y), e3 = bfhi(w.y), e4 = bflo(w.z), e5 = bfhi(w.z), e6 = bflo(w.w), e7 = bfhi(w.w);
                s_ += e0 * e0 + e1 * e1 + e2 * e2 + e3 * e3 + e4 * e4 + e5 * e5 + e6 * e6 + e7 * e7; }
            ss[r] = s_; }
#pragma unroll
        for (int o = 1; o < 64; o <<= 1) {
#pragma unroll
            for (int r = 0; r < NR; ++r) ss[r] += __shfl_xor(ss[r], o); }
        float xs[NR];
#pragma unroll
        for (int r = 0; r < NR; ++r) { const float ry = 1.0f / sqrtf(ss[r] * (1.0f / DM) + EPS); float s_ = 0.f; const size_t off = (size_t)(grp * NR + r) * DM + 8 * lane;
#pragma unroll
            for (int j = 0; j < 2; ++j) { const u32x4 w = yw[r][j]; const u32x4 xx = xw[r][j]; f32x4 a0, a1;
                a0[0] = bflo(xx.x) + bflo(w.x) * ry * gv[2 * j][0]; a0[1] = bfhi(xx.x) + bfhi(w.x) * ry * gv[2 * j][1]; a0[2] = bflo(xx.y) + bflo(w.y) * ry * gv[2 * j][2]; a0[3] = bfhi(xx.y) + bfhi(w.y) * ry * gv[2 * j][3];
                a1[0] = bflo(xx.z) + bflo(w.z) * ry * gv[2 * j + 1][0]; a1[1] = bfhi(xx.z) + bfhi(w.z) * ry * gv[2 * j + 1][1]; a1[2] = bflo(xx.w) + bflo(w.w) * ry * gv[2 * j + 1][2]; a1[3] = bfhi(xx.w) + bfhi(w.w) * ry * gv[2 * j + 1][3];
                if (final_out) { *(f32x4*)(xo + off + 512 * j) = a0; *(f32x4*)(xo + off + 512 * j + 4) = a1; }
                else { u32x4 o; o.x = pk2(a0[0], a0[1]); o.y = pk2(a0[2], a0[3]); o.z = pk2(a1[0], a1[1]); o.w = pk2(a1[2], a1[3]); *(u32x4*)(xb + off + 512 * j) = o;
                    const float b0 = bflo(o.x), b1 = bfhi(o.x), b2 = bflo(o.y), b3 = bfhi(o.y), b4 = bflo(o.z), b5 = bfhi(o.z), b6 = bflo(o.w), b7 = bfhi(o.w);
                    s_ += b0 * b0 + b1 * b1 + b2 * b2 + b3 * b3 + b4 * b4 + b5 * b5 + b6 * b6 + b7 * b7; } }
            xs[r] = s_; }
        if (!final_out) {
#pragma unroll
            for (int o = 1; o < 64; o <<= 1) {
#pragma unroll
                for (int r = 0; r < NR; ++r) xs[r] += __shfl_xor(xs[r], o); }
            if (lane == 0) {
#pragma unroll
                for (int r = 0; r < NR; ++r) rs[grp * NR + r] = 1.0f / sqrtf(xs[r] * (1.0f / DM) + EPS); } }
    }
}

__device__ __forceinline__ void unpack8(const u32x4 w, float (&f)[8]) { f[0] = bflo(w.x); f[1] = bfhi(w.x); f[2] = bflo(w.y); f[3] = bfhi(w.y); f[4] = bflo(w.z); f[5] = bfhi(w.z); f[6] = bflo(w.w); f[7] = bfhi(w.w); }
__device__ __forceinline__ u32x4 pack8(const float (&f)[8]) { u32x4 o; o.x = pk2(f[0], f[1]); o.y = pk2(f[2], f[3]); o.z = pk2(f[4], f[5]); o.w = pk2(f[6], f[7]); return o; }

__device__ __forceinline__ void phase_e1(const Args& a, unsigned char* wsl, int l, LAS unsigned char* lds, int tid) {
    const int lane = tid & 63, wid = __builtin_amdgcn_readfirstlane(tid >> 6), r32 = lane & 31, hi = lane >> 5;
    unsigned char* ws = wsl;
    const bf16_t* P = (const bf16_t*)(ws + WS_PROJ); bf16_t* CQN = (bf16_t*)(ws + WS_CQN); bf16_t* CKVN = (bf16_t*)(ws + WS_CKVN); bf16_t* KR = (bf16_t*)(ws + WS_KR);
    bf16_t* BR = (bf16_t*)(ws + WS_BR); const float* rc = (const float*)(ws + WS_ROPEC); const float* rsn = (const float*)(ws + WS_ROPES);
    const bf16_t* SGWB = (const bf16_t*)(ws + WS_SGW);
    const float* convw = a.in[I_CONVW] + l * 3 * 256; const float* lng = a.in[I_LNG] + l * 256; const float* lnb = a.in[I_LNB] + l * 256; const float* sgb = a.in[I_SGB] + l * 512;
    for (int tile = blockIdx.x; tile < MTOK / 128; tile += gridDim.x) {
        const int R0 = tile * 128, s0 = R0 & (SEQ - 1);
        { const int rsub = lane >> 4, li = lane & 15;
#pragma unroll
          for (int it2 = 0; it2 < 2; ++it2) {
              u32x4 cqa[2], cqb[2], ckv[2]; float x1[2], x2[2], cc[2], ss[2];
#pragma unroll
              for (int u = 0; u < 2; ++u) { const int row = R0 + wid * 16 + (it2 * 2 + u) * 4 + rsub; const bf16_t* pr = P + (size_t)row * 2048;
                  cqa[u] = *(const u32x4*)(pr + 8 * li); cqb[u] = *(const u32x4*)(pr + 128 + 8 * li); ckv[u] = *(const u32x4*)(pr + 256 + 8 * li);
                  x1[u] = bf2f(pr[384 + li]); x2[u] = bf2f(pr[400 + li]); cc[u] = rc[(size_t)row * 16 + li]; ss[u] = rsn[(size_t)row * 16 + li]; }
#pragma unroll
              for (int u = 0; u < 2; ++u) { const int row = R0 + wid * 16 + (it2 * 2 + u) * 4 + rsub;
                  float qa[8], qb[8], kv[8]; unpack8(cqa[u], qa); unpack8(cqb[u], qb); unpack8(ckv[u], kv);
                  float sq = 0.f, sk = 0.f;
#pragma unroll
                  for (int e = 0; e < 8; ++e) { sq += qa[e] * qa[e] + qb[e] * qb[e]; sk += kv[e] * kv[e]; }
#pragma unroll
                  for (int o = 1; o < 16; o <<= 1) { sq += __shfl_xor(sq, o); sk += __shfl_xor(sk, o); }
                  const float rq = 1.0f / sqrtf(sq * (1.0f / 256.0f) + EPS), rk = 1.0f / sqrtf(sk * (1.0f / 128.0f) + EPS);
#pragma unroll
                  for (int e = 0; e < 8; ++e) { qa[e] *= rq; qb[e] *= rq; kv[e] *= rk; }
                  *(u32x4*)(CQN + (size_t)row * 256 + 8 * li) = pack8(qa); *(u32x4*)(CQN + (size_t)row * 256 + 128 + 8 * li) = pack8(qb);
                  *(u32x4*)(CKVN + (size_t)row * 128 + 8 * li) = pack8(kv);
                  KR[(size_t)row * 32 + li] = (bf16_t)f2bf(x1[u] * cc[u] - x2[u] * ss[u]); KR[(size_t)row * 32 + 16 + li] = (bf16_t)f2bf(x2[u] * cc[u] + x1[u] * ss[u]); } } }
        { const int ch = tid & 31, run = tid >> 5, t0 = run * 8; const bf16_t* pb = P + (size_t)(R0 + t0) * 2048 + 8 * ch; const int sb = s0 + t0;
          { float w0[8], w1[8], w2[8];
#pragma unroll
            for (int e = 0; e < 8; ++e) { w0[e] = convw[8 * ch + e]; w1[e] = convw[256 + 8 * ch + e]; w2[e] = convw[512 + 8 * ch + e]; }
            float zm2[8], zm1[8];
#pragma unroll
            for (int e = 0; e < 8; ++e) { zm2[e] = 0.f; zm1[e] = 0.f; }
            if (sb >= 2) { float xv[8], cv[8]; unpack8(*(const u32x4*)(pb - 2 * 2048 + 1024), xv); unpack8(*(const u32x4*)(pb - 2 * 2048 + 1536), cv);
#pragma unroll
                for (int e = 0; e < 8; ++e) zm2[e] = xv[e] * cv[e]; }
            if (sb >= 1) { float xv[8], cv[8]; unpack8(*(const u32x4*)(pb - 2048 + 1024), xv); unpack8(*(const u32x4*)(pb - 2048 + 1536), cv);
#pragma unroll
                for (int e = 0; e < 8; ++e) zm1[e] = xv[e] * cv[e]; }
#pragma unroll
            for (int half = 0; half < 2; ++half) { u32x4 lx[4], lc[4], lb[4];
#pragma unroll
                for (int j = 0; j < 4; ++j) { const bf16_t* pr = pb + (size_t)(half * 4 + j) * 2048; lx[j] = *(const u32x4*)(pr + 1024); lc[j] = *(const u32x4*)(pr + 1536); lb[j] = *(const u32x4*)(pr + 1280); }
#pragma unroll
                for (int j = 0; j < 4; ++j) { float xv[8], cv[8], bg[8], y[8]; unpack8(lx[j], xv); unpack8(lc[j], cv); unpack8(lb[j], bg);
#pragma unroll
                    for (int e = 0; e < 8; ++e) { const float z = xv[e] * cv[e]; y[e] = bg[e] * (w0[e] * zm2[e] + w1[e] * zm1[e] + w2[e] * z); zm2[e] = zm1[e]; zm1[e] = z; }
                    *(u32x4*)(BR + (size_t)(R0 + t0 + half * 4 + j) * DM + 512 + 8 * ch) = pack8(y); } } }
          { const int g = ch >> 3, win = 2 << g; float S[8];
#pragma unroll
            for (int e = 0; e < 8; ++e) S[e] = 0.f;
            for (int i = 1; i < win; ++i) { if (sb - i >= 0) { float pv[8]; unpack8(*(const u32x4*)(pb - (size_t)i * 2048 + 1792), pv);
#pragma unroll
                    for (int e = 0; e < 8; ++e) S[e] += pv[e]; } }
#pragma unroll
            for (int half = 0; half < 2; ++half) { u32x4 lp[4], lo[4];
#pragma unroll
                for (int j = 0; j < 4; ++j) { const int t = half * 4 + j; lp[j] = *(const u32x4*)(pb + (size_t)t * 2048 + 1792);
                    const int back = t - win + 1; lo[j] = (sb + back >= 0) ? *(const u32x4*)(pb + (ptrdiff_t)back * 2048 + 1792) : (u32x4){0u, 0u, 0u, 0u}; }
#pragma unroll
                for (int j = 0; j < 4; ++j) { const int t = half * 4 + j; float pt[8], po[8], o[8]; unpack8(lp[j], pt); unpack8(lo[j], po);
                    const int s = sb + t; const int cnt = (s + 1) < win ? (s + 1) : win; const float ic = 1.0f / (float)cnt;
#pragma unroll
                    for (int e = 0; e < 8; ++e) { S[e] += pt[e]; o[e] = S[e] * ic - pt[e]; S[e] -= po[e]; }
                    *(u32x4*)(BR + (size_t)(R0 + t0 + t) * DM + 768 + 8 * ch) = pack8(o); } } } }
        { const int srow = tid >> 2, qt = tid & 3; const bf16_t* vp = P + (size_t)(R0 + srow) * 2048 + 768 + qt * 64;
          float v[64]; float sum = 0.f;
#pragma unroll
          for (int j = 0; j < 8; ++j) { const u32x4 w = *(const u32x4*)(vp + 8 * j);
              v[8 * j + 0] = bflo(w.x); v[8 * j + 1] = bfhi(w.x); v[8 * j + 2] = bflo(w.y); v[8 * j + 3] = bfhi(w.y); v[8 * j + 4] = bflo(w.z); v[8 * j + 5] = bfhi(w.z); v[8 * j + 6] = bflo(w.w); v[8 * j + 7] = bfhi(w.w); }
#pragma unroll
          for (int j = 0; j < 64; ++j) sum += v[j];
          sum += __shfl_xor(sum, 1); sum += __shfl_xor(sum, 2);
          const float mean = sum * (1.0f / 256.0f); float var = 0.f;
#pragma unroll
          for (int j = 0; j < 64; ++j) { v[j] -= mean; var += v[j] * v[j]; }
          var += __shfl_xor(var, 1); var += __shfl_xor(var, 2);
          const float rstd = 1.0f / sqrtf(var * (1.0f / 256.0f) + EPS);
          LAS bf16_t* vT = (LAS bf16_t*)lds;
#pragma unroll
          for (int j = 0; j < 64; ++j) { const int c = qt * 64 + j; vT[c * 136 + srow] = (bf16_t)f2bf(v[j] * rstd * lng[c] + lnb[c]); } }
        __syncthreads();
        { const int g = wid >> 1, th = wid & 1;
#pragma unroll
          for (int tb = 0; tb < 2; ++tb) {
              const int nks = (64 * th + 32 * tb + 32) >> 4;
              const bf16_t* ap = SGWB + (size_t)(g * 128 + 64 * th + 32 * tb + r32) * 128 + 8 * hi;
              bf16x8 Af[8];
#pragma unroll
              for (int ks = 0; ks < 8; ++ks) Af[ks] = (ks < nks) ? *(const bf16x8*)(ap + 16 * ks) : (bf16x8){0, 0, 0, 0, 0, 0, 0, 0};
              float bsv[16];
#pragma unroll
              for (int r = 0; r < 16; ++r) bsv[r] = sgb[g * 128 + 64 * th + 32 * tb + crow(r, hi)];
#pragma unroll
              for (int cb = 0; cb < 2; ++cb) { f32x16 acc;
#pragma unroll
                  for (int r = 0; r < 16; ++r) acc[r] = 0.f;
                  const LAS unsigned char* bp = lds + (g * 64 + 32 * cb + r32) * 272 + 16 * hi;
                  const int c = g * 64 + 32 * cb + r32;
                  float uv[16];
#pragma unroll
                  for (int r = 0; r < 16; ++r) uv[r] = bf2f(P[(size_t)(R0 + 64 * th + 32 * tb + crow(r, hi)) * 2048 + 512 + c]);
#pragma unroll
                  for (int ks = 0; ks < 8; ++ks) { if (ks < nks) { const bf16x8 B = *(const LAS bf16x8*)(bp + 32 * ks); acc = MFMA32(Af[ks], B, acc); } }
#pragma unroll
                  for (int r = 0; r < 16; ++r) { const int t = 64 * th + 32 * tb + crow(r, hi);
                      BR[(size_t)(R0 + t) * DM + 256 + c] = (bf16_t)f2bf(uv[r] * (acc[r] + bsv[r])); } } } }
        __syncthreads();
    }
}

constexpr int KPITCH = 208, VPITCH = 264, KBUF = 128 * KPITCH, VBUF = 64 * VPITCH, ATT_V0 = 2 * KBUF, ATT_WS = ATT_V0 + 2 * VBUF;
#define MX3(a, b, c) __builtin_fmaxf(__builtin_fmaxf((a), (b)), (c))
#define ATT_QK(P0, P1, KB) do { \
    _Pragma("unroll") for (int kh = 0; kh < 2; ++kh) { bf16x8 ka_[3], kc_[3]; \
        _Pragma("unroll") for (int ks = 0; ks < 3; ++ks) { ka_[ks] = *(const LAS bf16x8*)((KB) + (3 * kh + ks) * 32); kc_[ks] = *(const LAS bf16x8*)((KB) + 32 * KPITCH + (3 * kh + ks) * 32); } \
        _Pragma("unroll") for (int ks = 0; ks < 3; ++ks) { if (kh == 0 && ks == 0) { P0 = MFMA32(ka_[0], qf[0], negm); P1 = MFMA32(kc_[0], qf[0], negm); } \
            else { P0 = MFMA32(ka_[ks], qf[3 * kh + ks], P0); P1 = MFMA32(kc_[ks], qf[3 * kh + ks], P1); } } } } while (0)
#define ATT_MAX(P0, P1, TT) do { \
    if (64 * (TT) + 63 > qw0) { const int qg_ = qw0 + r32; \
        _Pragma("unroll") for (int r = 0; r < 16; ++r) { const int kv_ = 64 * (TT) + crow(r, hi); if (kv_ > qg_) P0[r] = -INFINITY; if (kv_ + 32 > qg_) P1[r] = -INFINITY; } } \
    float ra_ = MX3(P0[0], P0[1], P1[0]), rb_ = MX3(P0[2], P0[3], P1[1]); ra_ = MX3(ra_, P1[2], P1[3]); \
    _Pragma("unroll") for (int r = 4; r < 16; r += 4) { ra_ = MX3(ra_, P0[r], P0[r + 1]); rb_ = MX3(rb_, P0[r + 2], P0[r + 3]); ra_ = MX3(ra_, P1[r], P1[r + 1]); rb_ = MX3(rb_, P1[r + 2], P1[r + 3]); } \
    float rm_ = __builtin_fmaxf(ra_, rb_); rm_ = __builtin_fmaxf(rm_, __shfl_xor(rm_, 32));        \
    const bool first_ = ((TT) == 0); \
    if (first_ || __any(rm_ > 8.0f)) { const float dl_ = first_ ? rm_ : __builtin_fmaxf(rm_, 0.f); mref += dl_; \
        _Pragma("unroll") for (int r = 0; r < 16; ++r) { P0[r] -= dl_; P1[r] -= dl_; } \
        _Pragma("unroll") for (int r = 0; r < 16; ++r) negm[r] = -mref; \
        const float alpha_ = __builtin_amdgcn_exp2f(-dl_); lsum *= alpha_; if (hi == 0) wsf[r32] = alpha_; \
        asm volatile("s_waitcnt lgkmcnt(0)" ::: "memory"); \
        _Pragma("unroll") for (int r = 0; r < 16; ++r) { const float f_ = wsf[crow(r, hi)]; o0[r] *= f_; o1[r] *= f_; } } } while (0)
#define ATT_EXP(P0, P1, PA) do { float ps_ = 0.f; \
    _Pragma("unroll") for (int r = 0; r < 16; ++r) { P0[r] = __builtin_amdgcn_exp2f(P0[r]); P1[r] = __builtin_amdgcn_exp2f(P1[r]); ps_ += P0[r] + P1[r]; } \
    lsum += ps_; u32x4 w_; \
    w_.x = cvtpk_v(P0[0], P0[1]); w_.y = cvtpk_v(P0[2], P0[3]); w_.z = cvtpk_v(P0[4], P0[5]); w_.w = cvtpk_v(P0[6], P0[7]); PA[0] = __builtin_bit_cast(bf16x8, w_); \
    w_.x = cvtpk_v(P0[8], P0[9]); w_.y = cvtpk_v(P0[10], P0[11]); w_.z = cvtpk_v(P0[12], P0[13]); w_.w = cvtpk_v(P0[14], P0[15]); PA[1] = __builtin_bit_cast(bf16x8, w_); \
    w_.x = cvtpk_v(P1[0], P1[1]); w_.y = cvtpk_v(P1[2], P1[3]); w_.z = cvtpk_v(P1[4], P1[5]); w_.w = cvtpk_v(P1[6], P1[7]); PA[2] = __builtin_bit_cast(bf16x8, w_); \
    w_.x = cvtpk_v(P1[8], P1[9]); w_.y = cvtpk_v(P1[10], P1[11]); w_.z = cvtpk_v(P1[12], P1[13]); w_.w = cvtpk_v(P1[14], P1[15]); PA[3] = __builtin_bit_cast(bf16x8, w_); } while (0)
#define ATT_PV(PA, VB) do { \
    _Pragma("unroll") for (int kk = 0; kk < 4; ++kk) { \
        const s16x4 l0_ = *(const LAS s16x4*)((VB) + kk * 32), h0_ = *(const LAS s16x4*)((VB) + kk * 32 + 16); \
        const s16x4 l1_ = *(const LAS s16x4*)((VB) + 32 * VPITCH + kk * 32), h1_ = *(const LAS s16x4*)((VB) + 32 * VPITCH + kk * 32 + 16); \
        const bf16x8 v0_ = __builtin_shufflevector(l0_, h0_, 0, 1, 2, 3, 4, 5, 6, 7), v1_ = __builtin_shufflevector(l1_, h1_, 0, 1, 2, 3, 4, 5, 6, 7); \
        o0 = MFMA32(PA[kk], v0_, o0); o1 = MFMA32(PA[kk], v1_, o1); } } while (0)

__device__ __forceinline__ void attn_unit(const Args& a, unsigned char* wsl, int b, int h, int qb, LAS unsigned char* lds, int tid_in) {
    int tid = tid_in; asm volatile("" : "+v"(tid));
    const int lane = tid & 63, wid = __builtin_amdgcn_readfirstlane(tid >> 6), r32 = lane & 31, hi = lane >> 5;
    unsigned char* ws = wsl;
    const bf16_t* Q = (const bf16_t*)(ws + WS_Q); const bf16_t* Kn = (const bf16_t*)(ws + WS_KN); const bf16_t* Kr = (const bf16_t*)(ws + WS_KR); const bf16_t* Vt = (const bf16_t*)(ws + WS_VT);
    bf16_t* O = (bf16_t*)(ws + WS_BR); const float* rc = (const float*)(ws + WS_ROPEC); const float* rsn = (const float*)(ws + WS_ROPES);
    const size_t rowbase = (size_t)b * SEQ; const int qw0 = qb * 256 + wid * 32;
    LAS float* wsf = (LAS float*)(lds + ATT_WS) + wid * 64;
    bf16x8 qf[6];
    { const size_t qrow = rowbase + qw0 + r32; const bf16_t* qp = Q + qrow * 512 + h * 96 + 8 * hi;
#pragma unroll
      for (int ks = 0; ks < 4; ++ks) qf[ks] = *(const bf16x8*)(qp + 16 * ks);
      const bf16x8 x1 = *(const bf16x8*)(qp + 64), x2 = *(const bf16x8*)(qp + 80);
      const float* cp = rc + qrow * 16 + 8 * hi; const float* sp = rsn + qrow * 16 + 8 * hi;
      const f32x4 c0 = *(const f32x4*)cp, c1 = *(const f32x4*)(cp + 4), s0 = *(const f32x4*)sp, s1 = *(const f32x4*)(sp + 4);
      bf16x8 o1, o2;
#pragma unroll
      for (int j = 0; j < 8; ++j) { const float xa = bf2f((bf16_t)x1[j]), xb = bf2f((bf16_t)x2[j]); const float c = j < 4 ? c0[j & 3] : c1[j & 3], s = j < 4 ? s0[j & 3] : s1[j & 3];
          o1[j] = (short)f2bf(xa * c - xb * s); o2[j] = (short)f2bf(xb * c + xa * s); }
      qf[4] = o1; qf[5] = o2; }
    const bf16_t* knu = Kn + rowbase * 256 + h * 64;
    const bf16_t* kru = Kr + rowbase * 32;
    const bf16_t* vtu = Vt + (size_t)(h * 64) * MTOK + rowbase;
    u32x4 gk0, gk1, gr, gv0, gv1;
#define ATT_LOAD(T) do { int t_ = tid; asm volatile("" : "+v"(t_)); const unsigned knv = (unsigned)((t_ >> 3) * 256 + (t_ & 7) * 8), krv = (unsigned)((t_ >> 2) * 32 + (t_ & 3) * 8), vtv = (unsigned)((t_ >> 3) * MTOK + (t_ & 7) * 8); \
        const bf16_t* k_ = knu + (size_t)(T) * 128 * 256; const bf16_t* r_ = kru + (size_t)(T) * 128 * 32; const bf16_t* v_ = vtu + (size_t)(T) * 128; \
        gk0 = *(const u32x4*)(k_ + knv); gk1 = *(const u32x4*)(k_ + 64 * 256 + knv); gr = *(const u32x4*)(r_ + krv); \
        gv0 = *(const u32x4*)(v_ + vtv); gv1 = *(const u32x4*)(v_ + 64 + vtv); } while (0)
#define ATT_STORE(bf) do { int t_ = tid; asm volatile("" : "+v"(t_)); const int krow = t_ >> 3, kch = t_ & 7, rrow = t_ >> 2, rch = t_ & 3; \
        LAS unsigned char* kd_ = lds + (bf) * KBUF; LAS unsigned char* vd_ = lds + ATT_V0 + (bf) * VBUF + krow * VPITCH + kch * 16; \
        *(LAS u32x4*)(kd_ + krow * KPITCH + kch * 16) = gk0; *(LAS u32x4*)(kd_ + (krow + 64) * KPITCH + kch * 16) = gk1; *(LAS u32x4*)(kd_ + rrow * KPITCH + 128 + rch * 16) = gr; \
        *(LAS u32x2*)(vd_) = (u32x2){gv0.x, gv0.y}; *(LAS u32x2*)(vd_ + 8) = (u32x2){gv0.z, gv0.w}; *(LAS u32x2*)(vd_ + 128) = (u32x2){gv1.x, gv1.y}; *(LAS u32x2*)(vd_ + 136) = (u32x2){gv1.z, gv1.w}; } while (0)
    float mref = 0.f, lsum = 0.f; f32x16 o0, o1, negm;
#pragma unroll
    for (int r = 0; r < 16; ++r) { o0[r] = 0.f; o1[r] = 0.f; negm[r] = 0.f; }
    const int NT2 = 2 * qb + 2;
    ATT_LOAD(0); ATT_STORE(0); __syncthreads();
    for (int T = 0; T < NT2; ++T) {
        const int buf = T & 1;
        if (T + 1 < NT2) ATT_LOAD(T + 1);
        const int tA = 2 * T, tB = 2 * T + 1;
        const LAS unsigned char* kbA = lds + buf * KBUF + r32 * KPITCH + hi * 16; const LAS unsigned char* kbB = kbA + 64 * KPITCH;
        const LAS unsigned char* vbA = lds + ATT_V0 + buf * VBUF + r32 * VPITCH + hi * 8; const LAS unsigned char* vbB = vbA + 128;
        if (64 * tB <= qw0 + 31) {
            f32x16 pA0, pA1, pB0, pB1; bf16x8 pa[4];
            ATT_QK(pA0, pA1, kbA);
            ATT_MAX(pA0, pA1, tA);
            ATT_QK(pB0, pB1, kbB);
            ATT_EXP(pA0, pA1, pa);
            ATT_MAX(pB0, pB1, tB);
            ATT_PV(pa, vbA);
            ATT_EXP(pB0, pB1, pa);
            ATT_PV(pa, vbB);
        } else if (64 * tA <= qw0 + 31) {
            f32x16 pA0, pA1; bf16x8 pa[4];
            ATT_QK(pA0, pA1, kbA);
            ATT_MAX(pA0, pA1, tA);
            ATT_EXP(pA0, pA1, pa);
            ATT_PV(pa, vbA);
        }
        if (T + 1 < NT2) ATT_STORE((T + 1) & 1);
        __syncthreads();
    }
#undef ATT_LOAD
#undef ATT_STORE
    lsum += __shfl_xor(lsum, 32);
    if (hi == 0) wsf[32 + r32] = 1.0f / lsum;
    asm volatile("s_waitcnt lgkmcnt(0)" ::: "memory");
    { bf16_t* ou = O + (rowbase + qw0) * DM + h * 64;
#pragma unroll
      for (int r = 0; r < 16; ++r) { const int qr = crow(r, hi); const float inv = wsf[32 + qr]; const unsigned ov = (unsigned)(qr * DM + r32);
          ou[ov] = (bf16_t)f2bf(o0[r] * inv); ou[ov + 32] = (bf16_t)f2bf(o1[r] * inv); } }
}
__device__ __forceinline__ void phase_attn(const Args& a, unsigned char* wsl, LAS unsigned char* lds, int tid) {
    const int G = gridDim.x, bx = blockIdx.x; const int v0 = (G % 8 == 0) ? (bx % 8) * (G / 8) + bx / 8 : bx;
    for (int v = v0; v < 256; v += G) { const int bh = v >> 4, s = v & 15;
        attn_unit(a, wsl, bh >> 2, bh & 3, 31 - s, lds, tid);
        attn_unit(a, wsl, bh >> 2, bh & 3, s, lds, tid); }
}

#define XB_TMO      128
#define XB_XCNT(j)  (256  + 64 * (j))
#define XB_XSUB(j)  (1280 + 64 * (j))
#define XB_XGEN(j)  (2304 + 64 * (j))
#define XB_TOP      3328
#define XB_TOPGEN   3392
#define XCD_BAR_WORDS 3456
#define XB_SPIN_CAP (1u << 18)

__device__ __forceinline__ unsigned xb_ld(unsigned* p)              { return __hip_atomic_load(p, __ATOMIC_RELAXED, __HIP_MEMORY_SCOPE_AGENT); }
__device__ __forceinline__ unsigned xb_add(unsigned* p, unsigned v) { return __hip_atomic_fetch_add(p, v, __ATOMIC_RELAXED, __HIP_MEMORY_SCOPE_AGENT); }
__device__ __forceinline__ unsigned xb_xcc_id() { return (unsigned)__builtin_amdgcn_s_getreg((3 << 11) | 20) & 0xFu; }
#define XB_SPIN(cond, bar) do { unsigned _sp = 0; while (cond) { __builtin_amdgcn_s_sleep(1); \
    if ((++_sp & 255u) == 0u) { if (xb_ld(&(bar)[XB_TMO])) break; if (_sp > XB_SPIN_CAP) { atomicAdd(&(bar)[XB_TMO], 1u); break; } } } } while (0)

struct XcdBarrier {
    unsigned* bar; unsigned x;
    volatile LAS unsigned* st;
};

__device__ __forceinline__ XcdBarrier xcd_barrier_post(unsigned* bar, volatile LAS unsigned* st) {
    XcdBarrier b; b.bar = bar; b.x = xb_xcc_id(); b.st = st;
    if (threadIdx.x == 0) (void)xb_add(&bar[XB_XCNT(b.x)], 1u);
    return b;
}
__device__ __forceinline__ void xcd_barrier_complete(unsigned* bar, unsigned x, unsigned& nloc, unsigned& nx) {
    const unsigned G = gridDim.x * gridDim.y * gridDim.z;
    unsigned sum, cnt, mine, sp = 0u;
    for (;;) {
        sum = 0u; cnt = 0u; mine = 0u;
#pragma unroll
        for (unsigned j = 0; j < 16; ++j) { const unsigned c = xb_ld(&bar[XB_XCNT(j)]); sum += c; cnt += (c > 0u) ? 1u : 0u; mine = (j == x) ? c : mine; }
        if (sum == G) break;
        __builtin_amdgcn_s_sleep(1);
        if ((++sp & 255u) == 0u) { if (xb_ld(&bar[XB_TMO])) break; if (sp > XB_SPIN_CAP) { atomicAdd(&bar[XB_TMO], 1u); break; } }
    }
    nloc = mine > 0u ? mine : 1u; nx = cnt > 0u ? cnt : 1u;
}

__device__ __forceinline__ void xcd_barrier(const XcdBarrier& b) {
    asm volatile("s_waitcnt vmcnt(0)" ::: "memory");
    __syncthreads();
    if (threadIdx.x == 0) {
        unsigned* bar = b.bar;
        __builtin_amdgcn_s_waitcnt(0);
        unsigned nloc = b.st[0], nx = b.st[1];
        if (nloc == 0u) { xcd_barrier_complete(bar, b.x, nloc, nx); b.st[0] = nloc; b.st[1] = nx; }
        const unsigned old = xb_add(&bar[XB_XSUB(b.x)], 1u);
        const unsigned gen = old / nloc;
        if (old + 1u == (gen + 1u) * nloc) {
            __builtin_amdgcn_fence(__ATOMIC_RELEASE, "agent");
            asm volatile("s_waitcnt vmcnt(0)" ::: "memory");
            const unsigned og = xb_add(&bar[XB_TOP], 1u);
            const unsigned tg = og / nx;
            if (og + 1u == (tg + 1u) * nx) xb_add(&bar[XB_TOPGEN], 1u);
            else XB_SPIN(xb_ld(&bar[XB_TOPGEN]) == tg, bar);
            __builtin_amdgcn_fence(__ATOMIC_ACQUIRE, "agent");
            xb_add(&bar[XB_XGEN(b.x)], 1u);
            asm volatile("s_waitcnt vmcnt(0)" ::: "memory");
        } else {
            XB_SPIN(xb_ld(&bar[XB_XGEN(b.x)]) == gen, bar);
            __builtin_amdgcn_fence(__ATOMIC_ACQUIRE, "agent");
            asm volatile("s_waitcnt vmcnt(0)" ::: "memory");
        }
    }
    __syncthreads();
}

__global__ void __launch_bounds__(512, 2) mk_fwd(Args a) {
    extern __shared__ __attribute__((aligned(16))) unsigned char lds_raw[];
    LAS unsigned char* lds = (LAS unsigned char*)lds_raw;
    cg::grid_group grid = cg::this_grid();
    const int tid0 = threadIdx.x, G = gridDim.x, bx = blockIdx.x;
    { volatile LAS unsigned* st0 = (volatile LAS unsigned*)(lds + 131072 + 64); if (tid0 == 0) { st0[0] = 0u; st0[1] = 0u; } }
    __syncthreads();
    XcdBarrier xbar = xcd_barrier_post((unsigned*)a.ws, (volatile LAS unsigned*)(lds + 131072 + 64));
    for (int ph = a.lo; ph < a.hi; ++ph) {
        unsigned char* ws = a.ws; int tid = (int)__builtin_amdgcn_workitem_id_x();
        asm volatile("" : "+s"(ws), "+v"(tid));
        int l = 0, k = -1; if (ph > 0) { l = (ph - 1) / 11; k = (ph - 1) % 11; }
        const int ng = (k == 0 || k == 4 || k == 5 || k == 6 || k == 8 || k == 9) ? 1 : (k == 2 ? 3 : 0);
#ifndef PM
#define PM 0xFF
#endif
        if (PM & 1) for (int j = 0; j < ng; ++j) {
            size_t oA, oB, oO; int M_ = MTOK, N_ = DM, K_ = DM, lda = DM, ldb = DM, ldc = DM, mode = 0, nbr = 1, coff = 0, use_rs = 0, zs = 0, bmode = 0;
            if (k == 0) {
                oA = WS_XBF; oB = WS_WIN; oO = WS_BIG; N_ = 2048; ldc = 2048; use_rs = 1; mode = 1;
            } else if (k == 2) {
                if (j == 0) { oA = WS_CQN; oB = WS_WUQ; oO = WS_Q; N_ = 512; K_ = 256; lda = 256; ldb = 256; ldc = 512; }
                else if (j == 1) { oA = WS_CKVN; oB = WS_WK; oO = WS_KN; N_ = 256; K_ = 128; lda = 128; ldb = 128; ldc = 256; }
                else { oA = WS_WV; oB = WS_CKVN; oO = WS_VT; M_ = 256; N_ = MTOK; K_ = 128; lda = 128; ldb = 128; ldc = MTOK; coff = G / 2; }
            } else if (k == 4) {
                oA = WS_BR; oB = WS_WBR; oO = WS_BIG; K_ = 256; ldb = 256; ldc = 4096; nbr = 4; mode = 6; bmode = 2;
            } else if (k == 5) {
                oA = WS_XBF; oB = WS_WIN + (size_t)2048 * DM * 2; oO = WS_BR; N_ = 4096; use_rs = 1; mode = 5; bmode = 1;
            } else if (k == 6) {
                oA = WS_BR; oB = WS_WOUT; oO = WS_BIG;
            } else if (k == 8) {
                oA = WS_XBF; oB = WS_W1; oO = WS_BIG; N_ = DFF; ldc = DFF; use_rs = 1; mode = 3;
            } else {
                oA = WS_BIG; oB = WS_W2; oO = WS_BR; K_ = DFF; lda = DFF; ldb = DFF;
            }
            pg8::Gemm g{(const bf16_t*)(ws + oA), (const bf16_t*)(ws + oB), M_, N_, K_, lda, ldb, bmode};
            pg8::EpiRT E{(bf16_t*)(ws + oO), ldc, use_rs ? (const float*)(ws + WS_RS) : nullptr, a.in[I_GATEB] + l * 4096, (const bf16_t*)ws, mode, zs};
            pg8::MergeOrder S; S.init(M_, N_, G, (bx + coff) % G, nbr);
            pg8::gemm_phase<pg8::EpiRT, pg8::MergeOrder, true, true>(lds, g, S, E, tid);
        }
        if ((PM & 2) && k == 1) phase_e1(a, ws, l, lds, tid);
        if ((PM & 4) && k == 3) phase_attn(a, ws, lds, tid);
        if ((PM & 8) && (k == 7 || k == 10)) phase_nr(a, ws, (k == 7 ? a.in[I_NPOST] : a.in[I_NFPOST]) + l * DM, k == 7 ? WS_BIG : WS_BR, (k == 10 && l == NLAYER - 1), tid);
        if ((PM & 16) && ph == 0) phase_s0(a, ws, lds, tid);
        if ((PM & 32) && (ph == 0 || (k == 10 && l + 1 < NLAYER))) prep_weights(a, ws, ph == 0 ? 0 : l + 1, lds, tid);
        if (ph + 1 < a.hi) { if (ph == a.lo) grid.sync(); else xcd_barrier(xbar); }
    }
}

constexpr int NPHASE = 1 + 11 * NLAYER;
#ifndef MK_ONE_LAUNCH
#define MK_ONE_LAUNCH 1
#endif
extern "C" void kernel_launch(void* const* d_in, const int* in_sizes, int n_in, void* d_out, int out_size, void* d_ws, size_t ws_size, hipStream_t stream) {
    static int grid = 0;
    if (grid == 0) {
        if (n_in != 26 || out_size != MTOK * DM || ws_size < WS_END) { fprintf(stderr, "kernel_launch: unexpected shapes (n_in %d out %d ws %zu)\n", n_in, out_size, ws_size); grid = -1; return; }
        int dev = 0, cus = 0, per_cu = 0;
        hipGetDevice(&dev); hipDeviceGetAttribute(&cus, hipDeviceAttributeMultiprocessorCount, dev);
        hipFuncSetAttribute((const void*)mk_fwd, hipFuncAttributeMaxDynamicSharedMemorySize, LDS_BYTES);
        hipOccupancyMaxActiveBlocksPerMultiprocessor(&per_cu, (const void*)mk_fwd, 512, LDS_BYTES);
        if (per_cu < 1) { fprintf(stderr, "kernel_launch: occupancy query says %d blocks per CU\n", per_cu); per_cu = 1; }
        (void)hipGetLastError();
        grid = cus;
    }
    if (grid < 0) return;
    Args a{};
    for (int i = 0; i < 26; ++i) a.in[i] = (const float*)d_in[i];
    a.out = (float*)d_out; a.ws = (unsigned char*)d_ws;
    if (hipMemsetAsync(d_ws, 0, 16384, stream) != hipSuccess) { fprintf(stderr, "memset failed\n"); return; }
#if MK_ONE_LAUNCH
    a.lo = 0; a.hi = NPHASE;
    { void* args[] = {&a}; hipError_t e = hipLaunchCooperativeKernel((const void*)mk_fwd, dim3(grid), dim3(512), args, LDS_BYTES, stream);
      if (e != hipSuccess) fprintf(stderr, "cooperative launch failed: %s (grid %d)\n", hipGetErrorString(e), grid); }
#else
    for (int ph = 0; ph < NPHASE; ++ph) { a.lo = ph; a.hi = ph + 1;
        void* args[] = {&a}; hipError_t e = hipLaunchCooperativeKernel((const void*)mk_fwd, dim3(grid), dim3(512), args, LDS_BYTES, stream);
        if (e != hipSuccess) { fprintf(stderr, "launch %d failed: %s (grid %d)\n", ph, hipGetErrorString(e), grid); break; } }
#endif
}
```

```cpp
#include <hip/hip_runtime.h>
#include <hip/hip_cooperative_groups.h>
#include <cstdio>
#include <cstdint>
namespace cg = cooperative_groups;

#define LAS __attribute__((address_space(3)))
typedef unsigned short bf16_t;
typedef short bf16x8 __attribute__((ext_vector_type(8)));
typedef short s16x4 __attribute__((ext_vector_type(4)));
typedef float f32x4 __attribute__((ext_vector_type(4)));
typedef float f32x2 __attribute__((ext_vector_type(2)));
typedef float f32x16 __attribute__((ext_vector_type(16)));
typedef unsigned u32x4 __attribute__((ext_vector_type(4)));
typedef unsigned u32x2 __attribute__((ext_vector_type(2)));

__device__ __forceinline__ unsigned f2bf(float f) { unsigned u = __builtin_bit_cast(unsigned, f); return (u + 0x7fffu + ((u >> 16) & 1u)) >> 16; }
__device__ __forceinline__ unsigned pk2(float lo, float hi) { return f2bf(lo) | (f2bf(hi) << 16); }
__device__ __forceinline__ float bflo(unsigned w) { return __builtin_bit_cast(float, w << 16); }
__device__ __forceinline__ float bfhi(unsigned w) { return __builtin_bit_cast(float, w & 0xffff0000u); }
__device__ __forceinline__ float bf2f(bf16_t h) { return __builtin_bit_cast(float, ((unsigned)h) << 16); }
__device__ __forceinline__ float wave_sum(float v) {
#pragma unroll
    for (int o = 1; o < 64; o <<= 1) v += __shfl_xor(v, o);
    return v;
}
__device__ __forceinline__ float fast_sigmoid(float v) { return __builtin_amdgcn_rcpf(1.0f + __builtin_amdgcn_exp2f(-1.4426950408889634f * v)); }
__device__ __forceinline__ float gelu_tanh(float x) { const float u = 0.7978845608028654f * (x + 0.044715f * x * x * x); return x * fast_sigmoid(2.0f * u); }

namespace pg8 {
#define PG8_LAS __attribute__((address_space(3)))
constexpr int BM = 256, BK = 64, HALF = 128, HTB = HALF * BK * 2  , STAGE_BYTES = 8 * HTB, NXCD = 8, WGM = 8;

__host__ __device__ __forceinline__ int lds_byte(int r, int c) { const int st = (r >> 4) * 2 + (c >> 5), rr = r & 15, cc = c & 31, ob = rr * 64 + cc * 2; return st * 1024 + (ob ^ (((ob >> 9) & 1) << 5)); }
__host__ __device__ __forceinline__ void stage_rc(int b, int& R, int& C) { const int st = b / 1024, sb = b % 1024, swz = sb ^ (((sb >> 9) & 1) << 5); R = (st >> 1) * 16 + swz / 64; C = (st & 1) * 32 + (swz % 64) / 2; }
__host__ __device__ __forceinline__ int perm32(int rho) { const int n = rho >> 4, i = rho & 15; return 8 * (i >> 2) + 4 * n + (i & 3); }

struct Unit { int pm, pn, bn, ak, z, kind, mode; };
struct Gemm { const bf16_t* A; const bf16_t* Bt; int M, N, K, lda, ldb, bmode; const bf16_t* A1; const bf16_t* B1; int K1, bmode1; };

struct StaticOrder {
    int nM, nN, nwg, G, c;
    __host__ __device__ void init(int M, int N, int G_, int c_) { nM = M / BM; nN = N / BM; nwg = nM * nN; G = G_; c = c_; }
    __host__ __device__ bool map(long L, Unit& u) const {
        if (L >= nwg) return false;
        int wgid = (int)L; { const int q = nwg / NXCD, r = nwg % NXCD, xcd = wgid % NXCD, off = wgid / NXCD; wgid = (xcd < r ? xcd * (q + 1) : r * (q + 1) + (xcd - r) * q) + off; }
        const int nig = WGM * nN, gid = wgid / nig, fm = gid * WGM, gsz = (nM - fm) < WGM ? (nM - fm) : WGM;
        u.pm = fm + ((wgid % nig) % gsz); u.pn = (wgid % nig) / gsz; return true;
    }
    __host__ __device__ bool next(int i, Unit& u) const { u.ak = 0; u.z = 0; u.kind = 0; u.mode = -1; const bool ok = map((long)i * G + c, u); u.bn = u.pn; return ok; }
    __device__ __forceinline__ void a_ready(const Unit&) const {}
    __device__ __forceinline__ void done(const Unit&) const {}
};
struct MergeOrder {
    StaticOrder S; int nbr;
    __host__ __device__ void init(int M, int N, int G_, int c_, int nbr_) { S.init(M, N, G_, c_); nbr = nbr_; }
    __host__ __device__ bool next(int i, Unit& u) const {
        if (nbr == 8) {
            const int j = i & 7; const bool ok = S.map((long)(i >> 3) * S.G + S.c, u); const int p4 = u.pn;
            if (j < 4) { u.kind = 0; u.mode = 6; u.z = j; u.ak = j * 256; u.bn = j * 4 + p4; }
            else { u.kind = 1; u.mode = 5; u.z = 0; u.ak = 0; u.pn = 4 * p4 + (j - 4); u.bn = u.pn; }
            return ok; }
        u.kind = 0; u.mode = -1; const int z = i % nbr; const bool ok = S.map((long)(i / nbr) * S.G + S.c, u); u.z = z; u.ak = z * 256; u.bn = z * S.nN + u.pn; return ok; }
    __device__ __forceinline__ void a_ready(const Unit&) const {}
    __device__ __forceinline__ void done(const Unit&) const {}
};

__device__ __forceinline__ unsigned cvt_pk_bf16(float lo, float hi) { unsigned r; asm volatile("v_cvt_pk_bf16_f32 %0, %1, %2" : "=v"(r) : "v"(lo), "v"(hi)); return r; }

constexpr size_t Y_OFF = (size_t)168 << 20;
struct EpiRT {
    static constexpr bool PERM = true, AFTER_DRAIN = false;
    bf16_t* O; int ldc; const float* rs; const float* bias; const bf16_t* gates; int mode, zs;
    __device__ __forceinline__ void operator()(const f32x4 (&acc)[2][2][4][2], const Unit& u, int wr, int wc, int fr, int fq) const {
        const int md = u.mode >= 0 ? u.mode : mode;
        if (md == 6) {
            const int tidx = (wr * 4 + wc) * 64 + fq * 16 + fr; u32x4* Yp = (u32x4*)((unsigned char*)gates + Y_OFF);
#pragma unroll
            for (int bj = 0; bj < 2; ++bj)
#pragma unroll
                for (int n = 0; n < 2; ++n) { const size_t base = ((size_t)((u.pm * 16 + 4 * u.pn + 2 * bj + n) * 4 + u.z) * 4) * 512 + tidx;
#pragma unroll
                    for (int ai = 0; ai < 2; ++ai)
#pragma unroll
                        for (int mp = 0; mp < 2; ++mp) { const f32x4 a0 = acc[ai][bj][2 * mp][n], a1 = acc[ai][bj][2 * mp + 1][n];
                            u32x4 w; w.x = cvt_pk_bf16(a0[0], a0[1]); w.y = cvt_pk_bf16(a0[2], a0[3]); w.z = cvt_pk_bf16(a1[0], a1[1]); w.w = cvt_pk_bf16(a1[2], a1[3]);
                            Yp[base + (size_t)(ai * 2 + mp) * 512] = w; } }
            return;
        }
        if (md == 5) {
            const int row0 = u.pm * BM + wr * 64 + fr; const int col = u.pn * 64 + wc * 16 + 4 * fq;
            const int tidx = (wr * 4 + wc) * 64 + fq * 16 + fr; size_t yo_ = Y_OFF + ((size_t)(u.pm * 16 + u.pn) * 16) * 512 * 16; asm volatile("" : "+s"(yo_));
            const u32x4* Yp = (const u32x4*)((const unsigned char*)gates + yo_) + tidx;
#pragma unroll
            for (int ai = 0; ai < 2; ++ai)
#pragma unroll
                for (int mp = 0; mp < 2; ++mp) {
                    f32x4 tot[2]; tot[0] = (f32x4){0.f, 0.f, 0.f, 0.f}; tot[1] = tot[0];
                    const float sc0 = rs[row0 + ai * HALF + (2 * mp) * 16], sc1 = rs[row0 + ai * HALF + (2 * mp + 1) * 16];
#pragma unroll
                    for (int bj = 0; bj < 2; ++bj) { u32x4 yw[2];
#pragma unroll
                        for (int n = 0; n < 2; ++n) yw[n] = Yp[(size_t)((2 * bj + n) * 4 + ai * 2 + mp) * 512];
#pragma unroll
                        for (int n = 0; n < 2; ++n) { const int z = 2 * bj + n; const f32x4 bz = *(const f32x4*)(bias + z * 1024 + col);
#pragma unroll
                            for (int mm = 0; mm < 2; ++mm) { const int m = 2 * mp + mm; const f32x4 v = acc[ai][bj][m][n] * (mm ? sc1 : sc0) + bz;
                                const unsigned y01 = mm ? yw[n].z : yw[n].x, y23 = mm ? yw[n].w : yw[n].y;
                                tot[mm][0] += fast_sigmoid(v[0]) * bflo(y01); tot[mm][1] += fast_sigmoid(v[1]) * bfhi(y01); tot[mm][2] += fast_sigmoid(v[2]) * bflo(y23); tot[mm][3] += fast_sigmoid(v[3]) * bfhi(y23); } } }
#pragma unroll
                    for (int mm = 0; mm < 2; ++mm) { const int row = row0 + ai * HALF + (2 * mp + mm) * 16;
                        u32x2 w; w.x = cvt_pk_bf16(tot[mm][0], tot[mm][1]); w.y = cvt_pk_bf16(tot[mm][2], tot[mm][3]);
                        *(u32x2*)(O + (size_t)row * ldc + col) = w; } }
            return;
        }
        const int row0 = u.pm * BM + wr * 64 + fr; const int col0 = u.pn * BM + wc * 32 + 8 * fq + u.z * zs;
        const int m_eff = (md == 1) ? ((u.pn == 2 || u.pn == 3) ? 1 : 0) : md;
#pragma unroll
        for (int ai = 0; ai < 2; ++ai)
#pragma unroll
            for (int m = 0; m < 4; ++m) { const int row = row0 + ai * HALF + m * 16; bf16_t* rowp = O + (size_t)row * ldc + col0;
                const float sc = rs ? rs[row] : 1.0f;
#pragma unroll
                for (int bj = 0; bj < 2; ++bj) { f32x4 v0 = acc[ai][bj][m][0] * sc, v1 = acc[ai][bj][m][1] * sc;
                    if (m_eff == 1) {
#pragma unroll
                        for (int e = 0; e < 4; ++e) { v0[e] = gelu_tanh(v0[e]); v1[e] = gelu_tanh(v1[e]); }
                    } else if (m_eff == 3) {
#pragma unroll
                        for (int e = 0; e < 4; ++e) { const float a = fmaxf(v0[e], 0.f), b = fmaxf(v1[e], 0.f); v0[e] = a * a; v1[e] = b * b; }
                    }
                    u32x4 w; w.x = cvt_pk_bf16(v0[0], v0[1]); w.y = cvt_pk_bf16(v0[2], v0[3]); w.z = cvt_pk_bf16(v1[0], v1[1]); w.w = cvt_pk_bf16(v1[2], v1[3]);
                    *(u32x4*)(rowp + bj * HALF) = w; } }
    }
};

template <class Epi, class Sched, bool ALIGN_EPI = false, bool SP2 = false>
__device__ __forceinline__ void gemm_phase(PG8_LAS unsigned char* lds, const Gemm g, const Sched& S, const Epi& E, const int tid) {
    const int wid = __builtin_amdgcn_readfirstlane(tid >> 6), lane = tid & 63, wr = wid >> 2, wc = wid & 3, fr = lane & 15, fq = lane >> 4;
    const int nt0 = g.K / BK, nt1 = g.K1 / BK;
    unsigned voffA, voffB0, voffB1;
    { int R, C; stage_rc(tid * 16, R, C); const int Rm1 = ((R >> 4) & 1) * 1024 + (R >> 5) * 16 + (R & 15), Rm2 = ((R >> 4) & 1) * 64 + (R >> 5) * 16 + (R & 15), Rm0 = (R & ~31) + perm32(R & 31);
        const int Rb0 = g.bmode == 1 ? Rm1 : g.bmode == 2 ? Rm2 : Rm0, Rb1 = g.bmode1 == 1 ? Rm1 : g.bmode1 == 2 ? Rm2 : Rm0;
        voffA = (unsigned)(R * g.lda + C) * 2u; voffB0 = (unsigned)(Rb0 * g.ldb + C) * 2u; voffB1 = (unsigned)(Rb1 * g.ldb + C) * 2u; }
    const unsigned voffA_d = 64u * g.lda * 2u, dB0 = (g.bmode ? 32u : 64u) * g.ldb * 2u, dB1 = (g.bmode1 ? 32u : 64u) * g.ldb * 2u;
    const size_t kstep = (size_t)(BK * 2);
    const size_t hstepA = (size_t)HALF * g.lda * 2, hstepB0 = (size_t)(g.bmode == 1 ? 2048 : HALF) * g.ldb * 2, hstepB1 = (size_t)(g.bmode1 == 1 ? 2048 : HALF) * g.ldb * 2;
    const size_t tstepA = 2 * hstepA, tstepB0 = (size_t)(g.bmode == 1 ? 64 : 256) * g.ldb * 2, tstepB1 = (size_t)(g.bmode1 == 1 ? 64 : 256) * g.ldb * 2;
    const unsigned ldsw = (unsigned)wid * 1024u;
    const int aoff = lds_byte(wr * 64 + fr, fq * 8), boff = lds_byte(wc * 32 + fr, fq * 8);
#define PG8_SA(b, h) (((b) * 2 + (h)) * HTB)
#define PG8_SB(b, h) ((4 + (b) * 2 + (h)) * HTB)
#define PG8_STAGE(bufoff, gbase, voff) do { _Pragma("unroll") for (int _i = 0; _i < 2; ++_i) \
        __builtin_amdgcn_global_load_lds((const unsigned*)((const char*)(gbase) + (size_t)(_i * voff##_d) + (voff)), (PG8_LAS unsigned*)(lds + (bufoff) + ldsw + _i * 8192), 16, 0, 0); } while (0)
#define PG8_LDA(dst, b, h) do { _Pragma("unroll") for (int m = 0; m < 4; ++m) _Pragma("unroll") for (int k = 0; k < 2; ++k) dst[m][k] = *(const PG8_LAS bf16x8*)(lds + PG8_SA(b, h) + aoff + m * 2048 + k * 1024); } while (0)
#define PG8_LDB(dst, b, h) do { _Pragma("unroll") for (int n = 0; n < 2; ++n) _Pragma("unroll") for (int k = 0; k < 2; ++k) dst[n][k] = *(const PG8_LAS bf16x8*)(lds + PG8_SB(b, h) + boff + n * 2048 + k * 1024); } while (0)
#define PG8_MMA(ai, bj, At, Bt) do { __builtin_amdgcn_s_setprio(1); _Pragma("unroll") for (int m = 0; m < 4; ++m) _Pragma("unroll") for (int n = 0; n < 2; ++n) _Pragma("unroll") for (int k = 0; k < 2; ++k) \
        acc[ai][bj][m][n] = __builtin_amdgcn_mfma_f32_16x16x32_bf16(Bt[n][k], At[m][k], acc[ai][bj][m][n], 0, 0, 0); __builtin_amdgcn_s_setprio(0); } while (0)
#define PG8_WAIT_V(n) asm volatile("s_waitcnt vmcnt(" #n ")" ::: "memory")
#define PG8_WAIT_L(n) asm volatile("s_waitcnt lgkmcnt(" #n ")" ::: "memory")
#define PG8_BAR __builtin_amdgcn_s_barrier()
#define PG8_SCHED __builtin_amdgcn_sched_barrier(0)
    Unit cur, nxt; int ui = 0;
    if (!S.next(0, cur)) return;
    f32x4 acc[2][2][4][2];
#pragma unroll
    for (int a = 0; a < 2; ++a)
#pragma unroll
        for (int b = 0; b < 2; ++b)
#pragma unroll
            for (int m = 0; m < 4; ++m)
#pragma unroll
                for (int n = 0; n < 2; ++n) acc[a][b][m][n] = (f32x4){0.f, 0.f, 0.f, 0.f};
    bf16x8 At[4][2], B0[2][2], B1[2][2];
    const char* cA = (const char*)(cur.kind ? g.A1 : g.A) + (size_t)cur.pm * tstepA + (size_t)cur.ak * 2; const char* cB = (const char*)(cur.kind ? g.B1 : g.Bt) + (size_t)cur.bn * (cur.kind ? tstepB1 : tstepB0);
    S.a_ready(cur);
    {
    const unsigned voffB = cur.kind ? voffB1 : voffB0, voffB_d = cur.kind ? dB1 : dB0; const size_t hstepB = cur.kind ? hstepB1 : hstepB0;
    if constexpr (SP2) {
        PG8_STAGE(PG8_SB(0, 0), cB, voffB); PG8_STAGE(PG8_SB(0, 1), cB + hstepB, voffB); PG8_STAGE(PG8_SA(0, 0), cA, voffA); PG8_STAGE(PG8_SA(0, 1), cA + hstepA, voffA);
        if (wr == 1) PG8_BAR;
        PG8_WAIT_V(2); PG8_BAR;
        PG8_STAGE(PG8_SB(1, 0), cB + kstep, voffB); PG8_STAGE(PG8_SA(1, 0), cA + kstep, voffA); PG8_STAGE(PG8_SB(1, 1), cB + hstepB + kstep, voffB);
        PG8_WAIT_V(6); PG8_BAR;
    } else {
        PG8_STAGE(PG8_SB(0, 0), cB, voffB); PG8_STAGE(PG8_SA(0, 0), cA, voffA); PG8_STAGE(PG8_SB(0, 1), cB + hstepB, voffB); PG8_STAGE(PG8_SA(0, 1), cA + hstepA, voffA);
        if (wr == 1) PG8_BAR;
        PG8_WAIT_V(4); PG8_BAR;
        PG8_STAGE(PG8_SB(1, 0), cB + kstep, voffB); PG8_STAGE(PG8_SA(1, 0), cA + kstep, voffA); PG8_STAGE(PG8_SB(1, 1), cB + hstepB + kstep, voffB);
        PG8_WAIT_V(6); PG8_BAR;
    }
    }
    for (;;) {
        const bool has_next = S.next(ui + 1, nxt); if (!has_next) nxt = cur;
        const int nt = cur.kind ? nt1 : nt0;
        const char* nA = has_next ? (const char*)(nxt.kind ? g.A1 : g.A) + (size_t)nxt.pm * tstepA + (size_t)nxt.ak * 2 : cA; const char* nB = has_next ? (const char*)(nxt.kind ? g.B1 : g.Bt) + (size_t)nxt.bn * (nxt.kind ? tstepB1 : tstepB0) : cB;
        for (int t = 0; t < nt; t += 2) {
            const bool last = (t == nt - 2);
            const int kB_ = last ? nxt.kind : cur.kind;
            const unsigned voffB = kB_ ? voffB1 : voffB0, voffB_d = kB_ ? dB1 : dB0; const size_t hstepB = kB_ ? hstepB1 : hstepB0;
            const char* a1 = cA + (size_t)(t + 1) * kstep;
            const char* a2 = last ? nA : cA + (size_t)(t + 2) * kstep; const char* b2 = last ? nB : cB + (size_t)(t + 2) * kstep;
            const char* a3 = a2 + kstep; const char* b3 = b2 + kstep;
            if (last && has_next) S.a_ready(nxt);
            if constexpr (SP2) {
            PG8_LDB(B0, 0, 0); PG8_LDB(B1, 0, 1); PG8_SCHED; PG8_LDA(At, 0, 0); PG8_STAGE(PG8_SA(1, 1), a1 + hstepA, voffA);
            PG8_WAIT_V(8); PG8_WAIT_L(0); PG8_BAR; PG8_MMA(0, 0, At, B0); PG8_MMA(0, 1, At, B1); PG8_BAR; PG8_SCHED;
            PG8_LDA(At, 0, 1); PG8_STAGE(PG8_SB(0, 0), b2, voffB); PG8_STAGE(PG8_SB(0, 1), b2 + hstepB, voffB); PG8_STAGE(PG8_SA(0, 0), a2, voffA);
            PG8_WAIT_V(8); PG8_WAIT_L(0); PG8_BAR; PG8_MMA(1, 0, At, B0); PG8_MMA(1, 1, At, B1); PG8_BAR; PG8_SCHED;
            PG8_LDB(B0, 1, 0); PG8_LDB(B1, 1, 1); PG8_SCHED; PG8_LDA(At, 1, 0); PG8_STAGE(PG8_SA(0, 1), a2 + hstepA, voffA);
            PG8_WAIT_V(8); PG8_WAIT_L(0); PG8_BAR; PG8_MMA(0, 0, At, B0); PG8_MMA(0, 1, At, B1); PG8_BAR; PG8_SCHED;
            PG8_LDA(At, 1, 1); PG8_STAGE(PG8_SB(1, 0), b3, voffB); PG8_STAGE(PG8_SB(1, 1), b3 + hstepB, voffB); PG8_STAGE(PG8_SA(1, 0), a3, voffA);
            PG8_WAIT_V(8); PG8_WAIT_L(0); PG8_BAR; PG8_MMA(1, 0, At, B0); PG8_MMA(1, 1, At, B1); PG8_BAR; PG8_SCHED;
            } else {
            PG8_LDB(B0, 0, 0); PG8_SCHED; PG8_LDA(At, 0, 0); PG8_STAGE(PG8_SA(1, 1), a1 + hstepA, voffA);
            PG8_WAIT_L(8); PG8_BAR; PG8_WAIT_L(0); PG8_MMA(0, 0, At, B0); PG8_BAR; PG8_SCHED;
            PG8_LDB(B1, 0, 1); PG8_STAGE(PG8_SB(0, 0), b2, voffB);
            PG8_BAR; PG8_WAIT_L(0); PG8_MMA(0, 1, At, B1); PG8_BAR;
            PG8_LDA(At, 0, 1); PG8_STAGE(PG8_SA(0, 0), a2, voffA);
            PG8_BAR; PG8_WAIT_L(0); PG8_MMA(1, 0, At, B0); PG8_BAR; PG8_SCHED;
            PG8_STAGE(PG8_SB(0, 1), b2 + hstepB, voffB);
            PG8_WAIT_V(6); PG8_BAR; PG8_MMA(1, 1, At, B1); PG8_BAR;
            PG8_LDB(B0, 1, 0); PG8_SCHED; PG8_LDA(At, 1, 0); PG8_STAGE(PG8_SA(0, 1), a2 + hstepA, voffA);
            PG8_WAIT_L(8); PG8_BAR; PG8_WAIT_L(0); PG8_MMA(0, 0, At, B0); PG8_BAR; PG8_SCHED;
            PG8_LDB(B1, 1, 1); PG8_STAGE(PG8_SB(1, 0), b3, voffB);
            PG8_BAR; PG8_WAIT_L(0); PG8_MMA(0, 1, At, B1); PG8_BAR;
            PG8_LDA(At, 1, 1); PG8_STAGE(PG8_SA(1, 0), a3, voffA);
            PG8_BAR; PG8_WAIT_L(0); PG8_MMA(1, 0, At, B0); PG8_BAR; PG8_SCHED;
            PG8_STAGE(PG8_SB(1, 1), b3 + hstepB, voffB);
            PG8_WAIT_V(6); PG8_BAR; PG8_MMA(1, 1, At, B1); PG8_BAR;
            }
        }
        if constexpr (ALIGN_EPI) { if (wr == 0) PG8_BAR; }
        if constexpr (!Epi::AFTER_DRAIN) { E(acc, cur, wr, wc, fr, fq); S.done(cur); }
        if (!has_next) break;
#pragma unroll
        for (int a = 0; a < 2; ++a)
#pragma unroll
            for (int b = 0; b < 2; ++b)
#pragma unroll
                for (int m = 0; m < 4; ++m)
#pragma unroll
                    for (int n = 0; n < 2; ++n) acc[a][b][m][n] = (f32x4){0.f, 0.f, 0.f, 0.f};
        cur = nxt; cA = nA; cB = nB; ++ui;
        if constexpr (ALIGN_EPI) { if (wr == 1) PG8_BAR; }
    }
    PG8_WAIT_V(0);
    if constexpr (!ALIGN_EPI) { if (wr == 0) PG8_BAR; }
    PG8_BAR;
    if constexpr (Epi::AFTER_DRAIN) { E.fused(acc, cur, wr, wc, fr, fq, lds, wid, lane); S.done(cur); }
#undef PG8_SA
#undef PG8_SB
#undef PG8_STAGE
#undef PG8_LDA
#undef PG8_LDB
#undef PG8_MMA
#undef PG8_WAIT_V
#undef PG8_WAIT_L
#undef PG8_BAR
#undef PG8_SCHED
}
}

constexpr int MTOK = 32768, DM = 1024, SEQ = 8192, NLAYER = 4, NIN = 6048, DFF = 4096;
constexpr float EPS = 1e-6f;
constexpr float QSCALE = 0.10206207261596575f * 1.4426950408889634f;
constexpr size_t MiB = 1u << 20;
constexpr size_t WS_RS = 1 * MiB, WS_ROPEC = 2 * MiB, WS_ROPES = 4 * MiB;
constexpr size_t WS_WIN = 6 * MiB, WS_WUQ = 18 * MiB, WS_WK = WS_WUQ + 256 * 1024, WS_WV = WS_WK + 64 * 1024, WS_SGW = WS_WUQ + 512 * 1024;
constexpr size_t WS_WBR = 424 * MiB, WS_WOUT = 21 * MiB, WS_W1 = 23 * MiB, WS_W2 = 31 * MiB;
constexpr size_t WS_XBF = 40 * MiB;
constexpr size_t WS_BR = 104 * MiB;
constexpr size_t WS_BIG = 168 * MiB;
constexpr size_t WS_PROJ = WS_BIG, WS_CQN = WS_BIG + 128 * MiB, WS_CKVN = WS_BIG + 144 * MiB, WS_KR = WS_BIG + 152 * MiB, WS_Q = WS_BIG + 154 * MiB, WS_KN = WS_BIG + 186 * MiB, WS_VT = WS_BIG + 202 * MiB;
constexpr size_t WS_END = 432 * MiB;
static_assert(WS_BIG == pg8::Y_OFF, "Y exchange offset");
constexpr int LDS_BYTES = 147456;

struct Args { const float* in[26]; float* out; unsigned char* ws; int lo, hi; };
enum { I_X = 0, I_POS, I_NPRE, I_WIN, I_GATEB, I_QN, I_WUQ, I_KVN, I_WUKV, I_WBRMLA, I_LNG, I_LNB, I_SGW, I_SGB, I_WBRSG, I_CONVW, I_WBRCONV, I_POOLW, I_POOLS, I_WBRPOOL, I_WOUT, I_NPOST, I_NFPRE, I_WFF1, I_WFF2, I_NFPOST };

typedef __bf16 bf16x2_t __attribute__((ext_vector_type(2)));
__device__ __forceinline__ unsigned cvtpk_v(float lo, float hi) { f32x2 v = {lo, hi}; bf16x2_t b = __builtin_convertvector(v, bf16x2_t); return __builtin_bit_cast(unsigned, b); }
__device__ __forceinline__ int crow(int r, int hi) { return (r & 3) + 8 * (r >> 2) + 4 * hi; }
#define MFMA32(a, b, c) __builtin_amdgcn_mfma_f32_32x32x16_bf16((a), (b), (c), 0, 0, 0)

__device__ __forceinline__ void tr_item(const float* __restrict__ W, int ldw, int k0, int srcn0, const float* __restrict__ gk, float mul, bf16_t* WT, int ldt, int dstn0, LAS float* scr, int lane) {
    float tv[32];
#pragma unroll
    for (int i = 0; i < 32; ++i) { const int kk = 2 * i + (lane >> 5); tv[i] = (srcn0 >= 0) ? W[(size_t)(k0 + kk) * ldw + srcn0 + (lane & 31)] : 0.f; }
    float gkv = mul; (void)gkv;
#pragma unroll
    for (int i = 0; i < 32; ++i) { const int kk = 2 * i + (lane >> 5); float v = tv[i] * mul; if (gk) v *= gk[k0 + kk]; scr[kk * 33 + (lane & 31)] = v; }
    asm volatile("s_waitcnt lgkmcnt(0)" ::: "memory");
    const int c = lane & 7;
#pragma unroll
    for (int j = 0; j < 4; ++j) { const int n = (lane >> 3) + 8 * j; const LAS float* s = scr + (8 * c) * 33 + n;
        u32x4 o; o.x = pk2(s[0 * 33], s[1 * 33]); o.y = pk2(s[2 * 33], s[3 * 33]); o.z = pk2(s[4 * 33], s[5 * 33]); o.w = pk2(s[6 * 33], s[7 * 33]);
        *(u32x4*)(WT + (size_t)(dstn0 + n) * ldt + k0 + 8 * c) = o; }
    asm volatile("s_waitcnt lgkmcnt(0)" ::: "memory");
}

__device__ __forceinline__ void prep_weights(const Args& a, unsigned char* wsl, int l, LAS unsigned char* lds, int tid) {
    const int lane = tid & 63, wave = tid >> 6, G = gridDim.x;
    LAS float* scr = (LAS float*)(lds + wave * 8448);
    const int gw = blockIdx.x * 8 + wave, NGW = G * 8;
    unsigned char* ws = wsl;
    constexpr int N0 = 16 * 192, N1 = 4 * 16, N2 = 2 * 8, N3 = 2 * 8, N4 = 3 * 4 * 32, N5 = 16 * 32, N6 = 16 * 128, N7 = 64 * 32;
    constexpr int NITEMS = N0 + N1 + N2 + N3 + N4 + N5 + N6 + N7;
    for (int it = gw; it < NITEMS; it += NGW) {
        int r = it;
        if (r < N0) { const int kb = r / 192, nb = r % 192, d0 = nb * 32; const int src = d0 < 416 ? d0 : (d0 < 512 ? -1 : d0 - 96);
            tr_item(a.in[I_WIN] + (size_t)l * DM * NIN, NIN, kb * 64, src, a.in[I_NPRE] + l * DM, 1.f, (bf16_t*)(ws + WS_WIN), DM, d0, scr, lane); continue; } r -= N0;
        if (r < N1) { const int kb = r / 16, nb = r % 16;
            tr_item(a.in[I_WUQ] + (size_t)l * 256 * 384, 384, kb * 64, nb < 12 ? nb * 32 : -1, a.in[I_QN] + l * 256, QSCALE, (bf16_t*)(ws + WS_WUQ), 256, nb * 32, scr, lane); continue; } r -= N1;
        if (r < N2) { const int kb = r / 8, nb = r % 8;
            tr_item(a.in[I_WUKV] + (size_t)l * 128 * 512, 512, kb * 64, (nb >> 1) * 128 + (nb & 1) * 32, a.in[I_KVN] + l * 128, 1.f, (bf16_t*)(ws + WS_WK), 128, nb * 32, scr, lane); continue; } r -= N2;
        if (r < N3) { const int kb = r / 8, nb = r % 8;
            tr_item(a.in[I_WUKV] + (size_t)l * 128 * 512, 512, kb * 64, (nb >> 1) * 128 + 64 + (nb & 1) * 32, a.in[I_KVN] + l * 128, 1.f, (bf16_t*)(ws + WS_WV), 128, nb * 32, scr, lane); continue; } r -= N3;
        if (r < N4) { const int z = r / 128, rr = r % 128, kb = rr / 32, nb = rr % 32; const float* W = (z == 0 ? a.in[I_WBRMLA] : z == 1 ? a.in[I_WBRSG] : a.in[I_WBRCONV]) + (size_t)l * 256 * DM;
            tr_item(W, DM, kb * 64, nb * 32, nullptr, 1.f, (bf16_t*)(ws + WS_WBR) + (size_t)z * DM * DM, DM, nb * 32, scr, lane); continue; } r -= N4;
        if (r < N5) { const int kb = r / 32, nb = r % 32;
            tr_item(a.in[I_WOUT] + (size_t)l * DM * DM, DM, kb * 64, nb * 32, nullptr, 1.f, (bf16_t*)(ws + WS_WOUT), DM, nb * 32, scr, lane); continue; } r -= N5;
        if (r < N6) { const int kb = r / 128, nb = r % 128;
            tr_item(a.in[I_WFF1] + (size_t)l * DM * DFF, DFF, kb * 64, nb * 32, a.in[I_NFPRE] + l * DM, 1.f, (bf16_t*)(ws + WS_W1), DM, nb * 32, scr, lane); continue; } r -= N6;
        { const int kb = r / 32, nb = r % 32;
            tr_item(a.in[I_WFF2] + (size_t)l * DFF * DM, DM, kb * 64, nb * 32, nullptr, 1.f, (bf16_t*)(ws + WS_W2), DFF, nb * 32, scr, lane); }
    }
    const int gt = blockIdx.x * 512 + tid, NGT = G * 512;
    { const float* sw = a.in[I_SGW] + (size_t)l * 65536; bf16_t* o = (bf16_t*)(ws + WS_SGW);
      for (int i = gt; i < 65536; i += NGT) { const int t = (i >> 7) & 127, s = i & 127; o[i] = (bf16_t)f2bf(s <= t ? sw[i] : 0.f); } }
    { const float* wp = a.in[I_POOLW] + (size_t)l * 4 * 64 * 64; const float* sc = a.in[I_POOLS] + l * 256; const float* wb = a.in[I_WBRPOOL] + (size_t)l * 256 * DM;
      bf16_t* o = (bf16_t*)(ws + WS_WBR) + (size_t)3 * DM * DM;
      for (int i = gt; i < 256 * DM; i += NGT) { const int n = i & 1023, cp = i >> 10, g = cp >> 6, c = cp & 63; float acc = 0.f;
          for (int d = 0; d < 64; ++d) acc += wp[(g * 64 + c) * 64 + d] * sc[g * 64 + d] * wb[(size_t)(g * 64 + d) * DM + n];
          o[(size_t)n * DM + cp] = (bf16_t)f2bf(acc); } }
}

__device__ __forceinline__ void phase_s0(const Args& a, unsigned char* wsl, LAS unsigned char* lds, int tid) {
    const int G = gridDim.x, gt = blockIdx.x * 512 + tid, NGT = G * 512;
    const int* pos = (const int*)a.in[I_POS];
    float* rc = (float*)(wsl + WS_ROPEC); float* rsn = (float*)(wsl + WS_ROPES);
    for (int i = gt; i < MTOK * 16; i += NGT) { const int tok = i & (MTOK - 1); const int k = __builtin_amdgcn_readfirstlane(i >> 15);
        const unsigned chi = (k == 0 ? 0x3fc45f30u : (k == 1 ? 0x3fb6e96eu : (k == 2 ? 0x3fa9c4c0u : (k == 3 ? 0x3f9cfb40u : (k == 4 ? 0x3f904c26u : (k == 5 ? 0x3f825458u : (k == 6 ? 0x3f749d66u : (k == 7 ? 0x3f672f66u : (k == 8 ? 0x3f5a1371u : (k == 9 ? 0x3f4d53c1u : (k == 10 ? 0x3f407debu : (k == 11 ? 0x3f328c52u : (k == 12 ? 0x3f24dc5au : (k == 13 ? 0x3f177634u : (k == 14 ? 0x3f0a6312u : (k == 15 ? 0x3efdad50u : 0u))))))))))))))));
        const unsigned clo = (k == 0 ? 0x6dc9c883u : (k == 1 ? 0xcaebf83fu : (k == 2 ? 0x200b604fu : (k == 3 ? 0x35fd7496u : (k == 4 ? 0xbe3b06cfu : (k == 5 ? 0xa2566033u : (k == 6 ? 0x800919d9u : (k == 7 ? 0x91979078u : (k == 8 ? 0x305e714cu : (k == 9 ? 0x03bd66b8u : (k == 10 ? 0x99a0e17au : (k == 11 ? 0x0e12d9f9u : (k == 12 ? 0x8d185aa3u : (k == 13 ? 0x02fdebc6u : (k == 14 ? 0x8f67cf2au : (k == 15 ? 0x16848ff5u : 0u))))))))))))))));
        const double cf = __hiloint2double((int)chi, (int)clo);
        const double rev = (double)pos[tok] * cf;
        const float fr = (float)(rev - __builtin_rint(rev));
        rc[tok * 16 + k] = __builtin_amdgcn_cosf(fr); rsn[tok * 16 + k] = __builtin_amdgcn_sinf(fr); }
    const int lane = tid & 63, wave = tid >> 6, gw = blockIdx.x * 8 + wave, NGW = G * 8;
    const float* x = a.in[I_X]; float* xo = a.out; bf16_t* xb = (bf16_t*)(wsl + WS_XBF); float* rs = (float*)(wsl + WS_RS);
    for (int row = gw; row < MTOK; row += NGW) {
        const float* xr = x + (size_t)row * DM + 8 * lane; bf16_t* bw = xb + (size_t)row * DM + 8 * lane;
        float ss = 0.f;
#pragma unroll
        for (int j = 0; j < 2; ++j) { const f32x4 v0 = *(const f32x4*)(xr + 512 * j), v1 = *(const f32x4*)(xr + 512 * j + 4);
            ss += v0.x * v0.x + v0.y * v0.y + v0.z * v0.z + v0.w * v0.w + v1.x * v1.x + v1.y * v1.y + v1.z * v1.z + v1.w * v1.w;
            u32x4 o; o.x = pk2(v0.x, v0.y); o.y = pk2(v0.z, v0.w); o.z = pk2(v1.x, v1.y); o.w = pk2(v1.z, v1.w); *(u32x4*)(bw + 512 * j) = o; }
        ss = wave_sum(ss);
        if (lane == 0) rs[row] = 1.0f / sqrtf(ss * (1.0f / DM) + EPS);
    }
}

__device__ __forceinline__ void phase_nr(const Args& a, unsigned char* wsl, const float* gpost, size_t ysrc, bool final_out, int tid) {
    const int G = gridDim.x, lane = tid & 63, wave = tid >> 6, gw = blockIdx.x * 8 + wave, NGW = G * 8;
    float* xo = a.out; bf16_t* xb = (bf16_t*)(wsl + WS_XBF); float* rs = (float*)(wsl + WS_RS); const bf16_t* y = (const bf16_t*)(wsl + ysrc);
    f32x4 gv[4];
#pragma unroll
    for (int j = 0; j < 2; ++j) { gv[2 * j] = *(const f32x4*)(gpost + 8 * lane + 512 * j); gv[2 * j + 1] = *(const f32x4*)(gpost + 8 * lane + 512 * j + 4); }
    constexpr int NR = 4;
    for (int grp = gw; grp < MTOK / NR; grp += NGW) {
        u32x4 yw[NR][2], xw[NR][2];
#pragma unroll
        for (int r = 0; r < NR; ++r) { const size_t off = (size_t)(grp * NR + r) * DM + 8 * lane;
#pragma unroll
            for (int j = 0; j < 2; ++j) { yw[r][j] = *(const u32x4*)(y + off + 512 * j); xw[r][j] = *(const u32x4*)(xb + off + 512 * j); } }
        float ss[NR];
#pragma unroll
        for (int r = 0; r < NR; ++r) { float s_ = 0.f;
#pragma unroll
            for (int j = 0; j < 2; ++j) { const u32x4 w = yw[r][j]; const float e0 = bflo(w.x), e1 = bfhi(w.x), e2 = bflo(w.y), e3 = bfhi(w.y), e4 = bflo(w.z), e5 = bfhi(w.z), e6 = bflo(w.w), e7 = bfhi(w.w);
                s_ += e0 * e0 + e1 * e1 + e2 * e2 + e3 * e3 + e4 * e4 + e5 * e5 + e6 * e6 + e7 * e7; }
            ss[r] = s_; }
#pragma unroll
        for (int o = 1; o < 64; o <<= 1) {
#pragma unroll
            for (int r = 0; r < NR; ++r) ss[r] += __shfl_xor(ss[r], o); }
        float xs[NR];
#pragma unroll
        for (int r = 0; r < NR; ++r) { const float ry = 1.0f / sqrtf(ss[r] * (1.0f / DM) + EPS); float s_ = 0.f; const size_t off = (size_t)(grp * NR + r) * DM + 8 * lane;
#pragma unroll
            for (int j = 0; j < 2; ++j) { const u32x4 w = yw[r][j]; const u32x4 xx = xw[r][j]; f32x4 a0, a1;
                a0[0] = bflo(xx.x) + bflo(w.x) * ry * gv[2 * j][0]; a0[1] = bfhi(xx.x) + bfhi(w.x) * ry * gv[2 * j][1]; a0[2] = bflo(xx.y) + bflo(w.y) * ry * gv[2 * j][2]; a0[3] = bfhi(xx.y) + bfhi(w.y) * ry * gv[2 * j][3];
                a1[0] = bflo(xx.z) + bflo(w.z) * ry * gv[2 * j + 1][0]; a1[1] = bfhi(xx.z) + bfhi(w.z) * ry * gv[2 * j + 1][1]; a1[2] = bflo(xx.w) + bflo(w.w) * ry * gv[2 * j + 1][2]; a1[3] = bfhi(xx.w) + bfhi(w.w) * ry * gv[2 * j + 1][3];
                if (final_out) { *(f32x4*)(xo + off + 512 * j) = a0; *(f32x4*)(xo + off + 512 * j + 4) = a1; }
                else { u32x4 o; o.x = pk2(a0[0], a0[1]); o.y = pk2(a0[2], a0[3]); o.z = pk2(a1[0], a1[1]); o.w = pk2(a1[2], a1[3]); *(u32x4*)(xb + off + 512 * j) = o;
                    const float b0 = bflo(o.x), b1 = bfhi(o.x), b2 = bflo(o.y), b3 = bfhi(o.y), b4 = bflo(o.z), b5 = bfhi(o.z), b6 = bflo(o.w), b7 = bfhi(o.w);
                    s_ += b0 * b0 + b1 * b1 + b2 * b2 + b3 * b3 + b4 * b4 + b5 * b5 + b6 * b6 + b7 * b7; } }
            xs[r] = s_; }
        if (!final_out) {
#pragma unroll
            for (int o = 1; o < 64; o <<= 1) {
#pragma unroll
                for (int r = 0; r < NR; ++r) xs[r] += __shfl_xor(xs[r], o); }
            if (lane == 0) {
#pragma unroll
                for (int r = 0; r < NR; ++r) rs[grp * NR + r] = 1.0f / sqrtf(xs[r] * (1.0f / DM) + EPS); } }
    }
}

__device__ __forceinline__ void unpack8(const u32x4 w, float (&f)[8]) { f[0] = bflo(w.x); f[1] = bfhi(w.x); f[2] = bflo(w.y); f[3] = bfhi(w.y); f[4] = bflo(w.z); f[5] = bfhi(w.z); f[6] = bflo(w.w); f[7] = bfhi(w.w); }
__device__ __forceinline__ u32x4 pack8(const float (&f)[8]) { u32x4 o; o.x = pk2(f[0], f[1]); o.y = pk2(f[2], f[3]); o.z = pk2(f[4], f[5]); o.w = pk2(f[6], f[7]); return o; }

__device__ __forceinline__ void phase_e1(const Args& a, unsigned char* wsl, int l, LAS unsigned char* lds, int tid) {
    const int lane = tid & 63, wid = __builtin_amdgcn_readfirstlane(tid >> 6), r32 = lane & 31, hi = lane >> 5;
    unsigned char* ws = wsl;
    const bf16_t* P = (const bf16_t*)(ws + WS_PROJ); bf16_t* CQN = (bf16_t*)(ws + WS_CQN); bf16_t* CKVN = (bf16_t*)(ws + WS_CKVN); bf16_t* KR = (bf16_t*)(ws + WS_KR);
    bf16_t* BR = (bf16_t*)(ws + WS_BR); const float* rc = (const float*)(ws + WS_ROPEC); const float* rsn = (const float*)(ws + WS_ROPES);
    const bf16_t* SGWB = (const bf16_t*)(ws + WS_SGW);
    const float* convw = a.in[I_CONVW] + l * 3 * 256; const float* lng = a.in[I_LNG] + l * 256; const float* lnb = a.in[I_LNB] + l * 256; const float* sgb = a.in[I_SGB] + l * 512;
    for (int tile = blockIdx.x; tile < MTOK / 128; tile += gridDim.x) {
        const int R0 = tile * 128, s0 = R0 & (SEQ - 1);
        { const int rsub = lane >> 4, li = lane & 15;
#pragma unroll
          for (int it2 = 0; it2 < 2; ++it2) {
              u32x4 cqa[2], cqb[2], ckv[2]; float x1[2], x2[2], cc[2], ss[2];
#pragma unroll
              for (int u = 0; u < 2; ++u) { const int row = R0 + wid * 16 + (it2 * 2 + u) * 4 + rsub; const bf16_t* pr = P + (size_t)row * 2048;
                  cqa[u] = *(const u32x4*)(pr + 8 * li); cqb[u] = *(const u32x4*)(pr + 128 + 8 * li); ckv[u] = *(const u32x4*)(pr + 256 + 8 * li);
                  x1[u] = bf2f(pr[384 + li]); x2[u] = bf2f(pr[400 + li]); cc[u] = rc[(size_t)row * 16 + li]; ss[u] = rsn[(size_t)row * 16 + li]; }
#pragma unroll
              for (int u = 0; u < 2; ++u) { const int row = R0 + wid * 16 + (it2 * 2 + u) * 4 + rsub;
                  float qa[8], qb[8], kv[8]; unpack8(cqa[u], qa); unpack8(cqb[u], qb); unpack8(ckv[u], kv);
                  float sq = 0.f, sk = 0.f;
#pragma unroll
                  for (int e = 0; e < 8; ++e) { sq += qa[e] * qa[e] + qb[e] * qb[e]; sk += kv[e] * kv[e]; }
#pragma unroll
                  for (int o = 1; o < 16; o <<= 1) { sq += __shfl_xor(sq, o); sk += __shfl_xor(sk, o); }
                  const float rq = 1.0f / sqrtf(sq * (1.0f / 256.0f) + EPS), rk = 1.0f / sqrtf(sk * (1.0f / 128.0f) + EPS);
#pragma unroll
                  for (int e = 0; e < 8; ++e) { qa[e] *= rq; qb[e] *= rq; kv[e] *= rk; }
                  *(u32x4*)(CQN + (size_t)row * 256 + 8 * li) = pack8(qa); *(u32x4*)(CQN + (size_t)row * 256 + 128 + 8 * li) = pack8(qb);
                  *(u32x4*)(CKVN + (size_t)row * 128 + 8 * li) = pack8(kv);
                  KR[(size_t)row * 32 + li] = (bf16_t)f2bf(x1[u] * cc[u] - x2[u] * ss[u]); KR[(size_t)row * 32 + 16 + li] = (bf16_t)f2bf(x2[u] * cc[u] + x1[u] * ss[u]); } } }
        { const int ch = tid & 31, run = tid >> 5, t0 = run * 8; const bf16_t* pb = P + (size_t)(R0 + t0) * 2048 + 8 * ch; const int sb = s0 + t0;
          { float w0[8], w1[8], w2[8];
#pragma unroll
            for (int e = 0; e < 8; ++e) { w0[e] = convw[8 * ch + e]; w1[e] = convw[256 + 8 * ch + e]; w2[e] = convw[512 + 8 * ch + e]; }
            float zm2[8], zm1[8];
#pragma unroll
            for (int e = 0; e < 8; ++e) { zm2[e] = 0.f; zm1[e] = 0.f; }
            if (sb >= 2) { float xv[8], cv[8]; unpack8(*(const u32x4*)(pb - 2 * 2048 + 1024), xv); unpack8(*(const u32x4*)(pb - 2 * 2048 + 1536), cv);
#pragma unroll
                for (int e = 0; e < 8; ++e) zm2[e] = xv[e] * cv[e]; }
            if (sb >= 1) { float xv[8], cv[8]; unpack8(*(const u32x4*)(pb - 2048 + 1024), xv); unpack8(*(const u32x4*)(pb - 2048 + 1536), cv);
#pragma unroll
                for (int e = 0; e < 8; ++e) zm1[e] = xv[e] * cv[e]; }
#pragma unroll
            for (int half = 0; half < 2; ++half) { u32x4 lx[4], lc[4], lb[4];
#pragma unroll
                for (int j = 0; j < 4; ++j) { const bf16_t* pr = pb + (size_t)(half * 4 + j) * 2048; lx[j] = *(const u32x4*)(pr + 1024); lc[j] = *(const u32x4*)(pr + 1536); lb[j] = *(const u32x4*)(pr + 1280); }
#pragma unroll
                for (int j = 0; j < 4; ++j) { float xv[8], cv[8], bg[8], y[8]; unpack8(lx[j], xv); unpack8(lc[j], cv); unpack8(lb[j], bg);
#pragma unroll
                    for (int e = 0; e < 8; ++e) { const float z = xv[e] * cv[e]; y[e] = bg[e] * (w0[e] * zm2[e] + w1[e] * zm1[e] + w2[e] * z); zm2[e] = zm1[e]; zm1[e] = z; }
                    *(u32x4*)(BR + (size_t)(R0 + t0 + half * 4 + j) * DM + 512 + 8 * ch) = pack8(y); } } }
          { const int g = ch >> 3, win = 2 << g; float S[8];
#pragma unroll
            for (int e = 0; e < 8; ++e) S[e] = 0.f;
            for (int i = 1; i < win; ++i) { if (sb - i >= 0) { float pv[8]; unpack8(*(const u32x4*)(pb - (size_t)i * 2048 + 1792), pv);
#pragma unroll
                    for (int e = 0; e < 8; ++e) S[e] += pv[e]; } }
#pragma unroll
            for (int half = 0; half < 2; ++half) { u32x4 lp[4], lo[4];
#pragma unroll
                for (int j = 0; j < 4; ++j) { const int t = half * 4 + j; lp[j] = *(const u32x4*)(pb + (size_t)t * 2048 + 1792);
                    const int back = t - win + 1; lo[j] = (sb + back >= 0) ? *(const u32x4*)(pb + (ptrdiff_t)back * 2048 + 1792) : (u32x4){0u, 0u, 0u, 0u}; }
#pragma unroll
                for (int j = 0; j < 4; ++j) { const int t = half * 4 + j; float pt[8], po[8], o[8]; unpack8(lp[j], pt); unpack8(lo[j], po);
                    const int s = sb + t; const int cnt = (s + 1) < win ? (s + 1) : win; const float ic = 1.0f / (float)cnt;
#pragma unroll
                    for (int e = 0; e < 8; ++e) { S[e] += pt[e]; o[e] = S[e] * ic - pt[e]; S[e] -= po[e]; }
                    *(u32x4*)(BR + (size_t)(R0 + t0 + t) * DM + 768 + 8 * ch) = pack8(o); } } } }
        { const int srow = tid >> 2, qt = tid & 3; const bf16_t* vp = P + (size_t)(R0 + srow) * 2048 + 768 + qt * 64;
          float v[64]; float sum = 0.f;
#pragma unroll
          for (int j = 0; j < 8; ++j) { const u32x4 w = *(const u32x4*)(vp + 8 * j);
              v[8 * j + 0] = bflo(w.x); v[8 * j + 1] = bfhi(w.x); v[8 * j + 2] = bflo(w.y); v[8 * j + 3] = bfhi(w.y); v[8 * j + 4] = bflo(w.z); v[8 * j + 5] = bfhi(w.z); v[8 * j + 6] = bflo(w.w); v[8 * j + 7] = bfhi(w.w); }
#pragma unroll
          for (int j = 0; j < 64; ++j) sum += v[j];
          sum += __shfl_xor(sum, 1); sum += __shfl_xor(sum, 2);
          const float mean = sum * (1.0f / 256.0f); float var = 0.f;
#pragma unroll
          for (int j = 0; j < 64; ++j) { v[j] -= mean; var += v[j] * v[j]; }
          var += __shfl_xor(var, 1); var += __shfl_xor(var, 2);
          const float rstd = 1.0f / sqrtf(var * (1.0f / 256.0f) + EPS);
          LAS bf16_t* vT = (LAS bf16_t*)lds;
#pragma unroll
          for (int j = 0; j < 64; ++j) { const int c = qt * 64 + j; vT[c * 136 + srow] = (bf16_t)f2bf(v[j] * rstd * lng[c] + lnb[c]); } }
        __syncthreads();
        { const int g = wid >> 1, th = wid & 1;
#pragma unroll
          for (int tb = 0; tb < 2; ++tb) {
              const int nks = (64 * th + 32 * tb + 32) >> 4;
              const bf16_t* ap = SGWB + (size_t)(g * 128 + 64 * th + 32 * tb + r32) * 128 + 8 * hi;
              bf16x8 Af[8];
#pragma unroll
              for (int ks = 0; ks < 8; ++ks) Af[ks] = (ks < nks) ? *(const bf16x8*)(ap + 16 * ks) : (bf16x8){0, 0, 0, 0, 0, 0, 0, 0};
              float bsv[16];
#pragma unroll
              for (int r = 0; r < 16; ++r) bsv[r] = sgb[g * 128 + 64 * th + 32 * tb + crow(r, hi)];
#pragma unroll
              for (int cb = 0; cb < 2; ++cb) { f32x16 acc;
#pragma unroll
                  for (int r = 0; r < 16; ++r) acc[r] = 0.f;
                  const LAS unsigned char* bp = lds + (g * 64 + 32 * cb + r32) * 272 + 16 * hi;
                  const int c = g * 64 + 32 * cb + r32;
                  float uv[16];
#pragma unroll
                  for (int r = 0; r < 16; ++r) uv[r] = bf2f(P[(size_t)(R0 + 64 * th + 32 * tb + crow(r, hi)) * 2048 + 512 + c]);
#pragma unroll
                  for (int ks = 0; ks < 8; ++ks) { if (ks < nks) { const bf16x8 B = *(const LAS bf16x8*)(bp + 32 * ks); acc = MFMA32(Af[ks], B, acc); } }
#pragma unroll
                  for (int r = 0; r < 16; ++r) { const int t = 64 * th + 32 * tb + crow(r, hi);
                      BR[(size_t)(R0 + t) * DM + 256 + c] = (bf16_t)f2bf(uv[r] * (acc[r] + bsv[r])); } } } }
        __syncthreads();
    }
}

constexpr int KPITCH = 208, VPITCH = 264, KBUF = 128 * KPITCH, VBUF = 64 * VPITCH, ATT_V0 = 2 * KBUF, ATT_WS = ATT_V0 + 2 * VBUF;
#define MX3(a, b, c) __builtin_fmaxf(__builtin_fmaxf((a), (b)), (c))
#define ATT_QK(P0, P1, KB) do { \
    _Pragma("unroll") for (int kh = 0; kh < 2; ++kh) { bf16x8 ka_[3], kc_[3]; \
        _Pragma("unroll") for (int ks = 0; ks < 3; ++ks) { ka_[ks] = *(const LAS bf16x8*)((KB) + (3 * kh + ks) * 32); kc_[ks] = *(const LAS bf16x8*)((KB) + 32 * KPITCH + (3 * kh + ks) * 32); } \
        _Pragma("unroll") for (int ks = 0; ks < 3; ++ks) { if (kh == 0 && ks == 0) { P0 = MFMA32(ka_[0], qf[0], negm); P1 = MFMA32(kc_[0], qf[0], negm); } \
            else { P0 = MFMA32(ka_[ks], qf[3 * kh + ks], P0); P1 = MFMA32(kc_[ks], qf[3 * kh + ks], P1); } } } } while (0)
#define ATT_MAX(P0, P1, TT) do { \
    if (64 * (TT) + 63 > qw0) { const int qg_ = qw0 + r32; \
        _Pragma("unroll") for (int r = 0; r < 16; ++r) { const int kv_ = 64 * (TT) + crow(r, hi); if (kv_ > qg_) P0[r] = -INFINITY; if (kv_ + 32 > qg_) P1[r] = -INFINITY; } } \
    float ra_ = MX3(P0[0], P0[1], P1[0]), rb_ = MX3(P0[2], P0[3], P1[1]); ra_ = MX3(ra_, P1[2], P1[3]); \
    _Pragma("unroll") for (int r = 4; r < 16; r += 4) { ra_ = MX3(ra_, P0[r], P0[r + 1]); rb_ = MX3(rb_, P0[r + 2], P0[r + 3]); ra_ = MX3(ra_, P1[r], P1[r + 1]); rb_ = MX3(rb_, P1[r + 2], P1[r + 3]); } \
    float rm_ = __builtin_fmaxf(ra_, rb_); rm_ = __builtin_fmaxf(rm_, __shfl_xor(rm_, 32));        \
    const bool first_ = ((TT) == 0); \
    if (first_ || __any(rm_ > 8.0f)) { const float dl_ = first_ ? rm_ : __builtin_fmaxf(rm_, 0.f); mref += dl_; \
        _Pragma("unroll") for (int r = 0; r < 16; ++r) { P0[r] -= dl_; P1[r] -= dl_; } \
        _Pragma("unroll") for (int r = 0; r < 16; ++r) negm[r] = -mref; \
        const float alpha_ = __builtin_amdgcn_exp2f(-dl_); lsum *= alpha_; if (hi == 0) wsf[r32] = alpha_; \
        asm volatile("s_waitcnt lgkmcnt(0)" ::: "memory"); \
        _Pragma("unroll") for (int r = 0; r < 16; ++r) { const float f_ = wsf[crow(r, hi)]; o0[r] *= f_; o1[r] *= f_; } } } while (0)
#define ATT_EXP(P0, P1, PA) do { float ps_ = 0.f; \
    _Pragma("unroll") for (int r = 0; r < 16; ++r) { P0[r] = __builtin_amdgcn_exp2f(P0[r]); P1[r] = __builtin_amdgcn_exp2f(P1[r]); ps_ += P0[r] + P1[r]; } \
    lsum += ps_; u32x4 w_; \
    w_.x = cvtpk_v(P0[0], P0[1]); w_.y = cvtpk_v(P0[2], P0[3]); w_.z = cvtpk_v(P0[4], P0[5]); w_.w = cvtpk_v(P0[6], P0[7]); PA[0] = __builtin_bit_cast(bf16x8, w_); \
    w_.x = cvtpk_v(P0[8], P0[9]); w_.y = cvtpk_v(P0[10], P0[11]); w_.z = cvtpk_v(P0[12], P0[13]); w_.w = cvtpk_v(P0[14], P0[15]); PA[1] = __builtin_bit_cast(bf16x8, w_); \
    w_.x = cvtpk_v(P1[0], P1[1]); w_.y = cvtpk_v(P1[2], P1[3]); w_.z = cvtpk_v(P1[4], P1[5]); w_.w = cvtpk_v(P1[6], P1[7]); PA[2] = __builtin_bit_cast(bf16x8, w_); \
    w_.x = cvtpk_v(P1[8], P1[9]); w_.y = cvtpk_v(P1[10], P1[11]); w_.z = cvtpk_v(P1[12], P1[13]); w_.w = cvtpk_v(P1[14], P1[15]); PA[3] = __builtin_bit_cast(bf16x8, w_); } while (0)
#define ATT_PV(PA, VB) do { \
    _Pragma("unroll") for (int kk = 0; kk < 4; ++kk) { \
        const s16x4 l0_ = *(const LAS s16x4*)((VB) + kk * 32), h0_ = *(const LAS s16x4*)((VB) + kk * 32 + 16); \
        const s16x4 l1_ = *(const LAS s16x4*)((VB) + 32 * VPITCH + kk * 32), h1_ = *(const LAS s16x4*)((VB) + 32 * VPITCH + kk * 32 + 16); \
        const bf16x8 v0_ = __builtin_shufflevector(l0_, h0_, 0, 1, 2, 3, 4, 5, 6, 7), v1_ = __builtin_shufflevector(l1_, h1_, 0, 1, 2, 3, 4, 5, 6, 7); \
        o0 = MFMA32(PA[kk], v0_, o0); o1 = MFMA32(PA[kk], v1_, o1); } } while (0)

__device__ __forceinline__ void attn_unit(const Args& a, unsigned char* wsl, int b, int h, int qb, LAS unsigned char* lds, int tid_in) {
    int tid = tid_in; asm volatile("" : "+v"(tid));
    const int lane = tid & 63, wid = __builtin_amdgcn_readfirstlane(tid >> 6), r32 = lane & 31, hi = lane >> 5;
    unsigned char* ws = wsl;
    const bf16_t* Q = (const bf16_t*)(ws + WS_Q); const bf16_t* Kn = (const bf16_t*)(ws + WS_KN); const bf16_t* Kr = (const bf16_t*)(ws + WS_KR); const bf16_t* Vt = (const bf16_t*)(ws + WS_VT);
    bf16_t* O = (bf16_t*)(ws + WS_BR); const float* rc = (const float*)(ws + WS_ROPEC); const float* rsn = (const float*)(ws + WS_ROPES);
    const size_t rowbase = (size_t)b * SEQ; const int qw0 = qb * 256 + wid * 32;
    LAS float* wsf = (LAS float*)(lds + ATT_WS) + wid * 64;
    bf16x8 qf[6];
    { const size_t qrow = rowbase + qw0 + r32; const bf16_t* qp = Q + qrow * 512 + h * 96 + 8 * hi;
#pragma unroll
      for (int ks = 0; ks < 4; ++ks) qf[ks] = *(const bf16x8*)(qp + 16 * ks);
      const bf16x8 x1 = *(const bf16x8*)(qp + 64), x2 = *(const bf16x8*)(qp + 80);
      const float* cp = rc + qrow * 16 + 8 * hi; const float* sp = rsn + qrow * 16 + 8 * hi;
      const f32x4 c0 = *(const f32x4*)cp, c1 = *(const f32x4*)(cp + 4), s0 = *(const f32x4*)sp, s1 = *(const f32x4*)(sp + 4);
      bf16x8 o1, o2;
#pragma unroll
      for (int j = 0; j < 8; ++j) { const float xa = bf2f((bf16_t)x1[j]), xb = bf2f((bf16_t)x2[j]); const float c = j < 4 ? c0[j & 3] : c1[j & 3], s = j < 4 ? s0[j & 3] : s1[j & 3];
          o1[j] = (short)f2bf(xa * c - xb * s); o2[j] = (short)f2bf(xb * c + xa * s); }
      qf[4] = o1; qf[5] = o2; }
    const bf16_t* knu = Kn + rowbase * 256 + h * 64;
    const bf16_t* kru = Kr + rowbase * 32;
    const bf16_t* vtu = Vt + (size_t)(h * 64) * MTOK + rowbase;
    u32x4 gk0, gk1, gr, gv0, gv1;
#define ATT_LOAD(T) do { int t_ = tid; asm volatile("" : "+v"(t_)); const unsigned knv = (unsigned)((t_ >> 3) * 256 + (t_ & 7) * 8), krv = (unsigned)((t_ >> 2) * 32 + (t_ & 3) * 8), vtv = (unsigned)((t_ >> 3) * MTOK + (t_ & 7) * 8); \
        const bf16_t* k_ = knu + (size_t)(T) * 128 * 256; const bf16_t* r_ = kru + (size_t)(T) * 128 * 32; const bf16_t* v_ = vtu + (size_t)(T) * 128; \
        gk0 = *(const u32x4*)(k_ + knv); gk1 = *(const u32x4*)(k_ + 64 * 256 + knv); gr = *(const u32x4*)(r_ + krv); \
        gv0 = *(const u32x4*)(v_ + vtv); gv1 = *(const u32x4*)(v_ + 64 + vtv); } while (0)
#define ATT_STORE(bf) do { int t_ = tid; asm volatile("" : "+v"(t_)); const int krow = t_ >> 3, kch = t_ & 7, rrow = t_ >> 2, rch = t_ & 3; \
        LAS unsigned char* kd_ = lds + (bf) * KBUF; LAS unsigned char* vd_ = lds + ATT_V0 + (bf) * VBUF + krow * VPITCH + kch * 16; \
        *(LAS u32x4*)(kd_ + krow * KPITCH + kch * 16) = gk0; *(LAS u32x4*)(kd_ + (krow + 64) * KPITCH + kch * 16) = gk1; *(LAS u32x4*)(kd_ + rrow * KPITCH + 128 + rch * 16) = gr; \
        *(LAS u32x2*)(vd_) = (u32x2){gv0.x, gv0.y}; *(LAS u32x2*)(vd_ + 8) = (u32x2){gv0.z, gv0.w}; *(LAS u32x2*)(vd_ + 128) = (u32x2){gv1.x, gv1.y}; *(LAS u32x2*)(vd_ + 136) = (u32x2){gv1.z, gv1.w}; } while (0)
    float mref = 0.f, lsum = 0.f; f32x16 o0, o1, negm;
#pragma unroll
    for (int r = 0; r < 16; ++r) { o0[r] = 0.f; o1[r] = 0.f; negm[r] = 0.f; }
    const int NT2 = 2 * qb + 2;
    ATT_LOAD(0); ATT_STORE(0); __syncthreads();
    for (int T = 0; T < NT2; ++T) {
        const int buf = T & 1;
        if (T + 1 < NT2) ATT_LOAD(T + 1);
        const int tA = 2 * T, tB = 2 * T + 1;
        const LAS unsigned char* kbA = lds + buf * KBUF + r32 * KPITCH + hi * 16; const LAS unsigned char* kbB = kbA + 64 * KPITCH;
        const LAS unsigned char* vbA = lds + ATT_V0 + buf * VBUF + r32 * VPITCH + hi * 8; const LAS unsigned char* vbB = vbA + 128;
        if (64 * tB <= qw0 + 31) {
            f32x16 pA0, pA1, pB0, pB1; bf16x8 pa[4];
            ATT_QK(pA0, pA1, kbA);
            ATT_MAX(pA0, pA1, tA);
            ATT_QK(pB0, pB1, kbB);
            ATT_EXP(pA0, pA1, pa);
            ATT_MAX(pB0, pB1, tB);
            ATT_PV(pa, vbA);
            ATT_EXP(pB0, pB1, pa);
            ATT_PV(pa, vbB);
        } else if (64 * tA <= qw0 + 31) {
            f32x16 pA0, pA1; bf16x8 pa[4];
            ATT_QK(pA0, pA1, kbA);
            ATT_MAX(pA0, pA1, tA);
            ATT_EXP(pA0, pA1, pa);
            ATT_PV(pa, vbA);
        }
        if (T + 1 < NT2) ATT_STORE((T + 1) & 1);
        __syncthreads();
    }
#undef ATT_LOAD
#undef ATT_STORE
    lsum += __shfl_xor(lsum, 32);
    if (hi == 0) wsf[32 + r32] = 1.0f / lsum;
    asm volatile("s_waitcnt lgkmcnt(0)" ::: "memory");
    { bf16_t* ou = O + (rowbase + qw0) * DM + h * 64;
#pragma unroll
      for (int r = 0; r < 16; ++r) { const int qr = crow(r, hi); const float inv = wsf[32 + qr]; const unsigned ov = (unsigned)(qr * DM + r32);
          ou[ov] = (bf16_t)f2bf(o0[r] * inv); ou[ov + 32] = (bf16_t)f2bf(o1[r] * inv); } }
}
__device__ __forceinline__ void phase_attn(const Args& a, unsigned char* wsl, LAS unsigned char* lds, int tid) {
    const int G = gridDim.x, bx = blockIdx.x; const int v0 = (G % 8 == 0) ? (bx % 8) * (G / 8) + bx / 8 : bx;
    for (int v = v0; v < 256; v += G) { const int bh = v >> 4, s = v & 15;
        attn_unit(a, wsl, bh >> 2, bh & 3, 31 - s, lds, tid);
        attn_unit(a, wsl, bh >> 2, bh & 3, s, lds, tid); }
}

#define XB_TMO      128
#define XB_XCNT(j)  (256  + 64 * (j))
#define XB_XSUB(j)  (1280 + 64 * (j))
#define XB_XGEN(j)  (2304 + 64 * (j))
#define XB_TOP      3328
#define XB_TOPGEN   3392
#define XCD_BAR_WORDS 3456
#define XB_SPIN_CAP (1u << 18)

__device__ __forceinline__ unsigned xb_ld(unsigned* p)              { return __hip_atomic_load(p, __ATOMIC_RELAXED, __HIP_MEMORY_SCOPE_AGENT); }
__device__ __forceinline__ unsigned xb_add(unsigned* p, unsigned v) { return __hip_atomic_fetch_add(p, v, __ATOMIC_RELAXED, __HIP_MEMORY_SCOPE_AGENT); }
__device__ __forceinline__ unsigned xb_xcc_id() { return (unsigned)__builtin_amdgcn_s_getreg((3 << 11) | 20) & 0xFu; }
#define XB_SPIN(cond, bar) do { unsigned _sp = 0; while (cond) { __builtin_amdgcn_s_sleep(1); \
    if ((++_sp & 255u) == 0u) { if (xb_ld(&(bar)[XB_TMO])) break; if (_sp > XB_SPIN_CAP) { atomicAdd(&(bar)[XB_TMO], 1u); break; } } } } while (0)

struct XcdBarrier {
    unsigned* bar; unsigned x;
    volatile LAS unsigned* st;
};

__device__ __forceinline__ XcdBarrier xcd_barrier_post(unsigned* bar, volatile LAS unsigned* st) {
    XcdBarrier b; b.bar = bar; b.x = xb_xcc_id(); b.st = st;
    if (threadIdx.x == 0) (void)xb_add(&bar[XB_XCNT(b.x)], 1u);
    return b;
}
__device__ __forceinline__ void xcd_barrier_complete(unsigned* bar, unsigned x, unsigned& nloc, unsigned& nx) {
    const unsigned G = gridDim.x * gridDim.y * gridDim.z;
    unsigned sum, cnt, mine, sp = 0u;
    for (;;) {
        sum = 0u; cnt = 0u; mine = 0u;
#pragma unroll
        for (unsigned j = 0; j < 16; ++j) { const unsigned c = xb_ld(&bar[XB_XCNT(j)]); sum += c; cnt += (c > 0u) ? 1u : 0u; mine = (j == x) ? c : mine; }
        if (sum == G) break;
        __builtin_amdgcn_s_sleep(1);
        if ((++sp & 255u) == 0u) { if (xb_ld(&bar[XB_TMO])) break; if (sp > XB_SPIN_CAP) { atomicAdd(&bar[XB_TMO], 1u); break; } }
    }
    nloc = mine > 0u ? mine : 1u; nx = cnt > 0u ? cnt : 1u;
}

__device__ __forceinline__ void xcd_barrier(const XcdBarrier& b) {
    asm volatile("s_waitcnt vmcnt(0)" ::: "memory");
    __syncthreads();
    if (threadIdx.x == 0) {
        unsigned* bar = b.bar;
        __builtin_amdgcn_s_waitcnt(0);
        unsigned nloc = b.st[0], nx = b.st[1];
        if (nloc == 0u) { xcd_barrier_complete(bar, b.x, nloc, nx); b.st[0] = nloc; b.st[1] = nx; }
        const unsigned old = xb_add(&bar[XB_XSUB(b.x)], 1u);
        const unsigned gen = old / nloc;
        if (old + 1u == (gen + 1u) * nloc) {
            __builtin_amdgcn_fence(__ATOMIC_RELEASE, "agent");
            asm volatile("s_waitcnt vmcnt(0)" ::: "memory");
            const unsigned og = xb_add(&bar[XB_TOP], 1u);
            const unsigned tg = og / nx;
            if (og + 1u == (tg + 1u) * nx) xb_add(&bar[XB_TOPGEN], 1u);
            else XB_SPIN(xb_ld(&bar[XB_TOPGEN]) == tg, bar);
            __builtin_amdgcn_fence(__ATOMIC_ACQUIRE, "agent");
            xb_add(&bar[XB_XGEN(b.x)], 1u);
            asm volatile("s_waitcnt vmcnt(0)" ::: "memory");
        } else {
            XB_SPIN(xb_ld(&bar[XB_XGEN(b.x)]) == gen, bar);
            __builtin_amdgcn_fence(__ATOMIC_ACQUIRE, "agent");
            asm volatile("s_waitcnt vmcnt(0)" ::: "memory");
        }
    }
    __syncthreads();
}

__global__ void __launch_bounds__(512, 2) mk_fwd(Args a) {
    extern __shared__ __attribute__((aligned(16))) unsigned char lds_raw[];
    LAS unsigned char* lds = (LAS unsigned char*)lds_raw;
    cg::grid_group grid = cg::this_grid();
    const int tid0 = threadIdx.x, G = gridDim.x, bx = blockIdx.x;
    { volatile LAS unsigned* st0 = (volatile LAS unsigned*)(lds + 131072 + 64); if (tid0 == 0) { st0[0] = 0u; st0[1] = 0u; } }
    __syncthreads();
    XcdBarrier xbar = xcd_barrier_post((unsigned*)a.ws, (volatile LAS unsigned*)(lds + 131072 + 64));
    for (int ph = a.lo; ph < a.hi; ++ph) {
        unsigned char* ws = a.ws; int tid = (int)__builtin_amdgcn_workitem_id_x();
        asm volatile("" : "+s"(ws), "+v"(tid));
        int l = 0, k = -1; if (ph > 0) { l = (ph - 1) / 10; k = (ph - 1) % 10; }
        const int ng = (k == 0 || k == 4 || k == 5 || k == 7 || k == 8) ? 1 : (k == 2 ? 3 : 0);
#ifndef PM
#define PM 0xFF
#endif
        if (PM & 1) for (int j = 0; j < ng; ++j) {
            size_t oA, oB, oO; int M_ = MTOK, N_ = DM, K_ = DM, lda = DM, ldb = DM, ldc = DM, mode = 0, nbr = 1, coff = 0, use_rs = 0, zs = 0, bmode = 0, fused = 0, a_in_out = 0, o_in_out = 0;
            if (k == 0) {
                oA = WS_XBF; oB = WS_WIN; oO = WS_BIG; N_ = 2048; ldc = 2048; use_rs = 1; mode = 1;
            } else if (k == 2) {
                if (j == 0) { oA = WS_CQN; oB = WS_WUQ; oO = WS_Q; N_ = 512; K_ = 256; lda = 256; ldb = 256; ldc = 512; }
                else if (j == 1) { oA = WS_CKVN; oB = WS_WK; oO = WS_KN; N_ = 256; K_ = 128; lda = 128; ldb = 128; ldc = 256; }
                else { oA = WS_WV; oB = WS_CKVN; oO = WS_VT; M_ = 256; N_ = MTOK; K_ = 128; lda = 128; ldb = 128; ldc = MTOK; coff = G / 2; }
            } else if (k == 4) {
                oA = WS_BR; oB = WS_WBR; oO = 0; o_in_out = 1; K_ = 256; N_ = DM; bmode = 2; nbr = 8; use_rs = 1; fused = 1;
            } else if (k == 5) {
                oA = 0; a_in_out = 1; oB = WS_WOUT; oO = WS_BIG;
            } else if (k == 7) {
                oA = WS_XBF; oB = WS_W1; oO = WS_BIG; N_ = DFF; ldc = DFF; use_rs = 1; mode = 3;
            } else {
                oA = WS_BIG; oB = WS_W2; oO = WS_BR; K_ = DFF; lda = DFF; ldb = DFF;
            }
            pg8::Gemm g{a_in_out ? (const bf16_t*)a.out : (const bf16_t*)(ws + oA), (const bf16_t*)(ws + oB), M_, N_, K_, lda, ldb, bmode,
                        fused ? (const bf16_t*)(ws + WS_XBF) : nullptr, fused ? (const bf16_t*)(ws + WS_WIN + (size_t)2048 * DM * 2) : nullptr, fused ? DM : 0, fused ? 1 : 0};
            pg8::EpiRT E{o_in_out ? (bf16_t*)a.out : (bf16_t*)(ws + oO), ldc, use_rs ? (const float*)(ws + WS_RS) : nullptr, a.in[I_GATEB] + l * 4096, (const bf16_t*)ws, mode, zs};
            pg8::MergeOrder S; S.init(M_, N_, G, (bx + coff) % G, nbr);
            pg8::gemm_phase<pg8::EpiRT, pg8::MergeOrder, true, true>(lds, g, S, E, tid);
        }
        if ((PM & 2) && k == 1) phase_e1(a, ws, l, lds, tid);
        if ((PM & 4) && k == 3) phase_attn(a, ws, lds, tid);
        if ((PM & 8) && (k == 6 || k == 9)) phase_nr(a, ws, (k == 6 ? a.in[I_NPOST] : a.in[I_NFPOST]) + l * DM, k == 6 ? WS_BIG : WS_BR, (k == 9 && l == NLAYER - 1), tid);
        if ((PM & 16) && ph == 0) phase_s0(a, ws, lds, tid);
        if ((PM & 32) && (ph == 0 || (k == 9 && l + 1 < NLAYER))) prep_weights(a, ws, ph == 0 ? 0 : l + 1, lds, tid);
        if (ph + 1 < a.hi) { if (ph == a.lo) grid.sync(); else xcd_barrier(xbar); }
    }
}

constexpr int NPHASE = 1 + 10 * NLAYER;
#ifndef MK_ONE_LAUNCH
#define MK_ONE_LAUNCH 1
#endif
extern "C" void kernel_launch(void* const* d_in, const int* in_sizes, int n_in, void* d_out, int out_size, void* d_ws, size_t ws_size, hipStream_t stream) {
    static int grid = 0;
    if (grid == 0) {
        if (n_in != 26 || out_size != MTOK * DM || ws_size < WS_END) { fprintf(stderr, "kernel_launch: unexpected shapes (n_in %d out %d ws %zu)\n", n_in, out_size, ws_size); grid = -1; return; }
        int dev = 0, cus = 0, per_cu = 0;
        hipGetDevice(&dev); hipDeviceGetAttribute(&cus, hipDeviceAttributeMultiprocessorCount, dev);
        hipFuncSetAttribute((const void*)mk_fwd, hipFuncAttributeMaxDynamicSharedMemorySize, LDS_BYTES);
        hipOccupancyMaxActiveBlocksPerMultiprocessor(&per_cu, (const void*)mk_fwd, 512, LDS_BYTES);
        if (per_cu < 1) { fprintf(stderr, "kernel_launch: occupancy query says %d blocks per CU\n", per_cu); per_cu = 1; }
        (void)hipGetLastError();
        grid = cus;
    }
    if (grid < 0) return;
    Args a{};
    for (int i = 0; i < 26; ++i) a.in[i] = (const float*)d_in[i];
    a.out = (float*)d_out; a.ws = (unsigned char*)d_ws;
    if (hipMemsetAsync(d_ws, 0, 16384, stream) != hipSuccess) { fprintf(stderr, "memset failed\n"); return; }
#if MK_ONE_LAUNCH
    a.lo = 0; a.hi = NPHASE;
    { void* args[] = {&a}; hipError_t e = hipLaunchCooperativeKernel((const void*)mk_fwd, dim3(grid), dim3(512), args, LDS_BYTES, stream);
      if (e != hipSuccess) fprintf(stderr, "cooperative launch failed: %s (grid %d)\n", hipGetErrorString(e), grid); }
#else
    for (int ph = 0; ph < NPHASE; ++ph) { a.lo = ph; a.hi = ph + 1;
        void* args[] = {&a}; hipError_t e = hipLaunchCooperativeKernel((const void*)mk_fwd, dim3(grid), dim3(512), args, LDS_BYTES, stream);
        if (e != hipSuccess) { fprintf(stderr, "launch %d failed: %s (grid %d)\n", ph, hipGetErrorString(e), grid); break; } }
#endif
}
```

```cpp
#include <hip/hip_runtime.h>
#include <hip/hip_cooperative_groups.h>
#include <cstdio>
#include <cstdint>
namespace cg = cooperative_groups;

#define LAS __attribute__((address_space(3)))
typedef unsigned short bf16_t;
typedef short bf16x8 __attribute__((ext_vector_type(8)));
typedef short s16x4 __attribute__((ext_vector_type(4)));
typedef float f32x4 __attribute__((ext_vector_type(4)));
typedef float f32x2 __attribute__((ext_vector_type(2)));
typedef float f32x16 __attribute__((ext_vector_type(16)));
typedef unsigned u32x4 __attribute__((ext_vector_type(4)));
typedef unsigned u32x2 __attribute__((ext_vector_type(2)));

__device__ __forceinline__ unsigned f2bf(float f) { unsigned u = __builtin_bit_cast(unsigned, f); return (u + 0x7fffu + ((u >> 16) & 1u)) >> 16; }
__device__ __forceinline__ unsigned pk2(float lo, float hi) { return f2bf(lo) | (f2bf(hi) << 16); }
__device__ __forceinline__ float bflo(unsigned w) { return __builtin_bit_cast(float, w << 16); }
__device__ __forceinline__ float bfhi(unsigned w) { return __builtin_bit_cast(float, w & 0xffff0000u); }
__device__ __forceinline__ float bf2f(bf16_t h) { return __builtin_bit_cast(float, ((unsigned)h) << 16); }
__device__ __forceinline__ float wave_sum(float v) {
#pragma unroll
    for (int o = 1; o < 64; o <<= 1) v += __shfl_xor(v, o);
    return v;
}
__device__ __forceinline__ float fast_sigmoid(float v) { return __builtin_amdgcn_rcpf(1.0f + __builtin_amdgcn_exp2f(-1.4426950408889634f * v)); }
__device__ __forceinline__ float gelu_tanh(float x) { const float u = 0.7978845608028654f * (x + 0.044715f * x * x * x); return x * fast_sigmoid(2.0f * u); }

namespace pg8 {
#define PG8_LAS __attribute__((address_space(3)))
constexpr int BM = 256, BK = 64, HALF = 128, HTB = HALF * BK * 2  , STAGE_BYTES = 8 * HTB, NXCD = 8, WGM = 8;

__host__ __device__ __forceinline__ int lds_byte(int r, int c) { const int st = (r >> 4) * 2 + (c >> 5), rr = r & 15, cc = c & 31, ob = rr * 64 + cc * 2; return st * 1024 + (ob ^ (((ob >> 9) & 1) << 5)); }
__host__ __device__ __forceinline__ void stage_rc(int b, int& R, int& C) { const int st = b / 1024, sb = b % 1024, swz = sb ^ (((sb >> 9) & 1) << 5); R = (st >> 1) * 16 + swz / 64; C = (st & 1) * 32 + (swz % 64) / 2; }
__host__ __device__ __forceinline__ int perm32(int rho) { const int n = rho >> 4, i = rho & 15; return 8 * (i >> 2) + 4 * n + (i & 3); }

struct Unit { int pm, pn, bn, ak, z, kind, mode; };
struct Gemm { const bf16_t* A; const bf16_t* Bt; int M, N, K, lda, ldb, bmode; const bf16_t* A1; const bf16_t* B1; int K1, bmode1; };

struct StaticOrder {
    int nM, nN, nwg, G, c;
    __host__ __device__ void init(int M, int N, int G_, int c_) { nM = M / BM; nN = N / BM; nwg = nM * nN; G = G_; c = c_; }
    __host__ __device__ bool map(long L, Unit& u) const {
        if (L >= nwg) return false;
        int wgid = (int)L; { const int q = nwg / NXCD, r = nwg % NXCD, xcd = wgid % NXCD, off = wgid / NXCD; wgid = (xcd < r ? xcd * (q + 1) : r * (q + 1) + (xcd - r) * q) + off; }
        const int nig = WGM * nN, gid = wgid / nig, fm = gid * WGM, gsz = (nM - fm) < WGM ? (nM - fm) : WGM;
        u.pm = fm + ((wgid % nig) % gsz); u.pn = (wgid % nig) / gsz; return true;
    }
    __host__ __device__ bool next(int i, Unit& u) const { u.ak = 0; u.z = 0; u.kind = 0; u.mode = -1; const bool ok = map((long)i * G + c, u); u.bn = u.pn; return ok; }
    __device__ __forceinline__ void a_ready(const Unit&) const {}
    __device__ __forceinline__ void done(const Unit&) const {}
};
struct MergeOrder {
    StaticOrder S; int nbr;
    __host__ __device__ void init(int M, int N, int G_, int c_, int nbr_) { S.init(M, N, G_, c_); nbr = nbr_; }
    __host__ __device__ bool next(int i, Unit& u) const {
        if (nbr == 8) {
            const int j = i & 7; const bool ok = S.map((long)(i >> 3) * S.G + S.c, u); const int p4 = u.pn;
            if (j < 4) { u.kind = 0; u.mode = 6; u.z = j; u.ak = j * 256; u.bn = j * 4 + p4; }
            else { u.kind = 1; u.mode = 5; u.z = 0; u.ak = 0; u.pn = 4 * p4 + (j - 4); u.bn = u.pn; }
            return ok; }
        u.kind = 0; u.mode = -1; const int z = i % nbr; const bool ok = S.map((long)(i / nbr) * S.G + S.c, u); u.z = z; u.ak = z * 256; u.bn = z * S.nN + u.pn; return ok; }
    __device__ __forceinline__ void a_ready(const Unit&) const {}
    __device__ __forceinline__ void done(const Unit&) const {}
};

__device__ __forceinline__ unsigned cvt_pk_bf16(float lo, float hi) { unsigned r; asm volatile("v_cvt_pk_bf16_f32 %0, %1, %2" : "=v"(r) : "v"(lo), "v"(hi)); return r; }

constexpr size_t Y_OFF = (size_t)168 << 20;
struct EpiRT {
    static constexpr bool PERM = true, AFTER_DRAIN = false;
    bf16_t* O; int ldc; const float* rs; const float* bias; const bf16_t* gates; int mode, zs;
    __device__ __forceinline__ void operator()(const f32x4 (&acc)[2][2][4][2], const Unit& u, int wr, int wc, int fr, int fq) const {
        const int md = u.mode >= 0 ? u.mode : mode;
        if (md == 6) {
            const int tidx = (wr * 4 + wc) * 64 + fq * 16 + fr; u32x4* Yp = (u32x4*)((unsigned char*)gates + Y_OFF);
#pragma unroll
            for (int bj = 0; bj < 2; ++bj)
#pragma unroll
                for (int n = 0; n < 2; ++n) { const size_t base = ((size_t)((u.pm * 16 + 4 * u.pn + 2 * bj + n) * 4 + u.z) * 4) * 512 + tidx;
#pragma unroll
                    for (int ai = 0; ai < 2; ++ai)
#pragma unroll
                        for (int mp = 0; mp < 2; ++mp) { const f32x4 a0 = acc[ai][bj][2 * mp][n], a1 = acc[ai][bj][2 * mp + 1][n];
                            u32x4 w; w.x = cvt_pk_bf16(a0[0], a0[1]); w.y = cvt_pk_bf16(a0[2], a0[3]); w.z = cvt_pk_bf16(a1[0], a1[1]); w.w = cvt_pk_bf16(a1[2], a1[3]);
                            Yp[base + (size_t)(ai * 2 + mp) * 512] = w; } }
            return;
        }
        if (md == 5) {
            const int row0 = u.pm * BM + wr * 64 + fr; const int col = u.pn * 64 + wc * 16 + 4 * fq;
            const int tidx = (wr * 4 + wc) * 64 + fq * 16 + fr; size_t yo_ = Y_OFF + ((size_t)(u.pm * 16 + u.pn) * 16) * 512 * 16; asm volatile("" : "+s"(yo_));
            const u32x4* Yp = (const u32x4*)((const unsigned char*)gates + yo_) + tidx;
            f32x4 bz[4];
#pragma unroll
            for (int z = 0; z < 4; ++z) bz[z] = *(const f32x4*)(bias + z * 1024 + col);
#pragma unroll
            for (int ai = 0; ai < 2; ++ai) {
                float sc[4]; u32x4 yw[2][4];
#pragma unroll
                for (int m = 0; m < 4; ++m) sc[m] = rs[row0 + ai * HALF + m * 16];
#pragma unroll
                for (int mp = 0; mp < 2; ++mp)
#pragma unroll
                    for (int z = 0; z < 4; ++z) yw[mp][z] = Yp[(size_t)(z * 4 + ai * 2 + mp) * 512];
#pragma unroll
                for (int mp = 0; mp < 2; ++mp) {
                    f32x4 tot[2]; tot[0] = (f32x4){0.f, 0.f, 0.f, 0.f}; tot[1] = tot[0];
#pragma unroll
                    for (int bj = 0; bj < 2; ++bj)
#pragma unroll
                        for (int n = 0; n < 2; ++n) { const int z = 2 * bj + n;
#pragma unroll
                            for (int mm = 0; mm < 2; ++mm) { const int m = 2 * mp + mm; const f32x4 v = acc[ai][bj][m][n] * sc[m] + bz[z];
                                const unsigned y01 = mm ? yw[mp][z].z : yw[mp][z].x, y23 = mm ? yw[mp][z].w : yw[mp][z].y;
                                tot[mm][0] += fast_sigmoid(v[0]) * bflo(y01); tot[mm][1] += fast_sigmoid(v[1]) * bfhi(y01); tot[mm][2] += fast_sigmoid(v[2]) * bflo(y23); tot[mm][3] += fast_sigmoid(v[3]) * bfhi(y23); } }
#pragma unroll
                    for (int mm = 0; mm < 2; ++mm) { const int row = row0 + ai * HALF + (2 * mp + mm) * 16;
                        u32x2 w; w.x = cvt_pk_bf16(tot[mm][0], tot[mm][1]); w.y = cvt_pk_bf16(tot[mm][2], tot[mm][3]);
                        *(u32x2*)(O + (size_t)row * ldc + col) = w; } } }
            return;
        }
        const int row0 = u.pm * BM + wr * 64 + fr; const int col0 = u.pn * BM + wc * 32 + 8 * fq + u.z * zs;
        const int m_eff = (md == 1) ? ((u.pn == 2 || u.pn == 3) ? 1 : 0) : md;
        float scv[8];
#pragma unroll
        for (int i = 0; i < 8; ++i) scv[i] = rs ? rs[row0 + (i >> 2) * HALF + (i & 3) * 16] : 1.0f;
#pragma unroll
        for (int ai = 0; ai < 2; ++ai)
#pragma unroll
            for (int m = 0; m < 4; ++m) { const int row = row0 + ai * HALF + m * 16; bf16_t* rowp = O + (size_t)row * ldc + col0;
                const float sc = scv[ai * 4 + m];
#pragma unroll
                for (int bj = 0; bj < 2; ++bj) { f32x4 v0 = acc[ai][bj][m][0] * sc, v1 = acc[ai][bj][m][1] * sc;
                    if (m_eff == 1) {
#pragma unroll
                        for (int e = 0; e < 4; ++e) { v0[e] = gelu_tanh(v0[e]); v1[e] = gelu_tanh(v1[e]); }
                    } else if (m_eff == 3) {
#pragma unroll
                        for (int e = 0; e < 4; ++e) { const float a = fmaxf(v0[e], 0.f), b = fmaxf(v1[e], 0.f); v0[e] = a * a; v1[e] = b * b; }
                    }
                    u32x4 w; w.x = cvt_pk_bf16(v0[0], v0[1]); w.y = cvt_pk_bf16(v0[2], v0[3]); w.z = cvt_pk_bf16(v1[0], v1[1]); w.w = cvt_pk_bf16(v1[2], v1[3]);
                    *(u32x4*)(rowp + bj * HALF) = w; } }
    }
};

template <class Epi, class Sched, bool ALIGN_EPI = false, bool SP2 = false>
__device__ __forceinline__ void gemm_phase(PG8_LAS unsigned char* lds, const Gemm g, const Sched& S, const Epi& E, const int tid) {
    const int wid = __builtin_amdgcn_readfirstlane(tid >> 6), lane = tid & 63, wr = wid >> 2, wc = wid & 3, fr = lane & 15, fq = lane >> 4;
    const int nt0 = g.K / BK, nt1 = g.K1 / BK;
    unsigned voffA, voffB0, voffB1;
    { int R, C; stage_rc(tid * 16, R, C); const int Rm1 = ((R >> 4) & 1) * 1024 + (R >> 5) * 16 + (R & 15), Rm2 = ((R >> 4) & 1) * 64 + (R >> 5) * 16 + (R & 15), Rm0 = (R & ~31) + perm32(R & 31);
        const int Rb0 = g.bmode == 1 ? Rm1 : g.bmode == 2 ? Rm2 : Rm0, Rb1 = g.bmode1 == 1 ? Rm1 : g.bmode1 == 2 ? Rm2 : Rm0;
        voffA = (unsigned)(R * g.lda + C) * 2u; voffB0 = (unsigned)(Rb0 * g.ldb + C) * 2u; voffB1 = (unsigned)(Rb1 * g.ldb + C) * 2u; }
    const unsigned voffA_d = 64u * g.lda * 2u, dB0 = (g.bmode ? 32u : 64u) * g.ldb * 2u, dB1 = (g.bmode1 ? 32u : 64u) * g.ldb * 2u;
    const size_t kstep = (size_t)(BK * 2);
    const size_t hstepA = (size_t)HALF * g.lda * 2, hstepB0 = (size_t)(g.bmode == 1 ? 2048 : HALF) * g.ldb * 2, hstepB1 = (size_t)(g.bmode1 == 1 ? 2048 : HALF) * g.ldb * 2;
    const size_t tstepA = 2 * hstepA, tstepB0 = (size_t)(g.bmode == 1 ? 64 : 256) * g.ldb * 2, tstepB1 = (size_t)(g.bmode1 == 1 ? 64 : 256) * g.ldb * 2;
    const unsigned ldsw = (unsigned)wid * 1024u;
    const int aoff = lds_byte(wr * 64 + fr, fq * 8), boff = lds_byte(wc * 32 + fr, fq * 8);
#define PG8_SA(b, h) (((b) * 2 + (h)) * HTB)
#define PG8_SB(b, h) ((4 + (b) * 2 + (h)) * HTB)
#define PG8_STAGE(bufoff, gbase, voff) do { _Pragma("unroll") for (int _i = 0; _i < 2; ++_i) \
        __builtin_amdgcn_global_load_lds((const unsigned*)((const char*)(gbase) + (size_t)(_i * voff##_d) + (voff)), (PG8_LAS unsigned*)(lds + (bufoff) + ldsw + _i * 8192), 16, 0, 0); } while (0)
#define PG8_LDA(dst, b, h) do { _Pragma("unroll") for (int m = 0; m < 4; ++m) _Pragma("unroll") for (int k = 0; k < 2; ++k) dst[m][k] = *(const PG8_LAS bf16x8*)(lds + PG8_SA(b, h) + aoff + m * 2048 + k * 1024); } while (0)
#define PG8_LDB(dst, b, h) do { _Pragma("unroll") for (int n = 0; n < 2; ++n) _Pragma("unroll") for (int k = 0; k < 2; ++k) dst[n][k] = *(const PG8_LAS bf16x8*)(lds + PG8_SB(b, h) + boff + n * 2048 + k * 1024); } while (0)
#define PG8_MMA(ai, bj, At, Bt) do { __builtin_amdgcn_s_setprio(1); _Pragma("unroll") for (int m = 0; m < 4; ++m) _Pragma("unroll") for (int n = 0; n < 2; ++n) _Pragma("unroll") for (int k = 0; k < 2; ++k) \
        acc[ai][bj][m][n] = __builtin_amdgcn_mfma_f32_16x16x32_bf16(Bt[n][k], At[m][k], acc[ai][bj][m][n], 0, 0, 0); __builtin_amdgcn_s_setprio(0); } while (0)
#define PG8_WAIT_V(n) asm volatile("s_waitcnt vmcnt(" #n ")" ::: "memory")
#define PG8_WAIT_L(n) asm volatile("s_waitcnt lgkmcnt(" #n ")" ::: "memory")
#define PG8_BAR __builtin_amdgcn_s_barrier()
#define PG8_SCHED __builtin_amdgcn_sched_barrier(0)
    Unit cur, nxt; int ui = 0;
    if (!S.next(0, cur)) return;
    f32x4 acc[2][2][4][2];
#pragma unroll
    for (int a = 0; a < 2; ++a)
#pragma unroll
        for (int b = 0; b < 2; ++b)
#pragma unroll
            for (int m = 0; m < 4; ++m)
#pragma unroll
                for (int n = 0; n < 2; ++n) acc[a][b][m][n] = (f32x4){0.f, 0.f, 0.f, 0.f};
    bf16x8 At[4][2], B0[2][2], B1[2][2];
    const char* cA = (const char*)(cur.kind ? g.A1 : g.A) + (size_t)cur.pm * tstepA + (size_t)cur.ak * 2; const char* cB = (const char*)(cur.kind ? g.B1 : g.Bt) + (size_t)cur.bn * (cur.kind ? tstepB1 : tstepB0);
    S.a_ready(cur);
    {
    const unsigned voffB = cur.kind ? voffB1 : voffB0, voffB_d = cur.kind ? dB1 : dB0; const size_t hstepB = cur.kind ? hstepB1 : hstepB0;
    if constexpr (SP2) {
        PG8_STAGE(PG8_SB(0, 0), cB, voffB); PG8_STAGE(PG8_SB(0, 1), cB + hstepB, voffB); PG8_STAGE(PG8_SA(0, 0), cA, voffA); PG8_STAGE(PG8_SA(0, 1), cA + hstepA, voffA);
        if (wr == 1) PG8_BAR;
        PG8_WAIT_V(2); PG8_BAR;
        PG8_STAGE(PG8_SB(1, 0), cB + kstep, voffB); PG8_STAGE(PG8_SA(1, 0), cA + kstep, voffA); PG8_STAGE(PG8_SB(1, 1), cB + hstepB + kstep, voffB);
        PG8_WAIT_V(6); PG8_BAR;
    } else {
        PG8_STAGE(PG8_SB(0, 0), cB, voffB); PG8_STAGE(PG8_SA(0, 0), cA, voffA); PG8_STAGE(PG8_SB(0, 1), cB + hstepB, voffB); PG8_STAGE(PG8_SA(0, 1), cA + hstepA, voffA);
        if (wr == 1) PG8_BAR;
        PG8_WAIT_V(4); PG8_BAR;
        PG8_STAGE(PG8_SB(1, 0), cB + kstep, voffB); PG8_STAGE(PG8_SA(1, 0), cA + kstep, voffA); PG8_STAGE(PG8_SB(1, 1), cB + hstepB + kstep, voffB);
        PG8_WAIT_V(6); PG8_BAR;
    }
    }
    for (;;) {
        const bool has_next = S.next(ui + 1, nxt); if (!has_next) nxt = cur;
        const int nt = cur.kind ? nt1 : nt0;
        const char* nA = has_next ? (const char*)(nxt.kind ? g.A1 : g.A) + (size_t)nxt.pm * tstepA + (size_t)nxt.ak * 2 : cA; const char* nB = has_next ? (const char*)(nxt.kind ? g.B1 : g.Bt) + (size_t)nxt.bn * (nxt.kind ? tstepB1 : tstepB0) : cB;
        for (int t = 0; t < nt; t += 2) {
            const bool last = (t == nt - 2);
            const int kB_ = last ? nxt.kind : cur.kind;
            const unsigned voffB = kB_ ? voffB1 : voffB0, voffB_d = kB_ ? dB1 : dB0; const size_t hstepB = kB_ ? hstepB1 : hstepB0;
            const char* a1 = cA + (size_t)(t + 1) * kstep;
            const char* a2 = last ? nA : cA + (size_t)(t + 2) * kstep; const char* b2 = last ? nB : cB + (size_t)(t + 2) * kstep;
            const char* a3 = a2 + kstep; const char* b3 = b2 + kstep;
            if (last && has_next) S.a_ready(nxt);
            if constexpr (SP2) {
            PG8_LDB(B0, 0, 0); PG8_LDB(B1, 0, 1); PG8_SCHED; PG8_LDA(At, 0, 0); PG8_STAGE(PG8_SA(1, 1), a1 + hstepA, voffA);
            PG8_WAIT_V(8); PG8_WAIT_L(0); PG8_BAR; PG8_MMA(0, 0, At, B0); PG8_MMA(0, 1, At, B1); PG8_BAR; PG8_SCHED;
            PG8_LDA(At, 0, 1); PG8_STAGE(PG8_SB(0, 0), b2, voffB); PG8_STAGE(PG8_SB(0, 1), b2 + hstepB, voffB); PG8_STAGE(PG8_SA(0, 0), a2, voffA);
            PG8_WAIT_V(8); PG8_WAIT_L(0); PG8_BAR; PG8_MMA(1, 0, At, B0); PG8_MMA(1, 1, At, B1); PG8_BAR; PG8_SCHED;
            PG8_LDB(B0, 1, 0); PG8_LDB(B1, 1, 1); PG8_SCHED; PG8_LDA(At, 1, 0); PG8_STAGE(PG8_SA(0, 1), a2 + hstepA, voffA);
            PG8_WAIT_V(8); PG8_WAIT_L(0); PG8_BAR; PG8_MMA(0, 0, At, B0); PG8_MMA(0, 1, At, B1); PG8_BAR; PG8_SCHED;
            PG8_LDA(At, 1, 1); PG8_STAGE(PG8_SB(1, 0), b3, voffB); PG8_STAGE(PG8_SB(1, 1), b3 + hstepB, voffB); PG8_STAGE(PG8_SA(1, 0), a3, voffA);
            PG8_WAIT_V(8); PG8_WAIT_L(0); PG8_BAR; PG8_MMA(1, 0, At, B0); PG8_MMA(1, 1, At, B1); PG8_BAR; PG8_SCHED;
            } else {
            PG8_LDB(B0, 0, 0); PG8_SCHED; PG8_LDA(At, 0, 0); PG8_STAGE(PG8_SA(1, 1), a1 + hstepA, voffA);
            PG8_WAIT_L(8); PG8_BAR; PG8_WAIT_L(0); PG8_MMA(0, 0, At, B0); PG8_BAR; PG8_SCHED;
            PG8_LDB(B1, 0, 1); PG8_STAGE(PG8_SB(0, 0), b2, voffB);
            PG8_BAR; PG8_WAIT_L(0); PG8_MMA(0, 1, At, B1); PG8_BAR;
            PG8_LDA(At, 0, 1); PG8_STAGE(PG8_SA(0, 0), a2, voffA);
            PG8_BAR; PG8_WAIT_L(0); PG8_MMA(1, 0, At, B0); PG8_BAR; PG8_SCHED;
            PG8_STAGE(PG8_SB(0, 1), b2 + hstepB, voffB);
            PG8_WAIT_V(6); PG8_BAR; PG8_MMA(1, 1, At, B1); PG8_BAR;
            PG8_LDB(B0, 1, 0); PG8_SCHED; PG8_LDA(At, 1, 0); PG8_STAGE(PG8_SA(0, 1), a2 + hstepA, voffA);
            PG8_WAIT_L(8); PG8_BAR; PG8_WAIT_L(0); PG8_MMA(0, 0, At, B0); PG8_BAR; PG8_SCHED;
            PG8_LDB(B1, 1, 1); PG8_STAGE(PG8_SB(1, 0), b3, voffB);
            PG8_BAR; PG8_WAIT_L(0); PG8_MMA(0, 1, At, B1); PG8_BAR;
            PG8_LDA(At, 1, 1); PG8_STAGE(PG8_SA(1, 0), a3, voffA);
            PG8_BAR; PG8_WAIT_L(0); PG8_MMA(1, 0, At, B0); PG8_BAR; PG8_SCHED;
            PG8_STAGE(PG8_SB(1, 1), b3 + hstepB, voffB);
            PG8_WAIT_V(6); PG8_BAR; PG8_MMA(1, 1, At, B1); PG8_BAR;
            }
        }
        if constexpr (ALIGN_EPI) { if (wr == 0) PG8_BAR; }
        if constexpr (!Epi::AFTER_DRAIN) { E(acc, cur, wr, wc, fr, fq); S.done(cur); }
        if (!has_next) break;
#pragma unroll
        for (int a = 0; a < 2; ++a)
#pragma unroll
            for (int b = 0; b < 2; ++b)
#pragma unroll
                for (int m = 0; m < 4; ++m)
#pragma unroll
                    for (int n = 0; n < 2; ++n) acc[a][b][m][n] = (f32x4){0.f, 0.f, 0.f, 0.f};
        cur = nxt; cA = nA; cB = nB; ++ui;
        if constexpr (ALIGN_EPI) { if (wr == 1) PG8_BAR; }
    }
    PG8_WAIT_V(0);
    if constexpr (!ALIGN_EPI) { if (wr == 0) PG8_BAR; }
    PG8_BAR;
    if constexpr (Epi::AFTER_DRAIN) { E.fused(acc, cur, wr, wc, fr, fq, lds, wid, lane); S.done(cur); }
#undef PG8_SA
#undef PG8_SB
#undef PG8_STAGE
#undef PG8_LDA
#undef PG8_LDB
#undef PG8_MMA
#undef PG8_WAIT_V
#undef PG8_WAIT_L
#undef PG8_BAR
#undef PG8_SCHED
}
}

constexpr int MTOK = 32768, DM = 1024, SEQ = 8192, NLAYER = 4, NIN = 6048, DFF = 4096;
constexpr float EPS = 1e-6f;
constexpr float QSCALE = 0.10206207261596575f * 1.4426950408889634f;
constexpr size_t MiB = 1u << 20;
constexpr size_t WS_RS = 1 * MiB, WS_ROPEC = 2 * MiB, WS_ROPES = 4 * MiB;
constexpr size_t WS_WIN = 6 * MiB, WS_WUQ = 18 * MiB, WS_WK = WS_WUQ + 256 * 1024, WS_WV = WS_WK + 64 * 1024, WS_SGW = WS_WUQ + 512 * 1024;
constexpr size_t WS_WBR = 424 * MiB, WS_WOUT = 21 * MiB, WS_W1 = 23 * MiB, WS_W2 = 31 * MiB;
constexpr size_t WS_XBF = 40 * MiB;
constexpr size_t WS_BR = 104 * MiB;
constexpr size_t WS_BIG = 168 * MiB;
constexpr size_t WS_PROJ = WS_BIG, WS_CQN = WS_BIG + 128 * MiB, WS_CKVN = WS_BIG + 144 * MiB, WS_KR = WS_BIG + 152 * MiB, WS_Q = WS_BIG + 154 * MiB, WS_KN = WS_BIG + 186 * MiB, WS_VT = WS_BIG + 202 * MiB;
constexpr size_t WS_END = 432 * MiB;
static_assert(WS_BIG == pg8::Y_OFF, "Y exchange offset");
constexpr int LDS_BYTES = 147456;

struct Args { const float* in[26]; float* out; unsigned char* ws; int lo, hi; };
enum { I_X = 0, I_POS, I_NPRE, I_WIN, I_GATEB, I_QN, I_WUQ, I_KVN, I_WUKV, I_WBRMLA, I_LNG, I_LNB, I_SGW, I_SGB, I_WBRSG, I_CONVW, I_WBRCONV, I_POOLW, I_POOLS, I_WBRPOOL, I_WOUT, I_NPOST, I_NFPRE, I_WFF1, I_WFF2, I_NFPOST };

typedef __bf16 bf16x2_t __attribute__((ext_vector_type(2)));
__device__ __forceinline__ unsigned cvtpk_v(float lo, float hi) { f32x2 v = {lo, hi}; bf16x2_t b = __builtin_convertvector(v, bf16x2_t); return __builtin_bit_cast(unsigned, b); }
__device__ __forceinline__ int crow(int r, int hi) { return (r & 3) + 8 * (r >> 2) + 4 * hi; }
#define MFMA32(a, b, c) __builtin_amdgcn_mfma_f32_32x32x16_bf16((a), (b), (c), 0, 0, 0)

__device__ __forceinline__ void tr_item(const float* __restrict__ W, int ldw, int k0, int srcn0, const float* __restrict__ gk, float mul, bf16_t* WT, int ldt, int dstn0, LAS float* scr, int lane) {
    float tv[32];
#pragma unroll
    for (int i = 0; i < 32; ++i) { const int kk = 2 * i + (lane >> 5); tv[i] = (srcn0 >= 0) ? W[(size_t)(k0 + kk) * ldw + srcn0 + (lane & 31)] : 0.f; }
    float gkv = mul; (void)gkv;
#pragma unroll
    for (int i = 0; i < 32; ++i) { const int kk = 2 * i + (lane >> 5); float v = tv[i] * mul; if (gk) v *= gk[k0 + kk]; scr[kk * 33 + (lane & 31)] = v; }
    asm volatile("s_waitcnt lgkmcnt(0)" ::: "memory");
    const int c = lane & 7;
#pragma unroll
    for (int j = 0; j < 4; ++j) { const int n = (lane >> 3) + 8 * j; const LAS float* s = scr + (8 * c) * 33 + n;
        u32x4 o; o.x = pk2(s[0 * 33], s[1 * 33]); o.y = pk2(s[2 * 33], s[3 * 33]); o.z = pk2(s[4 * 33], s[5 * 33]); o.w = pk2(s[6 * 33], s[7 * 33]);
        *(u32x4*)(WT + (size_t)(dstn0 + n) * ldt + k0 + 8 * c) = o; }
    asm volatile("s_waitcnt lgkmcnt(0)" ::: "memory");
}

__device__ __forceinline__ void prep_weights(const Args& a, unsigned char* wsl, int l, LAS unsigned char* lds, int tid) {
    const int lane = tid & 63, wave = tid >> 6, G = gridDim.x;
    LAS float* scr = (LAS float*)(lds + wave * 8448);
    const int gw = blockIdx.x * 8 + wave, NGW = G * 8;
    unsigned char* ws = wsl;
    constexpr int N0 = 16 * 192, N1 = 4 * 16, N2 = 2 * 8, N3 = 2 * 8, N4 = 3 * 4 * 32, N5 = 16 * 32, N6 = 16 * 128, N7 = 64 * 32;
    constexpr int NITEMS = N0 + N1 + N2 + N3 + N4 + N5 + N6 + N7;
    for (int it = gw; it < NITEMS; it += NGW) {
        int r = it;
        if (r < N0) { const int kb = r / 192, nb = r % 192, d0 = nb * 32; const int src = d0 < 416 ? d0 : (d0 < 512 ? -1 : d0 - 96);
            tr_item(a.in[I_WIN] + (size_t)l * DM * NIN, NIN, kb * 64, src, a.in[I_NPRE] + l * DM, 1.f, (bf16_t*)(ws + WS_WIN), DM, d0, scr, lane); continue; } r -= N0;
        if (r < N1) { const int kb = r / 16, nb = r % 16;
            tr_item(a.in[I_WUQ] + (size_t)l * 256 * 384, 384, kb * 64, nb < 12 ? nb * 32 : -1, a.in[I_QN] + l * 256, QSCALE, (bf16_t*)(ws + WS_WUQ), 256, nb * 32, scr, lane); continue; } r -= N1;
        if (r < N2) { const int kb = r / 8, nb = r % 8;
            tr_item(a.in[I_WUKV] + (size_t)l * 128 * 512, 512, kb * 64, (nb >> 1) * 128 + (nb & 1) * 32, a.in[I_KVN] + l * 128, 1.f, (bf16_t*)(ws + WS_WK), 128, nb * 32, scr, lane); continue; } r -= N2;
        if (r < N3) { const int kb = r / 8, nb = r % 8;
            tr_item(a.in[I_WUKV] + (size_t)l * 128 * 512, 512, kb * 64, (nb >> 1) * 128 + 64 + (nb & 1) * 32, a.in[I_KVN] + l * 128, 1.f, (bf16_t*)(ws + WS_WV), 128, nb * 32, scr, lane); continue; } r -= N3;
        if (r < N4) { const int z = r / 128, rr = r % 128, kb = rr / 32, nb = rr % 32; const float* W = (z == 0 ? a.in[I_WBRMLA] : z == 1 ? a.in[I_WBRSG] : a.in[I_WBRCONV]) + (size_t)l * 256 * DM;
            tr_item(W, DM, kb * 64, nb * 32, nullptr, 1.f, (bf16_t*)(ws + WS_WBR) + (size_t)z * DM * DM, DM, nb * 32, scr, lane); continue; } r -= N4;
        if (r < N5) { const int kb = r / 32, nb = r % 32;
            tr_item(a.in[I_WOUT] + (size_t)l * DM * DM, DM, kb * 64, nb * 32, nullptr, 1.f, (bf16_t*)(ws + WS_WOUT), DM, nb * 32, scr, lane); continue; } r -= N5;
        if (r < N6) { const int kb = r / 128, nb = r % 128;
            tr_item(a.in[I_WFF1] + (size_t)l * DM * DFF, DFF, kb * 64, nb * 32, a.in[I_NFPRE] + l * DM, 1.f, (bf16_t*)(ws + WS_W1), DM, nb * 32, scr, lane); continue; } r -= N6;
        { const int kb = r / 32, nb = r % 32;
            tr_item(a.in[I_WFF2] + (size_t)l * DFF * DM, DM, kb * 64, nb * 32, nullptr, 1.f, (bf16_t*)(ws + WS_W2), DFF, nb * 32, scr, lane); }
    }
    const int gt = blockIdx.x * 512 + tid, NGT = G * 512;
    { const float* sw = a.in[I_SGW] + (size_t)l * 65536; bf16_t* o = (bf16_t*)(ws + WS_SGW);
      for (int i = gt; i < 65536; i += NGT) { const int t = (i >> 7) & 127, s = i & 127; o[i] = (bf16_t)f2bf(s <= t ? sw[i] : 0.f); } }
    { const float* wp = a.in[I_POOLW] + (size_t)l * 4 * 64 * 64; const float* sc = a.in[I_POOLS] + l * 256; const float* wb = a.in[I_WBRPOOL] + (size_t)l * 256 * DM;
      bf16_t* o = (bf16_t*)(ws + WS_WBR) + (size_t)3 * DM * DM;
      for (int i = gt; i < 256 * DM; i += NGT) { const int n = i & 1023, cp = i >> 10, g = cp >> 6, c = cp & 63; float acc = 0.f;
          for (int d = 0; d < 64; ++d) acc += wp[(g * 64 + c) * 64 + d] * sc[g * 64 + d] * wb[(size_t)(g * 64 + d) * DM + n];
          o[(size_t)n * DM + cp] = (bf16_t)f2bf(acc); } }
}

__device__ __forceinline__ void phase_s0(const Args& a, unsigned char* wsl, LAS unsigned char* lds, int tid) {
    const int G = gridDim.x, gt = blockIdx.x * 512 + tid, NGT = G * 512;
    const int* pos = (const int*)a.in[I_POS];
    float* rc = (float*)(wsl + WS_ROPEC); float* rsn = (float*)(wsl + WS_ROPES);
    for (int i = gt; i < MTOK * 16; i += NGT) { const int tok = i & (MTOK - 1); const int k = __builtin_amdgcn_readfirstlane(i >> 15);
        const unsigned chi = (k == 0 ? 0x3fc45f30u : (k == 1 ? 0x3fb6e96eu : (k == 2 ? 0x3fa9c4c0u : (k == 3 ? 0x3f9cfb40u : (k == 4 ? 0x3f904c26u : (k == 5 ? 0x3f825458u : (k == 6 ? 0x3f749d66u : (k == 7 ? 0x3f672f66u : (k == 8 ? 0x3f5a1371u : (k == 9 ? 0x3f4d53c1u : (k == 10 ? 0x3f407debu : (k == 11 ? 0x3f328c52u : (k == 12 ? 0x3f24dc5au : (k == 13 ? 0x3f177634u : (k == 14 ? 0x3f0a6312u : (k == 15 ? 0x3efdad50u : 0u))))))))))))))));
        const unsigned clo = (k == 0 ? 0x6dc9c883u : (k == 1 ? 0xcaebf83fu : (k == 2 ? 0x200b604fu : (k == 3 ? 0x35fd7496u : (k == 4 ? 0xbe3b06cfu : (k == 5 ? 0xa2566033u : (k == 6 ? 0x800919d9u : (k == 7 ? 0x91979078u : (k == 8 ? 0x305e714cu : (k == 9 ? 0x03bd66b8u : (k == 10 ? 0x99a0e17au : (k == 11 ? 0x0e12d9f9u : (k == 12 ? 0x8d185aa3u : (k == 13 ? 0x02fdebc6u : (k == 14 ? 0x8f67cf2au : (k == 15 ? 0x16848ff5u : 0u))))))))))))))));
        const double cf = __hiloint2double((int)chi, (int)clo);
        const double rev = (double)pos[tok] * cf;
        const float fr = (float)(rev - __builtin_rint(rev));
        rc[tok * 16 + k] = __builtin_amdgcn_cosf(fr); rsn[tok * 16 + k] = __builtin_amdgcn_sinf(fr); }
    const int lane = tid & 63, wave = tid >> 6, gw = blockIdx.x * 8 + wave, NGW = G * 8;
    const float* x = a.in[I_X]; float* xo = a.out; bf16_t* xb = (bf16_t*)(wsl + WS_XBF); float* rs = (float*)(wsl + WS_RS);
    for (int row = gw; row < MTOK; row += NGW) {
        const float* xr = x + (size_t)row * DM + 8 * lane; bf16_t* bw = xb + (size_t)row * DM + 8 * lane;
        float ss = 0.f;
#pragma unroll
        for (int j = 0; j < 2; ++j) { const f32x4 v0 = *(const f32x4*)(xr + 512 * j), v1 = *(const f32x4*)(xr + 512 * j + 4);
            ss += v0.x * v0.x + v0.y * v0.y + v0.z * v0.z + v0.w * v0.w + v1.x * v1.x + v1.y * v1.y + v1.z * v1.z + v1.w * v1.w;
            u32x4 o; o.x = pk2(v0.x, v0.y); o.y = pk2(v0.z, v0.w); o.z = pk2(v1.x, v1.y); o.w = pk2(v1.z, v1.w); *(u32x4*)(bw + 512 * j) = o; }
        ss = wave_sum(ss);
        if (lane == 0) rs[row] = 1.0f / sqrtf(ss * (1.0f / DM) + EPS);
    }
}

__device__ __forceinline__ void phase_nr(const Args& a, unsigned char* wsl, const float* gpost, size_t ysrc, bool final_out, int tid) {
    const int G = gridDim.x, lane = tid & 63, wave = tid >> 6, gw = blockIdx.x * 8 + wave, NGW = G * 8;
    float* xo = a.out; bf16_t* xb = (bf16_t*)(wsl + WS_XBF); float* rs = (float*)(wsl + WS_RS); const bf16_t* y = (const bf16_t*)(wsl + ysrc);
    f32x4 gv[4];
#pragma unroll
    for (int j = 0; j < 2; ++j) { gv[2 * j] = *(const f32x4*)(gpost + 8 * lane + 512 * j); gv[2 * j + 1] = *(const f32x4*)(gpost + 8 * lane + 512 * j + 4); }
    constexpr int NR = 4;
    for (int grp = gw; grp < MTOK / NR; grp += NGW) {
        u32x4 yw[NR][2], xw[NR][2];
#pragma unroll
        for (int r = 0; r < NR; ++r) { const size_t off = (size_t)(grp * NR + r) * DM + 8 * lane;
#pragma unroll
            for (int j = 0; j < 2; ++j) { yw[r][j] = *(const u32x4*)(y + off + 512 * j); xw[r][j] = *(const u32x4*)(xb + off + 512 * j); } }
        float ss[NR];
#pragma unroll
        for (int r = 0; r < NR; ++r) { float s_ = 0.f;
#pragma unroll
            for (int j = 0; j < 2; ++j) { const u32x4 w = yw[r][j]; const float e0 = bflo(w.x), e1 = bfhi(w.x), e2 = bflo(w.y), e3 = bfhi(w.y), e4 = bflo(w.z), e5 = bfhi(w.z), e6 = bflo(w.w), e7 = bfhi(w.w);
                s_ += e0 * e0 + e1 * e1 + e2 * e2 + e3 * e3 + e4 * e4 + e5 * e5 + e6 * e6 + e7 * e7; }
            ss[r] = s_; }
#pragma unroll
        for (int o = 1; o < 64; o <<= 1) {
#pragma unroll
            for (int r = 0; r < NR; ++r) ss[r] += __shfl_xor(ss[r], o); }
        float xs[NR];
#pragma unroll
        for (int r = 0; r < NR; ++r) { const float ry = 1.0f / sqrtf(ss[r] * (1.0f / DM) + EPS); float s_ = 0.f; const size_t off = (size_t)(grp * NR + r) * DM + 8 * lane;
#pragma unroll
            for (int j = 0; j < 2; ++j) { const u32x4 w = yw[r][j]; const u32x4 xx = xw[r][j]; f32x4 a0, a1;
                a0[0] = bflo(xx.x) + bflo(w.x) * ry * gv[2 * j][0]; a0[1] = bfhi(xx.x) + bfhi(w.x) * ry * gv[2 * j][1]; a0[2] = bflo(xx.y) + bflo(w.y) * ry * gv[2 * j][2]; a0[3] = bfhi(xx.y) + bfhi(w.y) * ry * gv[2 * j][3];
                a1[0] = bflo(xx.z) + bflo(w.z) * ry * gv[2 * j + 1][0]; a1[1] = bfhi(xx.z) + bfhi(w.z) * ry * gv[2 * j + 1][1]; a1[2] = bflo(xx.w) + bflo(w.w) * ry * gv[2 * j + 1][2]; a1[3] = bfhi(xx.w) + bfhi(w.w) * ry * gv[2 * j + 1][3];
                if (final_out) { *(f32x4*)(xo + off + 512 * j) = a0; *(f32x4*)(xo + off + 512 * j + 4) = a1; }
                else { u32x4 o; o.x = pk2(a0[0], a0[1]); o.y = pk2(a0[2], a0[3]); o.z = pk2(a1[0], a1[1]); o.w = pk2(a1[2], a1[3]); *(u32x4*)(xb + off + 512 * j) = o;
                    const float b0 = bflo(o.x), b1 = bfhi(o.x), b2 = bflo(o.y), b3 = bfhi(o.y), b4 = bflo(o.z), b5 = bfhi(o.z), b6 = bflo(o.w), b7 = bfhi(o.w);
                    s_ += b0 * b0 + b1 * b1 + b2 * b2 + b3 * b3 + b4 * b4 + b5 * b5 + b6 * b6 + b7 * b7; } }
            xs[r] = s_; }
        if (!final_out) {
#pragma unroll
            for (int o = 1; o < 64; o <<= 1) {
#pragma unroll
                for (int r = 0; r < NR; ++r) xs[r] += __shfl_xor(xs[r], o); }
            if (lane == 0) {
#pragma unroll
                for (int r = 0; r < NR; ++r) rs[grp * NR + r] = 1.0f / sqrtf(xs[r] * (1.0f / DM) + EPS); } }
    }
}

__device__ __forceinline__ void unpack8(const u32x4 w, float (&f)[8]) { f[0] = bflo(w.x); f[1] = bfhi(w.x); f[2] = bflo(w.y); f[3] = bfhi(w.y); f[4] = bflo(w.z); f[5] = bfhi(w.z); f[6] = bflo(w.w); f[7] = bfhi(w.w); }
__device__ __forceinline__ u32x4 pack8(const float (&f)[8]) { u32x4 o; o.x = pk2(f[0], f[1]); o.y = pk2(f[2], f[3]); o.z = pk2(f[4], f[5]); o.w = pk2(f[6], f[7]); return o; }

__device__ __forceinline__ void phase_e1(const Args& a, unsigned char* wsl, int l, LAS unsigned char* lds, int tid) {
    const int lane = tid & 63, wid = __builtin_amdgcn_readfirstlane(tid >> 6), r32 = lane & 31, hi = lane >> 5;
    unsigned char* ws = wsl;
    const bf16_t* P = (const bf16_t*)(ws + WS_PROJ); bf16_t* CQN = (bf16_t*)(ws + WS_CQN); bf16_t* CKVN = (bf16_t*)(ws + WS_CKVN); bf16_t* KR = (bf16_t*)(ws + WS_KR);
    bf16_t* BR = (bf16_t*)(ws + WS_BR); const float* rc = (const float*)(ws + WS_ROPEC); const float* rsn = (const float*)(ws + WS_ROPES);
    const bf16_t* SGWB = (const bf16_t*)(ws + WS_SGW);
    const float* convw = a.in[I_CONVW] + l * 3 * 256; const float* lng = a.in[I_LNG] + l * 256; const float* lnb = a.in[I_LNB] + l * 256; const float* sgb = a.in[I_SGB] + l * 512;
    for (int tile = blockIdx.x; tile < MTOK / 128; tile += gridDim.x) {
        const int R0 = tile * 128, s0 = R0 & (SEQ - 1);
        { const int rsub = lane >> 4, li = lane & 15;
#pragma unroll
          for (int it2 = 0; it2 < 2; ++it2) {
              u32x4 cqa[2], cqb[2], ckv[2]; float x1[2], x2[2], cc[2], ss[2];
#pragma unroll
              for (int u = 0; u < 2; ++u) { const int row = R0 + wid * 16 + (it2 * 2 + u) * 4 + rsub; const bf16_t* pr = P + (size_t)row * 2048;
                  cqa[u] = *(const u32x4*)(pr + 8 * li); cqb[u] = *(const u32x4*)(pr + 128 + 8 * li); ckv[u] = *(const u32x4*)(pr + 256 + 8 * li);
                  x1[u] = bf2f(pr[384 + li]); x2[u] = bf2f(pr[400 + li]); cc[u] = rc[(size_t)row * 16 + li]; ss[u] = rsn[(size_t)row * 16 + li]; }
#pragma unroll
              for (int u = 0; u < 2; ++u) { const int row = R0 + wid * 16 + (it2 * 2 + u) * 4 + rsub;
                  float qa[8], qb[8], kv[8]; unpack8(cqa[u], qa); unpack8(cqb[u], qb); unpack8(ckv[u], kv);
                  float sq = 0.f, sk = 0.f;
#pragma unroll
                  for (int e = 0; e < 8; ++e) { sq += qa[e] * qa[e] + qb[e] * qb[e]; sk += kv[e] * kv[e]; }
#pragma unroll
                  for (int o = 1; o < 16; o <<= 1) { sq += __shfl_xor(sq, o); sk += __shfl_xor(sk, o); }
                  const float rq = 1.0f / sqrtf(sq * (1.0f / 256.0f) + EPS), rk = 1.0f / sqrtf(sk * (1.0f / 128.0f) + EPS);
#pragma unroll
                  for (int e = 0; e < 8; ++e) { qa[e] *= rq; qb[e] *= rq; kv[e] *= rk; }
                  *(u32x4*)(CQN + (size_t)row * 256 + 8 * li) = pack8(qa); *(u32x4*)(CQN + (size_t)row * 256 + 128 + 8 * li) = pack8(qb);
                  *(u32x4*)(CKVN + (size_t)row * 128 + 8 * li) = pack8(kv);
                  KR[(size_t)row * 32 + li] = (bf16_t)f2bf(x1[u] * cc[u] - x2[u] * ss[u]); KR[(size_t)row * 32 + 16 + li] = (bf16_t)f2bf(x2[u] * cc[u] + x1[u] * ss[u]); } } }
        { const int ch = tid & 31, run = tid >> 5, t0 = run * 8; const bf16_t* pb = P + (size_t)(R0 + t0) * 2048 + 8 * ch; const int sb = s0 + t0;
          { float w0[8], w1[8], w2[8];
#pragma unroll
            for (int e = 0; e < 8; ++e) { w0[e] = convw[8 * ch + e]; w1[e] = convw[256 + 8 * ch + e]; w2[e] = convw[512 + 8 * ch + e]; }
            float zm2[8], zm1[8];
#pragma unroll
            for (int e = 0; e < 8; ++e) { zm2[e] = 0.f; zm1[e] = 0.f; }
            if (sb >= 2) { float xv[8], cv[8]; unpack8(*(const u32x4*)(pb - 2 * 2048 + 1024), xv); unpack8(*(const u32x4*)(pb - 2 * 2048 + 1536), cv);
#pragma unroll
                for (int e = 0; e < 8; ++e) zm2[e] = xv[e] * cv[e]; }
            if (sb >= 1) { float xv[8], cv[8]; unpack8(*(const u32x4*)(pb - 2048 + 1024), xv); unpack8(*(const u32x4*)(pb - 2048 + 1536), cv);
#pragma unroll
                for (int e = 0; e < 8; ++e) zm1[e] = xv[e] * cv[e]; }
#pragma unroll
            for (int half = 0; half < 2; ++half) { u32x4 lx[4], lc[4], lb[4];
#pragma unroll
                for (int j = 0; j < 4; ++j) { const bf16_t* pr = pb + (size_t)(half * 4 + j) * 2048; lx[j] = *(const u32x4*)(pr + 1024); lc[j] = *(const u32x4*)(pr + 1536); lb[j] = *(const u32x4*)(pr + 1280); }
#pragma unroll
                for (int j = 0; j < 4; ++j) { float xv[8], cv[8], bg[8], y[8]; unpack8(lx[j], xv); unpack8(lc[j], cv); unpack8(lb[j], bg);
#pragma unroll
                    for (int e = 0; e < 8; ++e) { const float z = xv[e] * cv[e]; y[e] = bg[e] * (w0[e] * zm2[e] + w1[e] * zm1[e] + w2[e] * z); zm2[e] = zm1[e]; zm1[e] = z; }
                    *(u32x4*)(BR + (size_t)(R0 + t0 + half * 4 + j) * DM + 512 + 8 * ch) = pack8(y); } } }
          { const int g = ch >> 3, win = 2 << g; float S[8];
#pragma unroll
            for (int e = 0; e < 8; ++e) S[e] = 0.f;
            for (int i = 1; i < win; ++i) { if (sb - i >= 0) { float pv[8]; unpack8(*(const u32x4*)(pb - (size_t)i * 2048 + 1792), pv);
#pragma unroll
                    for (int e = 0; e < 8; ++e) S[e] += pv[e]; } }
#pragma unroll
            for (int half = 0; half < 2; ++half) { u32x4 lp[4], lo[4];
#pragma unroll
                for (int j = 0; j < 4; ++j) { const int t = half * 4 + j; lp[j] = *(const u32x4*)(pb + (size_t)t * 2048 + 1792);
                    const int back = t - win + 1; lo[j] = (sb + back >= 0) ? *(const u32x4*)(pb + (ptrdiff_t)back * 2048 + 1792) : (u32x4){0u, 0u, 0u, 0u}; }
#pragma unroll
                for (int j = 0; j < 4; ++j) { const int t = half * 4 + j; float pt[8], po[8], o[8]; unpack8(lp[j], pt); unpack8(lo[j], po);
                    const int s = sb + t; const int cnt = (s + 1) < win ? (s + 1) : win; const float ic = 1.0f / (float)cnt;
#pragma unroll
                    for (int e = 0; e < 8; ++e) { S[e] += pt[e]; o[e] = S[e] * ic - pt[e]; S[e] -= po[e]; }
                    *(u32x4*)(BR + (size_t)(R0 + t0 + t) * DM + 768 + 8 * ch) = pack8(o); } } } }
        { const int srow = tid >> 2, qt = tid & 3; const bf16_t* vp = P + (size_t)(R0 + srow) * 2048 + 768 + qt * 64;
          float v[64]; float sum = 0.f;
#pragma unroll
          for (int j = 0; j < 8; ++j) { const u32x4 w = *(const u32x4*)(vp + 8 * j);
              v[8 * j + 0] = bflo(w.x); v[8 * j + 1] = bfhi(w.x); v[8 * j + 2] = bflo(w.y); v[8 * j + 3] = bfhi(w.y); v[8 * j + 4] = bflo(w.z); v[8 * j + 5] = bfhi(w.z); v[8 * j + 6] = bflo(w.w); v[8 * j + 7] = bfhi(w.w); }
#pragma unroll
          for (int j = 0; j < 64; ++j) sum += v[j];
          sum += __shfl_xor(sum, 1); sum += __shfl_xor(sum, 2);
          const float mean = sum * (1.0f / 256.0f); float var = 0.f;
#pragma unroll
          for (int j = 0; j < 64; ++j) { v[j] -= mean; var += v[j] * v[j]; }
          var += __shfl_xor(var, 1); var += __shfl_xor(var, 2);
          const float rstd = 1.0f / sqrtf(var * (1.0f / 256.0f) + EPS);
          LAS bf16_t* vT = (LAS bf16_t*)lds;
#pragma unroll
          for (int j = 0; j < 64; ++j) { const int c = qt * 64 + j; vT[c * 136 + srow] = (bf16_t)f2bf(v[j] * rstd * lng[c] + lnb[c]); } }
        __syncthreads();
        { const int g = wid >> 1, th = wid & 1;
#pragma unroll
          for (int tb = 0; tb < 2; ++tb) {
              const int nks = (64 * th + 32 * tb + 32) >> 4;
              const bf16_t* ap = SGWB + (size_t)(g * 128 + 64 * th + 32 * tb + r32) * 128 + 8 * hi;
              bf16x8 Af[8];
#pragma unroll
              for (int ks = 0; ks < 8; ++ks) Af[ks] = (ks < nks) ? *(const bf16x8*)(ap + 16 * ks) : (bf16x8){0, 0, 0, 0, 0, 0, 0, 0};
              float bsv[16];
#pragma unroll
              for (int r = 0; r < 16; ++r) bsv[r] = sgb[g * 128 + 64 * th + 32 * tb + crow(r, hi)];
#pragma unroll
              for (int cb = 0; cb < 2; ++cb) { f32x16 acc;
#pragma unroll
                  for (int r = 0; r < 16; ++r) acc[r] = 0.f;
                  const LAS unsigned char* bp = lds + (g * 64 + 32 * cb + r32) * 272 + 16 * hi;
                  const int c = g * 64 + 32 * cb + r32;
                  float uv[16];
#pragma unroll
                  for (int r = 0; r < 16; ++r) uv[r] = bf2f(P[(size_t)(R0 + 64 * th + 32 * tb + crow(r, hi)) * 2048 + 512 + c]);
#pragma unroll
                  for (int ks = 0; ks < 8; ++ks) { if (ks < nks) { const bf16x8 B = *(const LAS bf16x8*)(bp + 32 * ks); acc = MFMA32(Af[ks], B, acc); } }
#pragma unroll
                  for (int r = 0; r < 16; ++r) { const int t = 64 * th + 32 * tb + crow(r, hi);
                      BR[(size_t)(R0 + t) * DM + 256 + c] = (bf16_t)f2bf(uv[r] * (acc[r] + bsv[r])); } } } }
        __syncthreads();
    }
}

constexpr int KPITCH = 208, VPITCH = 264, KBUF = 128 * KPITCH, VBUF = 64 * VPITCH, ATT_V0 = 2 * KBUF, ATT_WS = ATT_V0 + 2 * VBUF;
#define MX3(a, b, c) __builtin_fmaxf(__builtin_fmaxf((a), (b)), (c))
#define ATT_QK(P0, P1, KB) do { \
    _Pragma("unroll") for (int kh = 0; kh < 2; ++kh) { bf16x8 ka_[3], kc_[3]; \
        _Pragma("unroll") for (int ks = 0; ks < 3; ++ks) { ka_[ks] = *(const LAS bf16x8*)((KB) + (3 * kh + ks) * 32); kc_[ks] = *(const LAS bf16x8*)((KB) + 32 * KPITCH + (3 * kh + ks) * 32); } \
        _Pragma("unroll") for (int ks = 0; ks < 3; ++ks) { if (kh == 0 && ks == 0) { P0 = MFMA32(ka_[0], qf[0], negm); P1 = MFMA32(kc_[0], qf[0], negm); } \
            else { P0 = MFMA32(ka_[ks], qf[3 * kh + ks], P0); P1 = MFMA32(kc_[ks], qf[3 * kh + ks], P1); } } } } while (0)
#define ATT_MAX(P0, P1, TT) do { \
    if (64 * (TT) + 63 > qw0) { const int qg_ = qw0 + r32; \
        _Pragma("unroll") for (int r = 0; r < 16; ++r) { const int kv_ = 64 * (TT) + crow(r, hi); if (kv_ > qg_) P0[r] = -INFINITY; if (kv_ + 32 > qg_) P1[r] = -INFINITY; } } \
    float ra_ = MX3(P0[0], P0[1], P1[0]), rb_ = MX3(P0[2], P0[3], P1[1]); ra_ = MX3(ra_, P1[2], P1[3]); \
    _Pragma("unroll") for (int r = 4; r < 16; r += 4) { ra_ = MX3(ra_, P0[r], P0[r + 1]); rb_ = MX3(rb_, P0[r + 2], P0[r + 3]); ra_ = MX3(ra_, P1[r], P1[r + 1]); rb_ = MX3(rb_, P1[r + 2], P1[r + 3]); } \
    float rm_ = __builtin_fmaxf(ra_, rb_); rm_ = __builtin_fmaxf(rm_, __shfl_xor(rm_, 32));        \
    const bool first_ = ((TT) == 0); \
    if (first_ || __any(rm_ > 8.0f)) { const float dl_ = first_ ? rm_ : __builtin_fmaxf(rm_, 0.f); mref += dl_; \
        _Pragma("unroll") for (int r = 0; r < 16; ++r) { P0[r] -= dl_; P1[r] -= dl_; } \
        _Pragma("unroll") for (int r = 0; r < 16; ++r) negm[r] = -mref; \
        const float alpha_ = __builtin_amdgcn_exp2f(-dl_); lsum *= alpha_; if (hi == 0) wsf[r32] = alpha_; \
        asm volatile("s_waitcnt lgkmcnt(0)" ::: "memory"); \
        _Pragma("unroll") for (int r = 0; r < 16; ++r) { const float f_ = wsf[crow(r, hi)]; o0[r] *= f_; o1[r] *= f_; } } } while (0)
#define ATT_EXP(P0, P1, PA) do { float ps_ = 0.f; \
    _Pragma("unroll") for (int r = 0; r < 16; ++r) { P0[r] = __builtin_amdgcn_exp2f(P0[r]); P1[r] = __builtin_amdgcn_exp2f(P1[r]); ps_ += P0[r] + P1[r]; } \
    lsum += ps_; u32x4 w_; \
    w_.x = cvtpk_v(P0[0], P0[1]); w_.y = cvtpk_v(P0[2], P0[3]); w_.z = cvtpk_v(P0[4], P0[5]); w_.w = cvtpk_v(P0[6], P0[7]); PA[0] = __builtin_bit_cast(bf16x8, w_); \
    w_.x = cvtpk_v(P0[8], P0[9]); w_.y = cvtpk_v(P0[10], P0[11]); w_.z = cvtpk_v(P0[12], P0[13]); w_.w = cvtpk_v(P0[14], P0[15]); PA[1] = __builtin_bit_cast(bf16x8, w_); \
    w_.x = cvtpk_v(P1[0], P1[1]); w_.y = cvtpk_v(P1[2], P1[3]); w_.z = cvtpk_v(P1[4], P1[5]); w_.w = cvtpk_v(P1[6], P1[7]); PA[2] = __builtin_bit_cast(bf16x8, w_); \
    w_.x = cvtpk_v(P1[8], P1[9]); w_.y = cvtpk_v(P1[10], P1[11]); w_.z = cvtpk_v(P1[12], P1[13]); w_.w = cvtpk_v(P1[14], P1[15]); PA[3] = __builtin_bit_cast(bf16x8, w_); } while (0)
#define ATT_PV(PA, VB) do { \
    _Pragma("unroll") for (int kk = 0; kk < 4; ++kk) { \
        const s16x4 l0_ = *(const LAS s16x4*)((VB) + kk * 32), h0_ = *(const LAS s16x4*)((VB) + kk * 32 + 16); \
        const s16x4 l1_ = *(const LAS s16x4*)((VB) + 32 * VPITCH + kk * 32), h1_ = *(const LAS s16x4*)((VB) + 32 * VPITCH + kk * 32 + 16); \
        const bf16x8 v0_ = __builtin_shufflevector(l0_, h0_, 0, 1, 2, 3, 4, 5, 6, 7), v1_ = __builtin_shufflevector(l1_, h1_, 0, 1, 2, 3, 4, 5, 6, 7); \
        o0 = MFMA32(PA[kk], v0_, o0); o1 = MFMA32(PA[kk], v1_, o1); } } while (0)

__device__ __forceinline__ void attn_unit(const Args& a, unsigned char* wsl, int b, int h, int qb, LAS unsigned char* lds, int tid_in) {
    int tid = tid_in; asm volatile("" : "+v"(tid));
    const int lane = tid & 63, wid = __builtin_amdgcn_readfirstlane(tid >> 6), r32 = lane & 31, hi = lane >> 5;
    unsigned char* ws = wsl;
    const bf16_t* Q = (const bf16_t*)(ws + WS_Q); const bf16_t* Kn = (const bf16_t*)(ws + WS_KN); const bf16_t* Kr = (const bf16_t*)(ws + WS_KR); const bf16_t* Vt = (const bf16_t*)(ws + WS_VT);
    bf16_t* O = (bf16_t*)(ws + WS_BR); const float* rc = (const float*)(ws + WS_ROPEC); const float* rsn = (const float*)(ws + WS_ROPES);
    const size_t rowbase = (size_t)b * SEQ; const int qw0 = qb * 256 + wid * 32;
    LAS float* wsf = (LAS float*)(lds + ATT_WS) + wid * 64;
    bf16x8 qf[6];
    { const size_t qrow = rowbase + qw0 + r32; const bf16_t* qp = Q + qrow * 512 + h * 96 + 8 * hi;
#pragma unroll
      for (int ks = 0; ks < 4; ++ks) qf[ks] = *(const bf16x8*)(qp + 16 * ks);
      const bf16x8 x1 = *(const bf16x8*)(qp + 64), x2 = *(const bf16x8*)(qp + 80);
      const float* cp = rc + qrow * 16 + 8 * hi; const float* sp = rsn + qrow * 16 + 8 * hi;
      const f32x4 c0 = *(const f32x4*)cp, c1 = *(const f32x4*)(cp + 4), s0 = *(const f32x4*)sp, s1 = *(const f32x4*)(sp + 4);
      bf16x8 o1, o2;
#pragma unroll
      for (int j = 0; j < 8; ++j) { const float xa = bf2f((bf16_t)x1[j]), xb = bf2f((bf16_t)x2[j]); const float c = j < 4 ? c0[j & 3] : c1[j & 3], s = j < 4 ? s0[j & 3] : s1[j & 3];
          o1[j] = (short)f2bf(xa * c - xb * s); o2[j] = (short)f2bf(xb * c + xa * s); }
      qf[4] = o1; qf[5] = o2; }
    const bf16_t* knu = Kn + rowbase * 256 + h * 64;
    const bf16_t* kru = Kr + rowbase * 32;
    const bf16_t* vtu = Vt + (size_t)(h * 64) * MTOK + rowbase;
    u32x4 gk0, gk1, gr, gv0, gv1;
#define ATT_LOAD(T) do { int t_ = tid; asm volatile("" : "+v"(t_)); const unsigned knv = (unsigned)((t_ >> 3) * 256 + (t_ & 7) * 8), krv = (unsigned)((t_ >> 2) * 32 + (t_ & 3) * 8), vtv = (unsigned)((t_ >> 3) * MTOK + (t_ & 7) * 8); \
        const bf16_t* k_ = knu + (size_t)(T) * 128 * 256; const bf16_t* r_ = kru + (size_t)(T) * 128 * 32; const bf16_t* v_ = vtu + (size_t)(T) * 128; \
        gk0 = *(const u32x4*)(k_ + knv); gk1 = *(const u32x4*)(k_ + 64 * 256 + knv); gr = *(const u32x4*)(r_ + krv); \
        gv0 = *(const u32x4*)(v_ + vtv); gv1 = *(const u32x4*)(v_ + 64 + vtv); } while (0)
#define ATT_STORE(bf) do { int t_ = tid; asm volatile("" : "+v"(t_)); const int krow = t_ >> 3, kch = t_ & 7, rrow = t_ >> 2, rch = t_ & 3; \
        LAS unsigned char* kd_ = lds + (bf) * KBUF; LAS unsigned char* vd_ = lds + ATT_V0 + (bf) * VBUF + krow * VPITCH + kch * 16; \
        *(LAS u32x4*)(kd_ + krow * KPITCH + kch * 16) = gk0; *(LAS u32x4*)(kd_ + (krow + 64) * KPITCH + kch * 16) = gk1; *(LAS u32x4*)(kd_ + rrow * KPITCH + 128 + rch * 16) = gr; \
        *(LAS u32x2*)(vd_) = (u32x2){gv0.x, gv0.y}; *(LAS u32x2*)(vd_ + 8) = (u32x2){gv0.z, gv0.w}; *(LAS u32x2*)(vd_ + 128) = (u32x2){gv1.x, gv1.y}; *(LAS u32x2*)(vd_ + 136) = (u32x2){gv1.z, gv1.w}; } while (0)
    float mref = 0.f, lsum = 0.f; f32x16 o0, o1, negm;
#pragma unroll
    for (int r = 0; r < 16; ++r) { o0[r] = 0.f; o1[r] = 0.f; negm[r] = 0.f; }
    const int NT2 = 2 * qb + 2;
    ATT_LOAD(0); ATT_STORE(0); __syncthreads();
    for (int T = 0; T < NT2; ++T) {
        const int buf = T & 1;
        if (T + 1 < NT2) ATT_LOAD(T + 1);
        const int tA = 2 * T, tB = 2 * T + 1;
        const LAS unsigned char* kbA = lds + buf * KBUF + r32 * KPITCH + hi * 16; const LAS unsigned char* kbB = kbA + 64 * KPITCH;
        const LAS unsigned char* vbA = lds + ATT_V0 + buf * VBUF + r32 * VPITCH + hi * 8; const LAS unsigned char* vbB = vbA + 128;
        if (64 * tB <= qw0 + 31) {
            f32x16 pA0, pA1, pB0, pB1; bf16x8 pa[4];
            ATT_QK(pA0, pA1, kbA);
            ATT_MAX(pA0, pA1, tA);
            ATT_QK(pB0, pB1, kbB);
            ATT_EXP(pA0, pA1, pa);
            ATT_MAX(pB0, pB1, tB);
            ATT_PV(pa, vbA);
            ATT_EXP(pB0, pB1, pa);
            ATT_PV(pa, vbB);
        } else if (64 * tA <= qw0 + 31) {
            f32x16 pA0, pA1; bf16x8 pa[4];
            ATT_QK(pA0, pA1, kbA);
            ATT_MAX(pA0, pA1, tA);
            ATT_EXP(pA0, pA1, pa);
            ATT_PV(pa, vbA);
        }
        if (T + 1 < NT2) ATT_STORE((T + 1) & 1);
        __syncthreads();
    }
#undef ATT_LOAD
#undef ATT_STORE
    lsum += __shfl_xor(lsum, 32);
    if (hi == 0) wsf[32 + r32] = 1.0f / lsum;
    asm volatile("s_waitcnt lgkmcnt(0)" ::: "memory");
    { bf16_t* ou = O + (rowbase + qw0) * DM + h * 64;
#pragma unroll
      for (int r = 0; r < 16; ++r) { const int qr = crow(r, hi); const float inv = wsf[32 + qr]; const unsigned ov = (unsigned)(qr * DM + r32);
          ou[ov] = (bf16_t)f2bf(o0[r] * inv); ou[ov + 32] = (bf16_t)f2bf(o1[r] * inv); } }
}
__device__ __forceinline__ void phase_attn(const Args& a, unsigned char* wsl, LAS unsigned char* lds, int tid) {
    const int G = gridDim.x, bx = blockIdx.x; const int v0 = (G % 8 == 0) ? (bx % 8) * (G / 8) + bx / 8 : bx;
    for (int v = v0; v < 256; v += G) { const int bh = v >> 4, s = v & 15;
        attn_unit(a, wsl, bh >> 2, bh & 3, 31 - s, lds, tid);
        attn_unit(a, wsl, bh >> 2, bh & 3, s, lds, tid); }
}

#define XB_TMO      128
#define XB_XCNT(j)  (256  + 64 * (j))
#define XB_XSUB(j)  (1280 + 64 * (j))
#define XB_XGEN(j)  (2304 + 64 * (j))
#define XB_TOP      3328
#define XB_TOPGEN   3392
#define XCD_BAR_WORDS 3456
#define XB_SPIN_CAP (1u << 18)

__device__ __forceinline__ unsigned xb_ld(unsigned* p)              { return __hip_atomic_load(p, __ATOMIC_RELAXED, __HIP_MEMORY_SCOPE_AGENT); }
__device__ __forceinline__ unsigned xb_add(unsigned* p, unsigned v) { return __hip_atomic_fetch_add(p, v, __ATOMIC_RELAXED, __HIP_MEMORY_SCOPE_AGENT); }
__device__ __forceinline__ unsigned xb_xcc_id() { return (unsigned)__builtin_amdgcn_s_getreg((3 << 11) | 20) & 0xFu; }
#define XB_SPIN(cond, bar) do { unsigned _sp = 0; while (cond) { __builtin_amdgcn_s_sleep(1); \
    if ((++_sp & 255u) == 0u) { if (xb_ld(&(bar)[XB_TMO])) break; if (_sp > XB_SPIN_CAP) { atomicAdd(&(bar)[XB_TMO], 1u); break; } } } } while (0)

struct XcdBarrier {
    unsigned* bar; unsigned x;
    volatile LAS unsigned* st;
};

__device__ __forceinline__ XcdBarrier xcd_barrier_post(unsigned* bar, volatile LAS unsigned* st) {
    XcdBarrier b; b.bar = bar; b.x = xb_xcc_id(); b.st = st;
    if (threadIdx.x == 0) (void)xb_add(&bar[XB_XCNT(b.x)], 1u);
    return b;
}
__device__ __forceinline__ void xcd_barrier_complete(unsigned* bar, unsigned x, unsigned& nloc, unsigned& nx) {
    const unsigned G = gridDim.x * gridDim.y * gridDim.z;
    unsigned sum, cnt, mine, sp = 0u;
    for (;;) {
        sum = 0u; cnt = 0u; mine = 0u;
#pragma unroll
        for (unsigned j = 0; j < 16; ++j) { const unsigned c = xb_ld(&bar[XB_XCNT(j)]); sum += c; cnt += (c > 0u) ? 1u : 0u; mine = (j == x) ? c : mine; }
        if (sum == G) break;
        __builtin_amdgcn_s_sleep(1);
        if ((++sp & 255u) == 0u) { if (xb_ld(&bar[XB_TMO])) break; if (sp > XB_SPIN_CAP) { atomicAdd(&bar[XB_TMO], 1u); break; } }
    }
    nloc = mine > 0u ? mine : 1u; nx = cnt > 0u ? cnt : 1u;
}

__device__ __forceinline__ void xcd_barrier(const XcdBarrier& b) {
    asm volatile("s_waitcnt vmcnt(0)" ::: "memory");
    __syncthreads();
    if (threadIdx.x == 0) {
        unsigned* bar = b.bar;
        __builtin_amdgcn_s_waitcnt(0);
        unsigned nloc = b.st[0], nx = b.st[1];
        if (nloc == 0u) { xcd_barrier_complete(bar, b.x, nloc, nx); b.st[0] = nloc; b.st[1] = nx; }
        const unsigned old = xb_add(&bar[XB_XSUB(b.x)], 1u);
        const unsigned gen = old / nloc;
        if (old + 1u == (gen + 1u) * nloc) {
            __builtin_amdgcn_fence(__ATOMIC_RELEASE, "agent");
            asm volatile("s_waitcnt vmcnt(0)" ::: "memory");
            const unsigned og = xb_add(&bar[XB_TOP], 1u);
            const unsigned tg = og / nx;
            if (og + 1u == (tg + 1u) * nx) xb_add(&bar[XB_TOPGEN], 1u);
            else XB_SPIN(xb_ld(&bar[XB_TOPGEN]) == tg, bar);
            __builtin_amdgcn_fence(__ATOMIC_ACQUIRE, "agent");
            xb_add(&bar[XB_XGEN(b.x)], 1u);
            asm volatile("s_waitcnt vmcnt(0)" ::: "memory");
        } else {
            XB_SPIN(xb_ld(&bar[XB_XGEN(b.x)]) == gen, bar);
            __builtin_amdgcn_fence(__ATOMIC_ACQUIRE, "agent");
            asm volatile("s_waitcnt vmcnt(0)" ::: "memory");
        }
    }
    __syncthreads();
}

__global__ void __launch_bounds__(512, 2) mk_fwd(Args a) {
    extern __shared__ __attribute__((aligned(16))) unsigned char lds_raw[];
    LAS unsigned char* lds = (LAS unsigned char*)lds_raw;
    cg::grid_group grid = cg::this_grid();
    const int tid0 = threadIdx.x, G = gridDim.x, bx = blockIdx.x;
    { volatile LAS unsigned* st0 = (volatile LAS unsigned*)(lds + 131072 + 64); if (tid0 == 0) { st0[0] = 0u; st0[1] = 0u; } }
    __syncthreads();
    XcdBarrier xbar = xcd_barrier_post((unsigned*)a.ws, (volatile LAS unsigned*)(lds + 131072 + 64));
    for (int ph = a.lo; ph < a.hi; ++ph) {
        unsigned char* ws = a.ws; int tid = (int)__builtin_amdgcn_workitem_id_x();
        asm volatile("" : "+s"(ws), "+v"(tid));
        int l = 0, k = -1; if (ph > 0) { l = (ph - 1) / 10; k = (ph - 1) % 10; }
        const int ng = (k == 0 || k == 4 || k == 5 || k == 7 || k == 8) ? 1 : (k == 2 ? 3 : 0);
#ifndef PM
#define PM 0xFF
#endif
        if (PM & 1) for (int j = 0; j < ng; ++j) {
            size_t oA, oB, oO; int M_ = MTOK, N_ = DM, K_ = DM, lda = DM, ldb = DM, ldc = DM, mode = 0, nbr = 1, coff = 0, use_rs = 0, zs = 0, bmode = 0, fused = 0, a_in_out = 0, o_in_out = 0;
            if (k == 0) {
                oA = WS_XBF; oB = WS_WIN; oO = WS_BIG; N_ = 2048; ldc = 2048; use_rs = 1; mode = 1;
            } else if (k == 2) {
                if (j == 0) { oA = WS_CQN; oB = WS_WUQ; oO = WS_Q; N_ = 512; K_ = 256; lda = 256; ldb = 256; ldc = 512; }
                else if (j == 1) { oA = WS_CKVN; oB = WS_WK; oO = WS_KN; N_ = 256; K_ = 128; lda = 128; ldb = 128; ldc = 256; }
                else { oA = WS_WV; oB = WS_CKVN; oO = WS_VT; M_ = 256; N_ = MTOK; K_ = 128; lda = 128; ldb = 128; ldc = MTOK; coff = G / 2; }
            } else if (k == 4) {
                oA = WS_BR; oB = WS_WBR; oO = 0; o_in_out = 1; K_ = 256; N_ = DM; bmode = 2; nbr = 8; use_rs = 1; fused = 1;
            } else if (k == 5) {
                oA = 0; a_in_out = 1; oB = WS_WOUT; oO = WS_BIG;
            } else if (k == 7) {
                oA = WS_XBF; oB = WS_W1; oO = WS_BIG; N_ = DFF; ldc = DFF; use_rs = 1; mode = 3;
            } else {
                oA = WS_BIG; oB = WS_W2; oO = WS_BR; K_ = DFF; lda = DFF; ldb = DFF;
            }
            pg8::Gemm g{a_in_out ? (const bf16_t*)a.out : (const bf16_t*)(ws + oA), (const bf16_t*)(ws + oB), M_, N_, K_, lda, ldb, bmode,
                        fused ? (const bf16_t*)(ws + WS_XBF) : nullptr, fused ? (const bf16_t*)(ws + WS_WIN + (size_t)2048 * DM * 2) : nullptr, fused ? DM : 0, fused ? 1 : 0};
            pg8::EpiRT E{o_in_out ? (bf16_t*)a.out : (bf16_t*)(ws + oO), ldc, use_rs ? (const float*)(ws + WS_RS) : nullptr, a.in[I_GATEB] + l * 4096, (const bf16_t*)ws, mode, zs};
            pg8::MergeOrder S; S.init(M_, N_, G, (bx + coff) % G, nbr);
            pg8::gemm_phase<pg8::EpiRT, pg8::MergeOrder, true, true>(lds, g, S, E, tid);
        }
        if ((PM & 2) && k == 1) phase_e1(a, ws, l, lds, tid);
        if ((PM & 4) && k == 3) phase_attn(a, ws, lds, tid);
        if ((PM & 8) && (k == 6 || k == 9)) phase_nr(a, ws, (k == 6 ? a.in[I_NPOST] : a.in[I_NFPOST]) + l * DM, k == 6 ? WS_BIG : WS_BR, (k == 9 && l == NLAYER - 1), tid);
        if ((PM & 16) && ph == 0) phase_s0(a, ws, lds, tid);
        if ((PM & 32) && (ph == 0 || (k == 9 && l + 1 < NLAYER))) prep_weights(a, ws, ph == 0 ? 0 : l + 1, lds, tid);
        if (ph + 1 < a.hi) { if (ph == a.lo) grid.sync(); else xcd_barrier(xbar); }
    }
}

constexpr int NPHASE = 1 + 10 * NLAYER;
#ifndef MK_ONE_LAUNCH
#define MK_ONE_LAUNCH 1
#endif
extern "C" void kernel_launch(void* const* d_in, const int* in_sizes, int n_in, void* d_out, int out_size, void* d_ws, size_t ws_size, hipStream_t stream) {
    static int grid = 0;
    if (grid == 0) {
        if (n_in != 26 || out_size != MTOK * DM || ws_size < WS_END) { fprintf(stderr, "kernel_launch: unexpected shapes (n_in %d out %d ws %zu)\n", n_in, out_size, ws_size); grid = -1; return; }
        int dev = 0, cus = 0, per_cu = 0;
        hipGetDevice(&dev); hipDeviceGetAttribute(&cus, hipDeviceAttributeMultiprocessorCount, dev);
        hipFuncSetAttribute((const void*)mk_fwd, hipFuncAttributeMaxDynamicSharedMemorySize, LDS_BYTES);
        hipOccupancyMaxActiveBlocksPerMultiprocessor(&per_cu, (const void*)mk_fwd, 512, LDS_BYTES);
        if (per_cu < 1) { fprintf(stderr, "kernel_launch: occupancy query says %d blocks per CU\n", per_cu); per_cu = 1; }
        (void)hipGetLastError();
        grid = cus;
    }
    if (grid < 0) return;
    Args a{};
    for (int i = 0; i < 26; ++i) a.in[i] = (const float*)d_in[i];
    a.out = (float*)d_out; a.ws = (unsigned char*)d_ws;
    if (hipMemsetAsync(d_ws, 0, 16384, stream) != hipSuccess) { fprintf(stderr, "memset failed\n"); return; }
#if MK_ONE_LAUNCH
    a.lo = 0; a.hi = NPHASE;
    { void* args[] = {&a}; hipError_t e = hipLaunchCooperativeKernel((const void*)mk_fwd, dim3(grid), dim3(512), args, LDS_BYTES, stream);
      if (e != hipSuccess) fprintf(stderr, "cooperative launch failed: %s (grid %d)\n", hipGetErrorString(e), grid); }
#else
    for (int ph = 0; ph < NPHASE; ++ph) { a.lo = ph; a.hi = ph + 1;
        void* args[] = {&a}; hipError_t e = hipLaunchCooperativeKernel((const void*)mk_fwd, dim3(grid), dim3(512), args, LDS_BYTES, stream);
        if (e != hipSuccess) { fprintf(stderr, "launch %d failed: %s (grid %d)\n", ph, hipGetErrorString(e), grid); break; } }
#endif
}
```
